# Optimizing an MI355X kernel written in HIP

```python
import math
import jax, jax.numpy as jnp
from jax import lax
import numpy as np


D_MODEL = 1024
BATCH = 8
SEQ = 4096
DEPTH = 1

M_HEADS = 4
M_DV = 128
M_DQK = 64
M_CHUNK = 64
M_CONV = 4
A_HEADS = 8
A_DH = 64
IDX_HEADS = 8
IDX_DIM = 64
TOPK_MAX = 256
Q_BLOCK = 128
REL_BUCKETS = 32
REL_MAX_DIST = 128
D_FF = 2816
FFN_CONV = 3
EPS = 1e-6

M_WIDTH = M_HEADS * M_DV
A_WIDTH = A_HEADS * A_DH
D_MIX = M_WIDTH + A_WIDTH
IN_SIZES = (M_HEADS * M_DQK, M_HEADS * M_DQK, M_WIDTH, M_WIDTH, M_HEADS, M_HEADS,
            A_WIDTH, A_WIDTH, A_WIDTH, IDX_HEADS * IDX_DIM, IDX_DIM, IDX_HEADS)
D_IN = 2 * M_HEADS * M_DQK + 2 * M_WIDTH + 2 * M_HEADS + 3 * A_WIDTH + IDX_HEADS * IDX_DIM + IDX_DIM + IDX_HEADS

kernel_name = 'hymba_mlstm_dsa_convffn'


def rms_norm(x, g):
    xf = x.astype(jnp.float32)
    y = xf * lax.rsqrt(jnp.mean(xf * xf, axis=-1, keepdims=True) + EPS)
    return (y * g.astype(jnp.float32)).astype(x.dtype)


def causal_dwconv(x, w, b):
    width = w.shape[0]
    s = x.shape[1]
    xp = jnp.pad(x, ((0, 0), (width - 1, 0), (0, 0)))
    y = b + xp[:, 0:s] * w[0]
    for j in range(1, width):
        y = y + xp[:, j:j + s] * w[j]
    return y


def split_cols(z, sizes):
    out, off = [], 0
    for sz in sizes:
        out.append(z[..., off:off + sz])
        off += sz
    return out


def rel_bucket(dist):
    max_exact = REL_BUCKETS // 2
    d = jnp.maximum(dist, 0)
    large = max_exact + (jnp.log(jnp.maximum(d, 1).astype(jnp.float32) / max_exact)
                         / math.log(REL_MAX_DIST / max_exact) * (REL_BUCKETS - max_exact)).astype(jnp.int32)
    large = jnp.minimum(large, REL_BUCKETS - 1)
    return jnp.where(d < max_exact, d, large)


def mlstm_chunkwise(q, k, v, i_pre, f_pre):
    bsz, s, nh, dqk = q.shape
    dv = v.shape[-1]
    L = M_CHUNK
    nc = s // L
    f32 = jnp.float32

    def heads_chunks(t):
        return t.astype(f32).reshape(bsz, nc, L, nh, t.shape[-1]).transpose(0, 3, 1, 2, 4)

    q = heads_chunks(q) * (dqk ** -0.5)
    k = heads_chunks(k)
    v = heads_chunks(v)
    ig = i_pre.astype(f32).reshape(bsz, nc, L, nh).transpose(0, 3, 1, 2)
    logf = jax.nn.log_sigmoid(f_pre.astype(f32)).reshape(bsz, nc, L, nh).transpose(0, 3, 1, 2)

    b = jnp.cumsum(logf, axis=-1)
    g = b[..., -1]
    a = g[..., None] - b + ig
    m_loc = jnp.max(a, axis=-1)
    wgt = jnp.exp(a - m_loc[..., None])
    kv_c = jnp.einsum('bhcl,bhcld,bhcle->bhcde', wgt, k, v)
    ks_c = jnp.einsum('bhcl,bhcld->bhcd', wgt, k)

    def step(carry, xs):
        c_st, n_st, m_st = carry
        kv, ks, gc, ml = xs
        m_new = jnp.maximum(gc + m_st, ml)
        decay = jnp.exp(gc + m_st - m_new)
        scale = jnp.exp(ml - m_new)
        c_new = decay[..., None, None] * c_st + scale[..., None, None] * kv
        n_new = decay[..., None] * n_st + scale[..., None] * ks
        return (c_new, n_new, m_new), (c_st, n_st, m_st)

    init = (jnp.zeros((bsz, nh, dqk, dv), f32), jnp.zeros((bsz, nh, dqk), f32), jnp.zeros((bsz, nh), f32))
    xs = (jnp.moveaxis(kv_c, 2, 0), jnp.moveaxis(ks_c, 2, 0), jnp.moveaxis(g, 2, 0), jnp.moveaxis(m_loc, 2, 0))
    _, (c_prev, n_prev, m_prev) = lax.scan(step, init, xs)
    c_prev = jnp.moveaxis(c_prev, 0, 2)
    n_prev = jnp.moveaxis(n_prev, 0, 2)
    m_prev = jnp.moveaxis(m_prev, 0, 2)

    tril = jnp.tril(jnp.ones((L, L), dtype=bool))
    dmat = b[..., :, None] - b[..., None, :] + ig[..., None, :]
    dmat = jnp.where(tril, dmat, -jnp.inf)
    inter_log = b + m_prev[..., None]
    m_t = jnp.maximum(inter_log, jnp.max(dmat, axis=-1))
    sc = jnp.einsum('bhcld,bhcsd->bhcls', q, k) * jnp.exp(dmat - m_t[..., None])
    inter_w = jnp.exp(inter_log - m_t)
    num = inter_w[..., None] * jnp.einsum('bhcld,bhcde->bhcle', q, c_prev) + jnp.einsum('bhcls,bhcse->bhcle', sc, v)
    den = inter_w * jnp.einsum('bhcld,bhcd->bhcl', q, n_prev) + jnp.sum(sc, axis=-1)
    h = num / jnp.maximum(jnp.abs(den), jnp.exp(-m_t))[..., None]
    return h.transpose(0, 2, 3, 1, 4).reshape(bsz, s, nh, dv)


def dsa_attention(q_att, k_att, v_att, q_idx, k_idx, w_idx, rel_bias):
    bsz, s = q_att.shape[0], q_att.shape[1]
    topk = min(TOPK_MAX, s // 4)
    nqb = s // Q_BLOCK
    key_pos = jnp.arange(s, dtype=jnp.int32)

    def to_blocks(t):
        return t.reshape(bsz, nqb, Q_BLOCK, *t.shape[2:]).swapaxes(0, 1)

    def one_block(args):
        qa, qi, wi, st = args
        qpos = st + jnp.arange(Q_BLOCK, dtype=jnp.int32)
        isc = jnp.einsum('bqhd,bsd->bqhs', qi, k_idx).astype(jnp.float32) * (IDX_DIM ** -0.5)
        score = jnp.einsum('bqhs,bqh->bqs', jax.nn.relu(isc), wi.astype(jnp.float32))
        score = jnp.where(key_pos[None, None, :] <= qpos[None, :, None], score, -jnp.inf)
        _, idx = lax.top_k(score, topk)
        valid = idx <= qpos[None, :, None]
        ks = jax.vmap(lambda kb, ib: kb[ib])(k_att, idx)
        vs = jax.vmap(lambda vb, ib: vb[ib])(v_att, idx)
        bias = rel_bias[rel_bucket(qpos[None, :, None] - idx)]
        logits = jnp.einsum('bqhd,bqkhd->bqhk', qa, ks).astype(jnp.float32) * (A_DH ** -0.5)
        logits = logits + bias.astype(jnp.float32).transpose(0, 1, 3, 2)
        logits = jnp.where(valid[:, :, None, :], logits, -jnp.inf)
        p = jax.nn.softmax(logits, axis=-1)
        return jnp.einsum('bqhk,bqkhd->bqhd', p.astype(vs.dtype), vs)

    starts = jnp.arange(nqb, dtype=jnp.int32) * Q_BLOCK
    out = lax.map(one_block, (to_blocks(q_att), to_blocks(q_idx), to_blocks(w_idx), starts))
    return out.swapaxes(0, 1).reshape(bsz, s, A_HEADS, A_DH)


def setup_inputs(seed: int = 0) -> dict:
    key = jax.random.key(seed)
    ks = jax.random.split(key, 20)
    f32 = jnp.float32
    nrm = lambda k, shape, scale: jax.random.normal(k, shape, f32) * scale
    return {
        'x': nrm(ks[0], (BATCH, SEQ, D_MODEL), 1.0),
        'norm_mix': 1.0 + nrm(ks[1], (DEPTH, D_MODEL), 0.01),
        'w_in': nrm(ks[2], (DEPTH, D_MODEL, D_IN), D_MODEL ** -0.5),
        'mlstm_conv_w': nrm(ks[3], (DEPTH, M_CONV, 2 * M_HEADS * M_DQK), M_CONV ** -0.5),
        'mlstm_conv_b': nrm(ks[4], (DEPTH, 2 * M_HEADS * M_DQK), 0.01),
        'i_bias': nrm(ks[5], (DEPTH, M_HEADS), 0.1),
        'f_bias': 3.0 + nrm(ks[6], (DEPTH, M_HEADS), 0.5),
        'mlstm_norm': 1.0 + nrm(ks[7], (DEPTH, M_WIDTH), 0.01),
        'idx_k_norm': 1.0 + nrm(ks[8], (DEPTH, IDX_DIM), 0.01),
        'rel_bias': nrm(ks[9], (REL_BUCKETS, A_HEADS), 0.5),
        'w_out': nrm(ks[10], (DEPTH, D_MIX, D_MODEL), D_MIX ** -0.5),
        'norm_ffn': 1.0 + nrm(ks[11], (DEPTH, D_MODEL), 0.01),
        'w_up': nrm(ks[12], (DEPTH, D_MODEL, 2 * D_FF), D_MODEL ** -0.5),
        'ffn_conv_w': nrm(ks[13], (DEPTH, FFN_CONV, 2 * D_FF), FFN_CONV ** -0.5),
        'ffn_conv_b': nrm(ks[14], (DEPTH, 2 * D_FF), 0.01),
        'w_down': nrm(ks[15], (DEPTH, D_FF, D_MODEL), D_FF ** -0.5),
        'norm_final': 1.0 + nrm(ks[16], (D_MODEL,), 0.01),
    }


def reference(x, norm_mix, w_in, mlstm_conv_w, mlstm_conv_b, i_bias, f_bias, mlstm_norm,
              idx_k_norm, rel_bias, w_out, norm_ffn, w_up, ffn_conv_w, ffn_conv_b, w_down, norm_final):
    bsz, s, _ = x.shape
    for l in range(DEPTH):
        h = rms_norm(x, norm_mix[l])
        z = h @ w_in[l]
        (m_q, m_k, m_v, m_o, m_i, m_f, a_q, a_k, a_v, i_q, i_k, i_w) = split_cols(z, IN_SIZES)

        qk = jax.nn.silu(causal_dwconv(jnp.concatenate([m_q, m_k], axis=-1), mlstm_conv_w[l], mlstm_conv_b[l]))
        m_q, m_k = qk[..., :M_HEADS * M_DQK], qk[..., M_HEADS * M_DQK:]
        hm = mlstm_chunkwise(m_q.reshape(bsz, s, M_HEADS, M_DQK), m_k.reshape(bsz, s, M_HEADS, M_DQK),
                             m_v.reshape(bsz, s, M_HEADS, M_DV), m_i + i_bias[l], m_f + f_bias[l])
        hm = rms_norm(hm, mlstm_norm[l].reshape(M_HEADS, M_DV)).astype(x.dtype)
        hm = jax.nn.sigmoid(m_o) * hm.reshape(bsz, s, M_WIDTH)

        ha = dsa_attention(a_q.reshape(bsz, s, A_HEADS, A_DH), a_k.reshape(bsz, s, A_HEADS, A_DH),
                           a_v.reshape(bsz, s, A_HEADS, A_DH), i_q.reshape(bsz, s, IDX_HEADS, IDX_DIM),
                           rms_norm(i_k, idx_k_norm[l]), i_w * (IDX_HEADS ** -0.5), rel_bias)
        ha = ha.reshape(bsz, s, A_WIDTH)

        x = x + jnp.concatenate([hm, ha], axis=-1) @ w_out[l]

        h = rms_norm(x, norm_ffn[l])
        u = causal_dwconv(h @ w_up[l], ffn_conv_w[l], ffn_conv_b[l])
        gate, val = u[..., :D_FF], u[..., D_FF:]
        x = x + (jax.nn.silu(gate) * val) @ w_down[l]
    return rms_norm(x, norm_final)
```

```cpp
#include <hip/hip_runtime.h>
#include <cstdio>
#include <cstdint>

#define LAS __attribute__((address_space(3)))
typedef _Float16 h16;
typedef _Float16 h16x8 __attribute__((ext_vector_type(8)));
typedef float f32x4 __attribute__((ext_vector_type(4)));
typedef unsigned u32x4 __attribute__((ext_vector_type(4)));

constexpr int NB = 8, S = 4096, T = NB * S, D = 1024;
constexpr int ZP = 3840;
constexpr int DFF = 2816, NUP = 2 * DFF;
constexpr int ZC_MQ = 0, ZC_MK = 256, ZC_MV = 512, ZC_MO = 1024, ZC_AQ = 1536, ZC_AK = 2048, ZC_AV = 2560, ZC_IQ = 3072, ZC_IK = 3584, ZC_G = 3648;
constexpr int TOPK = 256;
constexpr float EPS = 1e-6f;
constexpr int NTHR = 512;

constexpr size_t MiB = 1u << 20;
constexpr size_t WS_CTL = 0;
constexpr size_t WS_WIN = 2 * MiB;
constexpr size_t WS_WOUT = 10 * MiB;
constexpr size_t WS_WUP = 12 * MiB;
constexpr size_t WS_WDN = 23 * MiB;
constexpr size_t WS_GATES = 29 * MiB;
constexpr size_t WS_XN = 32 * MiB;
constexpr size_t WS_Z = 96 * MiB;
constexpr size_t WS_MIX = 336 * MiB;
constexpr size_t WS_KN = 400 * MiB;
constexpr size_t WS_BM = 404 * MiB;
constexpr size_t WS_Y = 96 * MiB;
constexpr size_t WS_ACT = 272 * MiB;
constexpr size_t WS_END = 448 * MiB;

struct Args { const float* in[17]; float* out; unsigned char* ws; int ph_lo, ph_hi; };

struct Frame {
    const float *x, *norm_mix, *w_in, *conv_w, *conv_b, *i_bias, *f_bias, *mlstm_norm, *idx_k_norm, *rel_bias, *w_out, *norm_ffn, *w_up, *ffn_conv_w, *ffn_conv_b, *w_down, *norm_final;
    float* out;
    h16 *WIN, *WOUT, *WUP, *WDN, *XN, *Z, *MIX, *KN, *Y, *ACT;
    float* GATES; unsigned* BM;
    int tid, lane, wave;
};

__device__ __forceinline__ float wave_sum(float v) {
#pragma unroll
    for (int o = 1; o < 64; o <<= 1) v += __shfl_xor(v, o);
    return v;
}
__device__ __forceinline__ float wave_max(float v) {
#pragma unroll
    for (int o = 1; o < 64; o <<= 1) v = fmaxf(v, __shfl_xor(v, o));
    return v;
}
__device__ __forceinline__ int wave_isum(int v) {
#pragma unroll
    for (int o = 1; o < 64; o <<= 1) v += __shfl_xor(v, o);
    return v;
}
__device__ __forceinline__ float sigmoidf_(float x) { return 1.f / (1.f + __expf(-x)); }

__device__ __forceinline__ int src_col_in(int n) { return n < 1536 ? n : n < 3648 ? n + 8 : n < 3656 ? n - 3648 + 1536 : n < 3664 ? n : -1; }
__device__ __forceinline__ int src_col_up(int n) { const int pn = n >> 8, r = n & 255; return (r >> 7) * DFF + pn * 128 + (r & 127); }

template <int MODE>
__device__ __forceinline__ void transpose_item(const float* W, int K, int N, h16* WT, int NOUT, LAS float* scr, int item, int lane) {
    const int nblk = NOUT / 32, kb = item / nblk, nb = item % nblk, k0 = 64 * kb, n0 = 32 * nb;
    const int n = n0 + (lane & 31);
    const int sc = MODE == 1 ? src_col_in(n) : MODE == 2 ? src_col_up(n) : n;
#pragma unroll 8
    for (int i = 0; i < 32; ++i) { const int kk = 2 * i + (lane >> 5); scr[kk * 33 + (lane & 31)] = sc >= 0 ? W[(size_t)(k0 + kk) * N + sc] : 0.f; }
    __builtin_amdgcn_s_waitcnt(0xc07f); __builtin_amdgcn_wave_barrier();
    const int c = lane & 7;
#pragma unroll
    for (int j = 0; j < 4; ++j) {
        const int nn = (lane >> 3) + 8 * j; const LAS float* s = scr + (8 * c) * 33 + nn;
        h16x8 o;
#pragma unroll
        for (int i = 0; i < 8; ++i) o[i] = (h16)s[i * 33];
        *(h16x8*)(WT + (size_t)(n0 + nn) * K + k0 + 8 * c) = o;
    }
    __builtin_amdgcn_s_waitcnt(0xc07f); __builtin_amdgcn_wave_barrier();
}

__device__ __forceinline__ void rms_row_to_h16(const float* xrow, const float* g, h16* orow, int lane) {
    f32x4 v[4]; float s = 0.f;
#pragma unroll
    for (int j = 0; j < 4; ++j) { v[j] = *(const f32x4*)(xrow + 4 * lane + 256 * j); s += (v[j].x * v[j].x + v[j].y * v[j].y) + (v[j].z * v[j].z + v[j].w * v[j].w); }
    const float r = 1.f / sqrtf(wave_sum(s) * (1.f / D) + EPS);
#pragma unroll
    for (int j = 0; j < 4; ++j) {
        const f32x4 gg = *(const f32x4*)(g + 4 * lane + 256 * j);
        typedef _Float16 h16x4 __attribute__((ext_vector_type(4)));
        h16x4 o; o[0] = (h16)(v[j].x * r * gg.x); o[1] = (h16)(v[j].y * r * gg.y); o[2] = (h16)(v[j].z * r * gg.z); o[3] = (h16)(v[j].w * r * gg.w);
        *(h16x4*)(orow + 4 * lane + 256 * j) = o;
    }
}

__device__ __forceinline__ void p0_prologue(const Frame& F, LAS unsigned char* lds) {
    LAS float* scr = (LAS float*)lds + F.wave * (64 * 33);
    const int gw = blockIdx.x * 8 + F.wave, NGW = gridDim.x * 8;
    constexpr int I_IN = 16 * (ZP / 32), I_OUT = 16 * (D / 32), I_UP = 16 * (NUP / 32), I_DN = (DFF / 64) * (D / 32);
    for (int it = gw; it < I_IN + I_OUT + I_UP + I_DN; it += NGW) {
        int r = it;
        if (r < I_IN) { transpose_item<1>(F.w_in, D, 3664, F.WIN, ZP, scr, r, F.lane); continue; } r -= I_IN;
        if (r < I_OUT) { transpose_item<0>(F.w_out, D, D, F.WOUT, D, scr, r, F.lane); continue; } r -= I_OUT;
        if (r < I_UP) { transpose_item<2>(F.w_up, D, NUP, F.WUP, NUP, scr, r, F.lane); continue; } r -= I_UP;
        transpose_item<0>(F.w_down, DFF, D, F.WDN, D, scr, r, F.lane);
    }
    for (int m = gw; m < T; m += NGW) rms_row_to_h16(F.x + (size_t)m * D, F.norm_mix, F.XN + (size_t)m * D, F.lane);
}

template <class Epi>
__device__ __forceinline__ void gemm_naive(LAS unsigned char* lds, const h16* A, const h16* Bt, int row_lo, int row_hi, int N, int K, const Epi& E) {
    LAS float* As = (LAS float*)lds;
    LAS float* Bs = As + 32 * 132;
    const int tid = threadIdx.x, ty = tid >> 4, tx = tid & 15;
    const int ntm = (row_hi - row_lo) / 128, ntn = N / 64;
    for (int u = blockIdx.x; u < ntm * ntn; u += gridDim.x) {
        const int tm = u / ntn, tn = u % ntn, r0 = row_lo + tm * 128, c0 = tn * 64;
        float acc[4][4];
#pragma unroll
        for (int i = 0; i < 4; ++i)
#pragma unroll
            for (int j = 0; j < 4; ++j) acc[i][j] = 0.f;
        for (int k0 = 0; k0 < K; k0 += 32) {
            __syncthreads();
            { const int r = tid >> 2, kc = tid & 3; const h16x8 v = *(const h16x8*)(A + (size_t)(r0 + r) * K + k0 + kc * 8);
#pragma unroll
              for (int j = 0; j < 8; ++j) As[(kc * 8 + j) * 132 + r] = (float)v[j]; }
            if (tid < 256) { const int r = tid >> 2, kc = tid & 3; const h16x8 v = *(const h16x8*)(Bt + (size_t)(c0 + r) * K + k0 + kc * 8);
#pragma unroll
              for (int j = 0; j < 8; ++j) Bs[(kc * 8 + j) * 68 + r] = (float)v[j]; }
            __syncthreads();
#pragma unroll 8
            for (int k = 0; k < 32; ++k) {
                const f32x4 a = *(const LAS f32x4*)(As + k * 132 + ty * 4), b = *(const LAS f32x4*)(Bs + k * 68 + tx * 4);
#pragma unroll
                for (int i = 0; i < 4; ++i)
#pragma unroll
                    for (int j = 0; j < 4; ++j) acc[i][j] += a[i] * b[j];
            }
        }
#pragma unroll
        for (int i = 0; i < 4; ++i) E(r0 + ty * 4 + i, c0 + tx * 4, acc[i]);
    }
}

struct EpiZ {
    h16* Z; float* G;
    __device__ __forceinline__ void operator()(int row, int col, const float (&v)[4]) const {
        typedef _Float16 h16x4 __attribute__((ext_vector_type(4)));
        h16x4 o; o[0] = (h16)v[0]; o[1] = (h16)v[1]; o[2] = (h16)v[2]; o[3] = (h16)v[3];
        *(h16x4*)(Z + (size_t)row * ZP + col) = o;
        if (col >= ZC_G && col < ZC_G + 16) { *(f32x4*)(G + (size_t)row * 16 + (col - ZC_G)) = (f32x4){v[0], v[1], v[2], v[3]}; }
    }
};
struct EpiRes {
    const float* base; float* out;
    __device__ __forceinline__ void operator()(int row, int col, const float (&v)[4]) const {
        const f32x4 b = *(const f32x4*)(base + (size_t)row * D + col);
        *(f32x4*)(out + (size_t)row * D + col) = (f32x4){b.x + v[0], b.y + v[1], b.z + v[2], b.w + v[3]};
    }
};
struct EpiY {
    h16* Y; int row_lo;
    __device__ __forceinline__ void operator()(int row, int col, const float (&v)[4]) const {
        typedef _Float16 h16x4 __attribute__((ext_vector_type(4)));
        h16x4 o; o[0] = (h16)v[0]; o[1] = (h16)v[1]; o[2] = (h16)v[2]; o[3] = (h16)v[3];
        *(h16x4*)(Y + (size_t)(row - row_lo) * NUP + col) = o;
    }
};

__device__ __forceinline__ void mlstm_naive(const Frame& F, LAS unsigned char* lds) {
    LAS float* qs = (LAS float*)lds; LAS float* ks = qs + 64; LAS float* part = ks + 64; LAS float* red = part + 512;
    const int tid = F.tid, e = tid & 127, qd = tid >> 7;
    for (int unit = blockIdx.x; unit < NB * 4; unit += gridDim.x) {
        const int b = unit >> 2, h = unit & 3;
        float C[16]; float n_d = 0.f, m = 0.f;
#pragma unroll
        for (int i = 0; i < 16; ++i) C[i] = 0.f;
        const float ib = F.i_bias[h], fb = F.f_bias[h];
        for (int t = 0; t < S; ++t) {
            const size_t row = (size_t)b * S + t;
            if (tid < 128) {
                const int cc = (tid < 64) ? (h * 64 + tid) : (256 + h * 64 + (tid - 64));
                float a = F.conv_b[cc];
#pragma unroll
                for (int j = 0; j < 4; ++j) { const int tt = t - 3 + j; if (tt >= 0) a += F.conv_w[j * 512 + cc] * (float)F.Z[(row - 3 + j) * ZP + cc]; }
                float v = a * sigmoidf_(a);
                if (tid < 64) qs[tid] = v * 0.125f; else ks[tid - 64] = v;
            }
            const float ig = F.GATES[row * 16 + h] + ib, fp = F.GATES[row * 16 + 4 + h] + fb;
            const float logf = fminf(fp, 0.f) - log1pf(__expf(-fabsf(fp)));
            const float m_new = fmaxf(logf + m, ig), fs = __expf(logf + m - m_new), is = __expf(ig - m_new); m = m_new;
            __syncthreads();
            const float ve = (float)F.Z[row * ZP + ZC_MV + h * 128 + e];
            float pn = 0.f;
#pragma unroll
            for (int i = 0; i < 16; ++i) { const int d = qd * 16 + i; C[i] = fs * C[i] + is * ks[d] * ve; pn += qs[d] * C[i]; }
            part[qd * 128 + e] = pn;
            if (tid < 64) { n_d = fs * n_d + is * ks[tid]; const float dn = wave_sum(qs[tid] * n_d); if (tid == 0) red[0] = dn; }
            __syncthreads();
            float hv = 0.f;
            if (tid < 128) {
                const float num = (part[e] + part[128 + e]) + (part[256 + e] + part[384 + e]), den = red[0];
                hv = num / fmaxf(fabsf(den), __expf(-m));
                const float sq = wave_sum(hv * hv); if (F.lane == 0) red[1 + F.wave] = sq;
            }
            __syncthreads();
            if (tid < 128) {
                const float r = 1.f / sqrtf((red[1] + red[2]) * (1.f / 128.f) + EPS);
                const float og = (float)F.Z[row * ZP + ZC_MO + h * 128 + e];
                F.MIX[row * D + h * 128 + e] = (h16)(hv * r * F.mlstm_norm[h * 128 + e] * sigmoidf_(og));
            }
        }
        __syncthreads();
    }
}

__device__ __forceinline__ void kn_phase(const Frame& F) {
    const int gw = blockIdx.x * 8 + F.wave, NGW = gridDim.x * 8;
    const float g = F.idx_k_norm[F.lane];
    for (int m = gw; m < T; m += NGW) {
        const float v = (float)F.Z[(size_t)m * ZP + ZC_IK + F.lane];
        const float r = 1.f / sqrtf(wave_sum(v * v) * (1.f / 64.f) + EPS);
        F.KN[(size_t)m * 64 + F.lane] = (h16)(v * r * g);
    }
}

__device__ __forceinline__ unsigned ord_key(float f) { const unsigned u = __float_as_uint(f); return (u & 0x80000000u) ? ~u : (u | 0x80000000u); }

__device__ __forceinline__ void index_naive(const Frame& F, LAS unsigned char* lds) {
    LAS float* qf = (LAS float*)lds;
    LAS float* wq = qf + 512;
    LAS unsigned* cnt = (LAS unsigned*)(wq + 8);
    LAS unsigned* keys = cnt + 40;
    const int tid = F.tid;
    for (int row = blockIdx.x; row < T; row += gridDim.x) {
        const int t = row & (S - 1), b = row >> 12;
        __syncthreads();
        qf[tid] = (float)F.Z[(size_t)row * ZP + ZC_IQ + tid];
        if (tid < 8) wq[tid] = F.GATES[(size_t)row * 16 + 8 + tid] * 0.35355339059327373f;
        if (tid < 40) cnt[tid] = 0u;
        __syncthreads();
        unsigned kk[8];
#pragma unroll
        for (int j = 0; j < 8; ++j) {
            const int s = tid + 512 * j; kk[j] = 0u;
            if (s <= t) {
                const h16* kr = F.KN + ((size_t)b * S + s) * 64;
                float kf[64];
#pragma unroll
                for (int c = 0; c < 8; ++c) { const h16x8 v = *(const h16x8*)(kr + 8 * c);
#pragma unroll
                    for (int i = 0; i < 8; ++i) kf[8 * c + i] = (float)v[i]; }
                float score = 0.f;
#pragma unroll
                for (int hh = 0; hh < 8; ++hh) { float dot = 0.f;
#pragma unroll
                    for (int d = 0; d < 64; ++d) dot += qf[hh * 64 + d] * kf[d];
                    score += fmaxf(dot * 0.125f, 0.f) * wq[hh]; }
                kk[j] = ord_key(score); keys[s] = kk[j];
            }
        }
        unsigned vstar = 0u;
        if (t >= TOPK) {
            unsigned prefix = 0u;
            for (int bit = 31; bit >= 0; --bit) {
                const unsigned cand = prefix | (1u << bit); int c = 0;
#pragma unroll
                for (int j = 0; j < 8; ++j) c += (kk[j] >= cand) ? 1 : 0;
                c = wave_isum(c); if (F.lane == 0) atomicAdd((unsigned*)&cnt[bit], (unsigned)c);
                __syncthreads();
                if (cnt[bit] >= (unsigned)TOPK) prefix = cand;
            }
            vstar = prefix;
            int cg = 0, ce = 0;
#pragma unroll
            for (int j = 0; j < 8; ++j) { cg += (kk[j] > vstar) ? 1 : 0; ce += (kk[j] == vstar) ? 1 : 0; }
            cg = wave_isum(cg); ce = wave_isum(ce);
            if (F.lane == 0) { atomicAdd((unsigned*)&cnt[32], (unsigned)cg); atomicAdd((unsigned*)&cnt[33], (unsigned)ce); }
            __syncthreads();
            const int need = TOPK - (int)cnt[32];
            if ((int)cnt[33] > need) {
                if (tid == 0) { int nd = need; for (int s = 0; s <= t; ++s) if (keys[s] == vstar) { if (nd > 0) --nd; else keys[s] = 0u; } }
            }
        }
        __syncthreads();
        if (tid < 128) {
            unsigned word = 0u;
            for (int i = 0; i < 32; ++i) { const int s = 32 * tid + i; if (s <= t && keys[s] >= vstar) word |= (1u << i); }
            F.BM[(size_t)row * 128 + tid] = word;
        }
    }
}

__device__ __forceinline__ void attn_naive(const Frame& F, LAS unsigned char* lds) {
    LAS float* qf = (LAS float*)lds;
    LAS float* p = qf + 512;
    LAS int* sel = (LAS int*)(p + 2048);
    LAS int* pcs = sel + 288;
    LAS float* btab = (LAS float*)(pcs + 128);
    LAS int* nselp = (LAS int*)(btab + 1024);
    const int tid = F.tid, hh = F.wave, lane = F.lane;
    for (int i = tid; i < 1024; i += NTHR) {
        const int dist = i >> 3, h = i & 7; int bk;
        if (dist < 16) bk = dist; else { bk = 16 + (int)(log((double)dist / 16.0) / log(8.0) * 16.0); if (bk > 31) bk = 31; }
        btab[i] = F.rel_bias[bk * 8 + h];
    }
    for (int row = blockIdx.x; row < T; row += gridDim.x) {
        const int t = row & (S - 1), b = row >> 12;
        __syncthreads();
        unsigned word = 0u;
        if (tid < 128) { word = F.BM[(size_t)row * 128 + tid]; pcs[tid] = __popc(word); }
        qf[tid] = (float)F.Z[(size_t)row * ZP + ZC_AQ + tid];
        __syncthreads();
        if (tid < 128) {
            int off = 0; for (int i = 0; i < tid; ++i) off += pcs[i];
            if (tid == 127) *nselp = off + pcs[127];
            while (word) { const int bpos = __ffs(word) - 1; word &= word - 1; if (off < 288) sel[off] = 32 * tid + bpos; ++off; }
        }
        __syncthreads();
        const int nsel = min(*nselp, 256);
        float lg[4]; float mx = -INFINITY;
#pragma unroll
        for (int jj = 0; jj < 4; ++jj) {
            const int j = lane + 64 * jj; lg[jj] = -INFINITY;
            if (j < nsel) {
                const int s = sel[j]; const h16* kr = F.Z + ((size_t)b * S + s) * ZP + ZC_AK + hh * 64;
                float dot = 0.f;
#pragma unroll
                for (int c = 0; c < 8; ++c) { const h16x8 v = *(const h16x8*)(kr + 8 * c);
#pragma unroll
                    for (int i = 0; i < 8; ++i) dot += qf[hh * 64 + 8 * c + i] * (float)v[i]; }
                const int dist = t - s;
                lg[jj] = dot * 0.125f + btab[(dist < 127 ? dist : 127) * 8 + hh];
                mx = fmaxf(mx, lg[jj]);
            }
        }
        mx = wave_max(mx);
        float sum = 0.f;
#pragma unroll
        for (int jj = 0; jj < 4; ++jj) { const int j = lane + 64 * jj; const float ev = (j < nsel) ? __expf(lg[jj] - mx) : 0.f; sum += ev; p[hh * 256 + j] = ev; }
        sum = wave_sum(sum);
        __syncthreads();
        float acc = 0.f;
        for (int j = 0; j < nsel; ++j) acc += p[hh * 256 + j] * (float)F.Z[((size_t)b * S + sel[j]) * ZP + ZC_AV + hh * 64 + lane];
        F.MIX[(size_t)row * D + 512 + hh * 64 + lane] = (h16)(acc / sum);
    }
}

__device__ __forceinline__ void h2_phase(const Frame& F) {
    const int gw = blockIdx.x * 8 + F.wave, NGW = gridDim.x * 8;
    for (int m = gw; m < T; m += NGW) rms_row_to_h16(F.out + (size_t)m * D, F.norm_ffn, F.XN + (size_t)m * D, F.lane);
}
__device__ __forceinline__ void act_phase(const Frame& F, int row_lo, int row_hi) {
    const size_t total = (size_t)(row_hi - row_lo) * DFF;
    for (size_t i = (size_t)blockIdx.x * NTHR + F.tid; i < total; i += (size_t)gridDim.x * NTHR) {
        const int r = (int)(i / DFF), c = (int)(i % DFF); const int row = row_lo + r, t = row & (S - 1);
        const int pc = 256 * (c >> 7) + (c & 127);
        float ug = F.ffn_conv_b[c], uv = F.ffn_conv_b[DFF + c];
#pragma unroll
        for (int j = 0; j < 3; ++j) { const int tt = t - 2 + j; if (tt >= 0) {
            const h16* yr = F.Y + (size_t)(r - 2 + j) * NUP + pc;
            ug += F.ffn_conv_w[j * NUP + c] * (float)yr[0]; uv += F.ffn_conv_w[j * NUP + DFF + c] * (float)yr[128]; } }
        F.ACT[(size_t)row * DFF + c] = (h16)(ug * sigmoidf_(ug) * uv);
    }
}
__device__ __forceinline__ void final_norm_phase(const Frame& F) {
    const int gw = blockIdx.x * 8 + F.wave, NGW = gridDim.x * 8;
    for (int m = gw; m < T; m += NGW) {
        float* xr = F.out + (size_t)m * D; f32x4 v[4]; float s = 0.f;
#pragma unroll
        for (int j = 0; j < 4; ++j) { v[j] = *(const f32x4*)(xr + 4 * F.lane + 256 * j); s += (v[j].x * v[j].x + v[j].y * v[j].y) + (v[j].z * v[j].z + v[j].w * v[j].w); }
        const float r = 1.f / sqrtf(wave_sum(s) * (1.f / D) + EPS);
#pragma unroll
        for (int j = 0; j < 4; ++j) { const f32x4 g = *(const f32x4*)(F.norm_final + 4 * F.lane + 256 * j); *(f32x4*)(xr + 4 * F.lane + 256 * j) = (f32x4){v[j].x * r * g.x, v[j].y * r * g.y, v[j].z * r * g.z, v[j].w * r * g.w}; }
    }
}

constexpr int LDS_BYTES = 72 * 1024;
__global__ void __launch_bounds__(NTHR) mk_fwd(Args a) {
    extern __shared__ __attribute__((aligned(16))) unsigned char lds_raw[];
    LAS unsigned char* lds = (LAS unsigned char*)lds_raw;
    Frame F;
    F.x = a.in[0]; F.norm_mix = a.in[1]; F.w_in = a.in[2]; F.conv_w = a.in[3]; F.conv_b = a.in[4]; F.i_bias = a.in[5]; F.f_bias = a.in[6]; F.mlstm_norm = a.in[7];
    F.idx_k_norm = a.in[8]; F.rel_bias = a.in[9]; F.w_out = a.in[10]; F.norm_ffn = a.in[11]; F.w_up = a.in[12]; F.ffn_conv_w = a.in[13]; F.ffn_conv_b = a.in[14];
    F.w_down = a.in[15]; F.norm_final = a.in[16]; F.out = a.out;
    unsigned char* ws = a.ws;
    F.WIN = (h16*)(ws + WS_WIN); F.WOUT = (h16*)(ws + WS_WOUT); F.WUP = (h16*)(ws + WS_WUP); F.WDN = (h16*)(ws + WS_WDN);
    F.GATES = (float*)(ws + WS_GATES); F.XN = (h16*)(ws + WS_XN); F.Z = (h16*)(ws + WS_Z); F.MIX = (h16*)(ws + WS_MIX); F.KN = (h16*)(ws + WS_KN);
    F.BM = (unsigned*)(ws + WS_BM); F.Y = (h16*)(ws + WS_Y); F.ACT = (h16*)(ws + WS_ACT);
    F.tid = threadIdx.x; F.lane = F.tid & 63; F.wave = __builtin_amdgcn_readfirstlane(F.tid >> 6);
    const int lo = a.ph_lo, hi = a.ph_hi;
#define IN(k) (lo <= (k) && (k) < hi)
    if (IN(0)) p0_prologue(F, lds);
    if (IN(1)) { EpiZ E{F.Z, F.GATES}; gemm_naive(lds, F.XN, F.WIN, 0, T, ZP, D, E); }
    if (IN(2)) { kn_phase(F); mlstm_naive(F, lds); }
    if (IN(3)) index_naive(F, lds);
    if (IN(4)) attn_naive(F, lds);
    if (IN(5)) { EpiRes E{F.x, F.out}; gemm_naive(lds, F.MIX, F.WOUT, 0, T, D, D, E); }
    if (IN(6)) h2_phase(F);
    if (IN(7)) { EpiY E{F.Y, 0}; gemm_naive(lds, F.XN, F.WUP, 0, T / 2, NUP, D, E); }
    if (IN(8)) act_phase(F, 0, T / 2);
    if (IN(9)) { EpiY E{F.Y, T / 2}; gemm_naive(lds, F.XN, F.WUP, T / 2, T, NUP, D, E); }
    if (IN(10)) act_phase(F, T / 2, T);
    if (IN(11)) { EpiRes E{F.out, F.out}; gemm_naive(lds, F.ACT, F.WDN, 0, T, D, DFF, E); }
    if (IN(12)) final_norm_phase(F);
#undef IN
}

extern "C" void kernel_launch(void* const* d_in, const int* in_sizes, int n_in, void* d_out, int out_size, void* d_ws, size_t ws_size, hipStream_t stream) {
    static int ok = 0;
    if (ok == 0) {
        ok = 1;
        if (n_in != 17 || in_sizes[0] != T * D || out_size != T * D || ws_size < WS_END) { fprintf(stderr, "kernel_launch: unexpected shapes (n_in %d, in0 %d, out %d, ws %zu)\n", n_in, n_in > 0 ? in_sizes[0] : -1, out_size, ws_size); ok = -1; }
        if (hipFuncSetAttribute((const void*)mk_fwd, hipFuncAttributeMaxDynamicSharedMemorySize, LDS_BYTES) != hipSuccess) { fprintf(stderr, "kernel_launch: hipFuncSetAttribute failed\n"); ok = -1; }
    }
    if (ok < 0) return;
    Args a{};
    for (int i = 0; i < 17; ++i) a.in[i] = (const float*)d_in[i];
    a.out = (float*)d_out; a.ws = (unsigned char*)d_ws;
    for (int ph = 0; ph < 13; ++ph) {
        a.ph_lo = ph; a.ph_hi = ph + 1;
        hipLaunchKernelGGL(mk_fwd, dim3(512), dim3(NTHR), LDS_BYTES, stream, a);
    }
}
```

```cpp
#include <hip/hip_runtime.h>
#include <cstdio>
#include <cstdint>

#define LAS __attribute__((address_space(3)))
typedef _Float16 h16;
typedef _Float16 h16x8 __attribute__((ext_vector_type(8)));
typedef float f32x4 __attribute__((ext_vector_type(4)));
typedef unsigned u32x4 __attribute__((ext_vector_type(4)));

constexpr int NB = 8, S = 4096, T = NB * S, D = 1024;
constexpr int ZP = 3840;
constexpr int DFF = 2816, NUP = 2 * DFF;
constexpr int ZC_MQ = 0, ZC_MK = 256, ZC_MV = 512, ZC_MO = 1024, ZC_AQ = 1536, ZC_AK = 2048, ZC_AV = 2560, ZC_IQ = 3072, ZC_IK = 3584, ZC_G = 3648;
constexpr int TOPK = 256;
constexpr float EPS = 1e-6f;
constexpr int NTHR = 512;

constexpr size_t MiB = 1u << 20;
constexpr size_t WS_CTL = 0;
constexpr size_t WS_WIN = 2 * MiB;
constexpr size_t WS_WOUT = 10 * MiB;
constexpr size_t WS_WUP = 12 * MiB;
constexpr size_t WS_WDN = 23 * MiB;
constexpr size_t WS_GATES = 29 * MiB;
constexpr size_t WS_XN = 32 * MiB;
constexpr size_t WS_Z = 96 * MiB;
constexpr size_t WS_MIX = 336 * MiB;
constexpr size_t WS_KN = 400 * MiB;
constexpr size_t WS_BM = 404 * MiB;
constexpr size_t WS_Y = 96 * MiB;
constexpr size_t WS_ACT = 272 * MiB;
constexpr size_t WS_END = 448 * MiB;

struct Args { const float* in[17]; float* out; unsigned char* ws; int ph_lo, ph_hi; };

struct Frame {
    const float *x, *norm_mix, *w_in, *conv_w, *conv_b, *i_bias, *f_bias, *mlstm_norm, *idx_k_norm, *rel_bias, *w_out, *norm_ffn, *w_up, *ffn_conv_w, *ffn_conv_b, *w_down, *norm_final;
    float* out;
    h16 *WIN, *WOUT, *WUP, *WDN, *XN, *Z, *MIX, *KN, *Y, *ACT;
    float* GATES; unsigned* BM;
    int tid, lane, wave;
};

__device__ __forceinline__ float wave_sum(float v) {
#pragma unroll
    for (int o = 1; o < 64; o <<= 1) v += __shfl_xor(v, o);
    return v;
}
__device__ __forceinline__ float wave_max(float v) {
#pragma unroll
    for (int o = 1; o < 64; o <<= 1) v = fmaxf(v, __shfl_xor(v, o));
    return v;
}
__device__ __forceinline__ int wave_isum(int v) {
#pragma unroll
    for (int o = 1; o < 64; o <<= 1) v += __shfl_xor(v, o);
    return v;
}
__device__ __forceinline__ float sigmoidf_(float x) { return 1.f / (1.f + __expf(-x)); }

__device__ __forceinline__ int src_col_in(int n) { return n < 1536 ? n : n < 3648 ? n + 8 : n < 3656 ? n - 3648 + 1536 : n < 3664 ? n : -1; }
__device__ __forceinline__ int src_col_up(int n) { const int pn = n >> 8, r = n & 255; return (r >> 7) * DFF + pn * 128 + (r & 127); }

template <int MODE>
__device__ __forceinline__ void transpose_item(const float* W, int K, int N, h16* WT, int NOUT, LAS float* scr, int item, int lane) {
    const int nblk = NOUT / 32, kb = item / nblk, nb = item % nblk, k0 = 64 * kb, n0 = 32 * nb;
    const int n = n0 + (lane & 31);
    const int sc = MODE == 1 ? src_col_in(n) : MODE == 2 ? src_col_up(n) : n;
#pragma unroll 8
    for (int i = 0; i < 32; ++i) { const int kk = 2 * i + (lane >> 5); scr[kk * 33 + (lane & 31)] = sc >= 0 ? W[(size_t)(k0 + kk) * N + sc] : 0.f; }
    __builtin_amdgcn_s_waitcnt(0xc07f); __builtin_amdgcn_wave_barrier();
    const int c = lane & 7;
#pragma unroll
    for (int j = 0; j < 4; ++j) {
        const int nn = (lane >> 3) + 8 * j; const LAS float* s = scr + (8 * c) * 33 + nn;
        h16x8 o;
#pragma unroll
        for (int i = 0; i < 8; ++i) o[i] = (h16)s[i * 33];
        *(h16x8*)(WT + (size_t)(n0 + nn) * K + k0 + 8 * c) = o;
    }
    __builtin_amdgcn_s_waitcnt(0xc07f); __builtin_amdgcn_wave_barrier();
}

__device__ __forceinline__ void rms_row_to_h16(const float* xrow, const float* g, h16* orow, int lane) {
    f32x4 v[4]; float s = 0.f;
#pragma unroll
    for (int j = 0; j < 4; ++j) { v[j] = *(const f32x4*)(xrow + 4 * lane + 256 * j); s += (v[j].x * v[j].x + v[j].y * v[j].y) + (v[j].z * v[j].z + v[j].w * v[j].w); }
    const float r = 1.f / sqrtf(wave_sum(s) * (1.f / D) + EPS);
#pragma unroll
    for (int j = 0; j < 4; ++j) {
        const f32x4 gg = *(const f32x4*)(g + 4 * lane + 256 * j);
        typedef _Float16 h16x4 __attribute__((ext_vector_type(4)));
        h16x4 o; o[0] = (h16)(v[j].x * r * gg.x); o[1] = (h16)(v[j].y * r * gg.y); o[2] = (h16)(v[j].z * r * gg.z); o[3] = (h16)(v[j].w * r * gg.w);
        *(h16x4*)(orow + 4 * lane + 256 * j) = o;
    }
}

__device__ __forceinline__ void p0_prologue(const Frame& F, LAS unsigned char* lds) {
    LAS float* scr = (LAS float*)lds + F.wave * (64 * 33);
    const int gw = blockIdx.x * 8 + F.wave, NGW = gridDim.x * 8;
    constexpr int I_IN = 16 * (ZP / 32), I_OUT = 16 * (D / 32), I_UP = 16 * (NUP / 32), I_DN = (DFF / 64) * (D / 32);
    for (int it = gw; it < I_IN + I_OUT + I_UP + I_DN; it += NGW) {
        int r = it;
        if (r < I_IN) { transpose_item<1>(F.w_in, D, 3664, F.WIN, ZP, scr, r, F.lane); continue; } r -= I_IN;
        if (r < I_OUT) { transpose_item<0>(F.w_out, D, D, F.WOUT, D, scr, r, F.lane); continue; } r -= I_OUT;
        if (r < I_UP) { transpose_item<2>(F.w_up, D, NUP, F.WUP, NUP, scr, r, F.lane); continue; } r -= I_UP;
        transpose_item<0>(F.w_down, DFF, D, F.WDN, D, scr, r, F.lane);
    }
    for (int m = gw; m < T; m += NGW) rms_row_to_h16(F.x + (size_t)m * D, F.norm_mix, F.XN + (size_t)m * D, F.lane);
}

namespace pg8 {
#define PG8_LAS __attribute__((address_space(3)))
typedef unsigned short bf16_t;
typedef short bf16x8 __attribute__((ext_vector_type(8)));
typedef float f32x4 __attribute__((ext_vector_type(4)));
typedef unsigned u32x4 __attribute__((ext_vector_type(4)));
constexpr int BM = 256, BK = 64, HALF = 128, HTB = HALF * BK * 2  , STAGE_BYTES = 8 * HTB, NXCD = 8, WGM = 8;

__host__ __device__ __forceinline__ int lds_byte(int r, int c) { const int st = (r >> 4) * 2 + (c >> 5), rr = r & 15, cc = c & 31, ob = rr * 64 + cc * 2; return st * 1024 + (ob ^ (((ob >> 9) & 1) << 5)); }
__host__ __device__ __forceinline__ void stage_rc(int b, int& R, int& C) { const int st = b / 1024, sb = b % 1024, swz = sb ^ (((sb >> 9) & 1) << 5); R = (st >> 1) * 16 + swz / 64; C = (st & 1) * 32 + (swz % 64) / 2; }
__host__ __device__ __forceinline__ int perm32(int rho) { const int n = rho >> 4, i = rho & 15; return 8 * (i >> 2) + 4 * n + (i & 3); }

struct Unit { int pm, pn; };
struct Gemm { const bf16_t* A; const bf16_t* Bt; int M, N, K; };

struct StaticOrder {
    int nM, nN, nwg, G, c;
    __host__ __device__ void init(int M, int N, int G_, int c_) { nM = M / BM; nN = N / BM; nwg = nM * nN; G = G_; c = c_; }
    __host__ __device__ bool next(int i, Unit& u) const {
        const long L = (long)i * G + c; if (L >= nwg) return false;
        int wgid = (int)L; { const int q = nwg / NXCD, r = nwg % NXCD, xcd = wgid % NXCD, off = wgid / NXCD; wgid = (xcd < r ? xcd * (q + 1) : r * (q + 1) + (xcd - r) * q) + off; }
        const int nig = WGM * nN, gid = wgid / nig, fm = gid * WGM, gsz = (nM - fm) < WGM ? (nM - fm) : WGM;
        u.pm = fm + ((wgid % nig) % gsz); u.pn = (wgid % nig) / gsz; return true;
    }
    __device__ __forceinline__ void a_ready(const Unit&) const {}
    __device__ __forceinline__ void done(const Unit&) const {}
};

typedef _Float16 f16x8 __attribute__((ext_vector_type(8)));
struct EpiH16 {
    static constexpr bool PERM = true, AFTER_DRAIN = false;
    _Float16* O; int ldc; int row_off; float* G; int gc0;
    __device__ __forceinline__ void operator()(const f32x4 (&acc)[2][2][4][2], const Unit& u, int wr, int wc, int fr, int fq) const {
        const int row0 = row_off + u.pm * BM + wr * 64 + fr, col0 = u.pn * BM + wc * 32 + 8 * fq;
#pragma unroll
        for (int ai = 0; ai < 2; ++ai)
#pragma unroll
            for (int m = 0; m < 4; ++m) { const size_t r = (size_t)(row0 + ai * HALF + m * 16);
#pragma unroll
                for (int bj = 0; bj < 2; ++bj) { const int c = col0 + bj * HALF; const f32x4 v0 = acc[ai][bj][m][0], v1 = acc[ai][bj][m][1];
                    f16x8 o; o[0] = (_Float16)v0[0]; o[1] = (_Float16)v0[1]; o[2] = (_Float16)v0[2]; o[3] = (_Float16)v0[3]; o[4] = (_Float16)v1[0]; o[5] = (_Float16)v1[1]; o[6] = (_Float16)v1[2]; o[7] = (_Float16)v1[3];
                    *(f16x8*)(O + r * ldc + c) = o;
                    if (G && c >= gc0 && c < gc0 + 16) { *(f32x4*)(G + r * 16 + (c - gc0)) = v0; *(f32x4*)(G + r * 16 + (c - gc0) + 4) = v1; } } }
    }
};
struct EpiRes32 {
    static constexpr bool PERM = false, AFTER_DRAIN = false;
    const float* base; float* out; int ldc;
    __device__ __forceinline__ void operator()(const f32x4 (&acc)[2][2][4][2], const Unit& u, int wr, int wc, int fr, int fq) const {
        const int row0 = u.pm * BM + wr * 64 + fr, col0 = u.pn * BM + wc * 32 + 4 * fq;
#pragma unroll
        for (int ai = 0; ai < 2; ++ai)
#pragma unroll
            for (int m = 0; m < 4; ++m) { const size_t off = (size_t)(row0 + ai * HALF + m * 16) * ldc + col0;
#pragma unroll
                for (int bj = 0; bj < 2; ++bj)
#pragma unroll
                    for (int n = 0; n < 2; ++n) { const f32x4 b = *(const f32x4*)(base + off + bj * HALF + n * 16); *(f32x4*)(out + off + bj * HALF + n * 16) = b + acc[ai][bj][m][n]; } }
    }
};
template <class Epi, class Sched, bool ALIGN_EPI = false, bool SP2 = false>
__device__ __forceinline__ void gemm_phase(PG8_LAS unsigned char* lds, const Gemm g, const Sched& S, const Epi& E) {
    const int tid = threadIdx.x, wid = __builtin_amdgcn_readfirstlane(tid >> 6), lane = tid & 63, wr = wid >> 2, wc = wid & 3, fr = lane & 15, fq = lane >> 4;
    const int K = g.K, nt = K / BK;
    unsigned voffA[2], voffB[2];
#pragma unroll
    for (int i = 0; i < 2; ++i) { int R, C; stage_rc(tid * 16 + i * 8192, R, C); const int Rb = Epi::PERM ? ((R & ~31) + perm32(R & 31)) : R;
        voffA[i] = (unsigned)(R * K + C) * 2u; voffB[i] = (unsigned)(Rb * K + C) * 2u; }
    const size_t kstep = (size_t)(BK * 2);
    const size_t hstep = (size_t)HALF * K * 2;
    const size_t tstep = 2 * hstep;
    const unsigned ldsw = (unsigned)wid * 1024u;
    const int aoff = lds_byte(wr * 64 + fr, fq * 8), boff = lds_byte(wc * 32 + fr, fq * 8);
#define PG8_SA(b, h) (((b) * 2 + (h)) * HTB)
#define PG8_SB(b, h) ((4 + (b) * 2 + (h)) * HTB)
#define PG8_STAGE(bufoff, gbase, voff) do { _Pragma("unroll") for (int _i = 0; _i < 2; ++_i) \
        __builtin_amdgcn_global_load_lds((const unsigned*)((const char*)(gbase) + (voff)[_i]), (PG8_LAS unsigned*)(lds + (bufoff) + ldsw + _i * 8192), 16, 0, 0); } while (0)
#define PG8_LDA(dst, b, h) do { _Pragma("unroll") for (int m = 0; m < 4; ++m) _Pragma("unroll") for (int k = 0; k < 2; ++k) dst[m][k] = *(const PG8_LAS bf16x8*)(lds + PG8_SA(b, h) + aoff + m * 2048 + k * 1024); } while (0)
#define PG8_LDB(dst, b, h) do { _Pragma("unroll") for (int n = 0; n < 2; ++n) _Pragma("unroll") for (int k = 0; k < 2; ++k) dst[n][k] = *(const PG8_LAS bf16x8*)(lds + PG8_SB(b, h) + boff + n * 2048 + k * 1024); } while (0)
#define PG8_MMA(ai, bj, At, Bt) do { __builtin_amdgcn_s_setprio(1); _Pragma("unroll") for (int m = 0; m < 4; ++m) _Pragma("unroll") for (int n = 0; n < 2; ++n) _Pragma("unroll") for (int k = 0; k < 2; ++k) \
        acc[ai][bj][m][n] = __builtin_amdgcn_mfma_f32_16x16x32_f16(__builtin_bit_cast(f16x8, Bt[n][k]), __builtin_bit_cast(f16x8, At[m][k]), acc[ai][bj][m][n], 0, 0, 0); __builtin_amdgcn_s_setprio(0); } while (0)
#define PG8_WAIT_V(n) asm volatile("s_waitcnt vmcnt(" #n ")" ::: "memory")
#define PG8_WAIT_L(n) asm volatile("s_waitcnt lgkmcnt(" #n ")" ::: "memory")
#define PG8_BAR __builtin_amdgcn_s_barrier()
#define PG8_SCHED __builtin_amdgcn_sched_barrier(0)
    Unit cur, nxt; int ui = 0;
    if (!S.next(0, cur)) return;
    f32x4 acc[2][2][4][2];
#pragma unroll
    for (int a = 0; a < 2; ++a)
#pragma unroll
        for (int b = 0; b < 2; ++b)
#pragma unroll
            for (int m = 0; m < 4; ++m)
#pragma unroll
                for (int n = 0; n < 2; ++n) acc[a][b][m][n] = (f32x4){0.f, 0.f, 0.f, 0.f};
    bf16x8 At[4][2], B0[2][2], B1[2][2];
    const char* cA = (const char*)g.A + (size_t)cur.pm * tstep; const char* cB = (const char*)g.Bt + (size_t)cur.pn * tstep;
    S.a_ready(cur);
    if constexpr (SP2) {
        PG8_STAGE(PG8_SB(0, 0), cB, voffB); PG8_STAGE(PG8_SB(0, 1), cB + hstep, voffB); PG8_STAGE(PG8_SA(0, 0), cA, voffA); PG8_STAGE(PG8_SA(0, 1), cA + hstep, voffA);
        if (wr == 1) PG8_BAR;
        PG8_WAIT_V(2); PG8_BAR;
        PG8_STAGE(PG8_SB(1, 0), cB + kstep, voffB); PG8_STAGE(PG8_SA(1, 0), cA + kstep, voffA); PG8_STAGE(PG8_SB(1, 1), cB + hstep + kstep, voffB);
        PG8_WAIT_V(6); PG8_BAR;
    } else {
        PG8_STAGE(PG8_SB(0, 0), cB, voffB); PG8_STAGE(PG8_SA(0, 0), cA, voffA); PG8_STAGE(PG8_SB(0, 1), cB + hstep, voffB); PG8_STAGE(PG8_SA(0, 1), cA + hstep, voffA);
        if (wr == 1) PG8_BAR;
        PG8_WAIT_V(4); PG8_BAR;
        PG8_STAGE(PG8_SB(1, 0), cB + kstep, voffB); PG8_STAGE(PG8_SA(1, 0), cA + kstep, voffA); PG8_STAGE(PG8_SB(1, 1), cB + hstep + kstep, voffB);
        PG8_WAIT_V(6); PG8_BAR;
    }
    for (;;) {
        const bool has_next = S.next(ui + 1, nxt);
        const char* nA = has_next ? (const char*)g.A + (size_t)nxt.pm * tstep : cA; const char* nB = has_next ? (const char*)g.Bt + (size_t)nxt.pn * tstep : cB;
        for (int t = 0; t < nt; t += 2) {
            const bool last = (t == nt - 2);
            const char* a1 = cA + (size_t)(t + 1) * kstep;
            const char* a2 = last ? nA : cA + (size_t)(t + 2) * kstep; const char* b2 = last ? nB : cB + (size_t)(t + 2) * kstep;
            const char* a3 = a2 + kstep; const char* b3 = b2 + kstep;
            if (last && has_next) S.a_ready(nxt);
            if constexpr (SP2) {
            PG8_LDB(B0, 0, 0); PG8_LDB(B1, 0, 1); PG8_SCHED; PG8_LDA(At, 0, 0); PG8_STAGE(PG8_SA(1, 1), a1 + hstep, voffA);
            PG8_WAIT_V(8); PG8_WAIT_L(0); PG8_BAR; PG8_MMA(0, 0, At, B0); PG8_MMA(0, 1, At, B1); PG8_BAR; PG8_SCHED;
            PG8_LDA(At, 0, 1); PG8_STAGE(PG8_SB(0, 0), b2, voffB); PG8_STAGE(PG8_SB(0, 1), b2 + hstep, voffB); PG8_STAGE(PG8_SA(0, 0), a2, voffA);
            PG8_WAIT_V(8); PG8_WAIT_L(0); PG8_BAR; PG8_MMA(1, 0, At, B0); PG8_MMA(1, 1, At, B1); PG8_BAR; PG8_SCHED;
            PG8_LDB(B0, 1, 0); PG8_LDB(B1, 1, 1); PG8_SCHED; PG8_LDA(At, 1, 0); PG8_STAGE(PG8_SA(0, 1), a2 + hstep, voffA);
            PG8_WAIT_V(8); PG8_WAIT_L(0); PG8_BAR; PG8_MMA(0, 0, At, B0); PG8_MMA(0, 1, At, B1); PG8_BAR; PG8_SCHED;
            PG8_LDA(At, 1, 1); PG8_STAGE(PG8_SB(1, 0), b3, voffB); PG8_STAGE(PG8_SB(1, 1), b3 + hstep, voffB); PG8_STAGE(PG8_SA(1, 0), a3, voffA);
            PG8_WAIT_V(8); PG8_WAIT_L(0); PG8_BAR; PG8_MMA(1, 0, At, B0); PG8_MMA(1, 1, At, B1); PG8_BAR; PG8_SCHED;
            } else {
            PG8_LDB(B0, 0, 0); PG8_SCHED; PG8_LDA(At, 0, 0); PG8_STAGE(PG8_SA(1, 1), a1 + hstep, voffA);
            PG8_WAIT_L(8); PG8_BAR; PG8_WAIT_L(0); PG8_MMA(0, 0, At, B0); PG8_BAR; PG8_SCHED;
            PG8_LDB(B1, 0, 1); PG8_STAGE(PG8_SB(0, 0), b2, voffB);
            PG8_BAR; PG8_WAIT_L(0); PG8_MMA(0, 1, At, B1); PG8_BAR;
            PG8_LDA(At, 0, 1); PG8_STAGE(PG8_SA(0, 0), a2, voffA);
            PG8_BAR; PG8_WAIT_L(0); PG8_MMA(1, 0, At, B0); PG8_BAR; PG8_SCHED;
            PG8_STAGE(PG8_SB(0, 1), b2 + hstep, voffB);
            PG8_WAIT_V(6); PG8_BAR; PG8_MMA(1, 1, At, B1); PG8_BAR;
            PG8_LDB(B0, 1, 0); PG8_SCHED; PG8_LDA(At, 1, 0); PG8_STAGE(PG8_SA(0, 1), a2 + hstep, voffA);
            PG8_WAIT_L(8); PG8_BAR; PG8_WAIT_L(0); PG8_MMA(0, 0, At, B0); PG8_BAR; PG8_SCHED;
            PG8_LDB(B1, 1, 1); PG8_STAGE(PG8_SB(1, 0), b3, voffB);
            PG8_BAR; PG8_WAIT_L(0); PG8_MMA(0, 1, At, B1); PG8_BAR;
            PG8_LDA(At, 1, 1); PG8_STAGE(PG8_SA(1, 0), a3, voffA);
            PG8_BAR; PG8_WAIT_L(0); PG8_MMA(1, 0, At, B0); PG8_BAR; PG8_SCHED;
            PG8_STAGE(PG8_SB(1, 1), b3 + hstep, voffB);
            PG8_WAIT_V(6); PG8_BAR; PG8_MMA(1, 1, At, B1); PG8_BAR;
            }
        }
        if constexpr (ALIGN_EPI) { if (wr == 0) PG8_BAR; }
        if constexpr (!Epi::AFTER_DRAIN) { E(acc, cur, wr, wc, fr, fq); S.done(cur); }
        if (!has_next) break;
#pragma unroll
        for (int a = 0; a < 2; ++a)
#pragma unroll
            for (int b = 0; b < 2; ++b)
#pragma unroll
                for (int m = 0; m < 4; ++m)
#pragma unroll
                    for (int n = 0; n < 2; ++n) acc[a][b][m][n] = (f32x4){0.f, 0.f, 0.f, 0.f};
        cur = nxt; cA = nA; cB = nB; ++ui;
        if constexpr (ALIGN_EPI) { if (wr == 1) PG8_BAR; }
    }
    PG8_WAIT_V(0);
    if constexpr (!ALIGN_EPI) { if (wr == 0) PG8_BAR; }
    PG8_BAR;
    if constexpr (Epi::AFTER_DRAIN) { E.fused(acc, cur, wr, wc, fr, fq, lds, wid, lane); S.done(cur); }
#undef PG8_SA
#undef PG8_SB
#undef PG8_STAGE
#undef PG8_LDA
#undef PG8_LDB
#undef PG8_MMA
#undef PG8_WAIT_V
#undef PG8_WAIT_L
#undef PG8_BAR
#undef PG8_SCHED
}
}


#define XB_TMO      128
#define XB_XCNT(j)  (256  + 64 * (j))
#define XB_XSUB(j)  (1280 + 64 * (j))
#define XB_XGEN(j)  (2304 + 64 * (j))
#define XB_TOP      3328
#define XB_TOPGEN   3392
#define XCD_BAR_WORDS 3456
#define XB_SPIN_CAP (1u << 18)

__device__ __forceinline__ unsigned xb_ld(unsigned* p)              { return __hip_atomic_load(p, __ATOMIC_RELAXED, __HIP_MEMORY_SCOPE_AGENT); }
__device__ __forceinline__ unsigned xb_add(unsigned* p, unsigned v) { return __hip_atomic_fetch_add(p, v, __ATOMIC_RELAXED, __HIP_MEMORY_SCOPE_AGENT); }
__device__ __forceinline__ unsigned xb_xcc_id() { return (unsigned)__builtin_amdgcn_s_getreg((3 << 11) | 20) & 0xFu; }
#define XB_SPIN(cond, bar) do { unsigned _sp = 0; while (cond) { __builtin_amdgcn_s_sleep(1); \
    if ((++_sp & 255u) == 0u) { if (xb_ld(&(bar)[XB_TMO])) break; if (_sp > XB_SPIN_CAP) { atomicAdd(&(bar)[XB_TMO], 1u); break; } } } } while (0)

struct XcdBarrier {
    unsigned* bar; unsigned x;
    volatile LAS unsigned* st;
};

__device__ __forceinline__ XcdBarrier xcd_barrier_post(unsigned* bar, volatile LAS unsigned* st) {
    XcdBarrier b; b.bar = bar; b.x = xb_xcc_id(); b.st = st;
    if (threadIdx.x == 0) (void)xb_add(&bar[XB_XCNT(b.x)], 1u);
    return b;
}
__device__ __forceinline__ void xcd_barrier_complete(unsigned* bar, unsigned x, unsigned& nloc, unsigned& nx) {
    const unsigned G = gridDim.x * gridDim.y * gridDim.z;
    unsigned sum, cnt, mine, sp = 0u;
    for (;;) {
        sum = 0u; cnt = 0u; mine = 0u;
#pragma unroll
        for (unsigned j = 0; j < 16; ++j) { const unsigned c = xb_ld(&bar[XB_XCNT(j)]); sum += c; cnt += (c > 0u) ? 1u : 0u; mine = (j == x) ? c : mine; }
        if (sum == G) break;
        __builtin_amdgcn_s_sleep(1);
        if ((++sp & 255u) == 0u) { if (xb_ld(&bar[XB_TMO])) break; if (sp > XB_SPIN_CAP) { atomicAdd(&bar[XB_TMO], 1u); break; } }
    }
    nloc = mine > 0u ? mine : 1u; nx = cnt > 0u ? cnt : 1u;
}

__device__ __forceinline__ void xcd_barrier(const XcdBarrier& b) {
    asm volatile("s_waitcnt vmcnt(0)" ::: "memory");
    __syncthreads();
    if (threadIdx.x == 0) {
        unsigned* bar = b.bar;
        __builtin_amdgcn_s_waitcnt(0);
        unsigned nloc = b.st[0], nx = b.st[1];
        if (nloc == 0u) { xcd_barrier_complete(bar, b.x, nloc, nx); b.st[0] = nloc; b.st[1] = nx; }
        const unsigned old = xb_add(&bar[XB_XSUB(b.x)], 1u);
        const unsigned gen = old / nloc;
        if (old + 1u == (gen + 1u) * nloc) {
            __builtin_amdgcn_fence(__ATOMIC_RELEASE, "agent");
            asm volatile("s_waitcnt vmcnt(0)" ::: "memory");
            const unsigned og = xb_add(&bar[XB_TOP], 1u);
            const unsigned tg = og / nx;
            if (og + 1u == (tg + 1u) * nx) xb_add(&bar[XB_TOPGEN], 1u);
            else XB_SPIN(xb_ld(&bar[XB_TOPGEN]) == tg, bar);
            __builtin_amdgcn_fence(__ATOMIC_ACQUIRE, "agent");
            xb_add(&bar[XB_XGEN(b.x)], 1u);
            asm volatile("s_waitcnt vmcnt(0)" ::: "memory");
        } else {
            XB_SPIN(xb_ld(&bar[XB_XGEN(b.x)]) == gen, bar);
            __builtin_amdgcn_fence(__ATOMIC_ACQUIRE, "agent");
            asm volatile("s_waitcnt vmcnt(0)" ::: "memory");
        }
    }
    __syncthreads();
}

__device__ __forceinline__ void mlstm_naive(const Frame& F, LAS unsigned char* lds) {
    LAS float* qs = (LAS float*)lds; LAS float* ks = qs + 64; LAS float* part = ks + 64; LAS float* red = part + 512;
    const int tid = F.tid, e = tid & 127, qd = tid >> 7;
    for (int unit = blockIdx.x; unit < NB * 4; unit += gridDim.x) {
        const int b = unit >> 2, h = unit & 3;
        float C[16]; float n_d = 0.f, m = 0.f;
#pragma unroll
        for (int i = 0; i < 16; ++i) C[i] = 0.f;
        const float ib = F.i_bias[h], fb = F.f_bias[h];
        for (int t = 0; t < S; ++t) {
            const size_t row = (size_t)b * S + t;
            if (tid < 128) {
                const int cc = (tid < 64) ? (h * 64 + tid) : (256 + h * 64 + (tid - 64));
                float a = F.conv_b[cc];
#pragma unroll
                for (int j = 0; j < 4; ++j) { const int tt = t - 3 + j; if (tt >= 0) a += F.conv_w[j * 512 + cc] * (float)F.Z[(row - 3 + j) * ZP + cc]; }
                float v = a * sigmoidf_(a);
                if (tid < 64) qs[tid] = v * 0.125f; else ks[tid - 64] = v;
            }
            const float ig = F.GATES[row * 16 + h] + ib, fp = F.GATES[row * 16 + 4 + h] + fb;
            const float logf = fminf(fp, 0.f) - log1pf(__expf(-fabsf(fp)));
            const float m_new = fmaxf(logf + m, ig), fs = __expf(logf + m - m_new), is = __expf(ig - m_new); m = m_new;
            __syncthreads();
            const float ve = (float)F.Z[row * ZP + ZC_MV + h * 128 + e];
            float pn = 0.f;
#pragma unroll
            for (int i = 0; i < 16; ++i) { const int d = qd * 16 + i; C[i] = fs * C[i] + is * ks[d] * ve; pn += qs[d] * C[i]; }
            part[qd * 128 + e] = pn;
            if (tid < 64) { n_d = fs * n_d + is * ks[tid]; const float dn = wave_sum(qs[tid] * n_d); if (tid == 0) red[0] = dn; }
            __syncthreads();
            float hv = 0.f;
            if (tid < 128) {
                const float num = (part[e] + part[128 + e]) + (part[256 + e] + part[384 + e]), den = red[0];
                hv = num / fmaxf(fabsf(den), __expf(-m));
                const float sq = wave_sum(hv * hv); if (F.lane == 0) red[1 + F.wave] = sq;
            }
            __syncthreads();
            if (tid < 128) {
                const float r = 1.f / sqrtf((red[1] + red[2]) * (1.f / 128.f) + EPS);
                const float og = (float)F.Z[row * ZP + ZC_MO + h * 128 + e];
                F.MIX[row * D + h * 128 + e] = (h16)(hv * r * F.mlstm_norm[h * 128 + e] * sigmoidf_(og));
            }
        }
        __syncthreads();
    }
}

__device__ __forceinline__ void kn_phase(const Frame& F) {
    const int gw = blockIdx.x * 8 + F.wave, NGW = gridDim.x * 8;
    const float g = F.idx_k_norm[F.lane];
    for (int m = gw; m < T; m += NGW) {
        const float v = (float)F.Z[(size_t)m * ZP + ZC_IK + F.lane];
        const float r = 1.f / sqrtf(wave_sum(v * v) * (1.f / 64.f) + EPS);
        F.KN[(size_t)m * 64 + F.lane] = (h16)(v * r * g);
    }
}

__device__ __forceinline__ unsigned ord_key(float f) { const unsigned u = __float_as_uint(f); return (u & 0x80000000u) ? ~u : (u | 0x80000000u); }

__device__ __forceinline__ void index_naive(const Frame& F, LAS unsigned char* lds) {
    LAS float* qf = (LAS float*)lds;
    LAS float* wq = qf + 512;
    LAS unsigned* cnt = (LAS unsigned*)(wq + 8);
    LAS unsigned* keys = cnt + 40;
    const int tid = F.tid;
    for (int row = blockIdx.x; row < T; row += gridDim.x) {
        const int t = row & (S - 1), b = row >> 12;
        __syncthreads();
        qf[tid] = (float)F.Z[(size_t)row * ZP + ZC_IQ + tid];
        if (tid < 8) wq[tid] = F.GATES[(size_t)row * 16 + 8 + tid] * 0.35355339059327373f;
        if (tid < 40) cnt[tid] = 0u;
        __syncthreads();
        unsigned kk[8];
#pragma unroll
        for (int j = 0; j < 8; ++j) {
            const int s = tid + 512 * j; kk[j] = 0u;
            if (s <= t) {
                const h16* kr = F.KN + ((size_t)b * S + s) * 64;
                float kf[64];
#pragma unroll
                for (int c = 0; c < 8; ++c) { const h16x8 v = *(const h16x8*)(kr + 8 * c);
#pragma unroll
                    for (int i = 0; i < 8; ++i) kf[8 * c + i] = (float)v[i]; }
                float score = 0.f;
#pragma unroll
                for (int hh = 0; hh < 8; ++hh) { float dot = 0.f;
#pragma unroll
                    for (int d = 0; d < 64; ++d) dot += qf[hh * 64 + d] * kf[d];
                    score += fmaxf(dot * 0.125f, 0.f) * wq[hh]; }
                kk[j] = ord_key(score); keys[s] = kk[j];
            }
        }
        unsigned vstar = 0u;
        if (t >= TOPK) {
            unsigned prefix = 0u;
            for (int bit = 31; bit >= 0; --bit) {
                const unsigned cand = prefix | (1u << bit); int c = 0;
#pragma unroll
                for (int j = 0; j < 8; ++j) c += (kk[j] >= cand) ? 1 : 0;
                c = wave_isum(c); if (F.lane == 0) atomicAdd((unsigned*)&cnt[bit], (unsigned)c);
                __syncthreads();
                if (cnt[bit] >= (unsigned)TOPK) prefix = cand;
            }
            vstar = prefix;
            int cg = 0, ce = 0;
#pragma unroll
            for (int j = 0; j < 8; ++j) { cg += (kk[j] > vstar) ? 1 : 0; ce += (kk[j] == vstar) ? 1 : 0; }
            cg = wave_isum(cg); ce = wave_isum(ce);
            if (F.lane == 0) { atomicAdd((unsigned*)&cnt[32], (unsigned)cg); atomicAdd((unsigned*)&cnt[33], (unsigned)ce); }
            __syncthreads();
            const int need = TOPK - (int)cnt[32];
            if ((int)cnt[33] > need) {
                if (tid == 0) { int nd = need; for (int s = 0; s <= t; ++s) if (keys[s] == vstar) { if (nd > 0) --nd; else keys[s] = 0u; } }
            }
        }
        __syncthreads();
        if (tid < 128) {
            unsigned word = 0u;
            for (int i = 0; i < 32; ++i) { const int s = 32 * tid + i; if (s <= t && keys[s] >= vstar) word |= (1u << i); }
            F.BM[(size_t)row * 128 + tid] = word;
        }
    }
}

__device__ __forceinline__ void attn_naive(const Frame& F, LAS unsigned char* lds) {
    LAS float* qf = (LAS float*)lds;
    LAS float* p = qf + 512;
    LAS int* sel = (LAS int*)(p + 2048);
    LAS int* pcs = sel + 288;
    LAS float* btab = (LAS float*)(pcs + 128);
    LAS int* nselp = (LAS int*)(btab + 1024);
    const int tid = F.tid, hh = F.wave, lane = F.lane;
    for (int i = tid; i < 1024; i += NTHR) {
        const int dist = i >> 3, h = i & 7; int bk;
        if (dist < 16) bk = dist; else { bk = 16 + (int)(log((double)dist / 16.0) / log(8.0) * 16.0); if (bk > 31) bk = 31; }
        btab[i] = F.rel_bias[bk * 8 + h];
    }
    for (int row = blockIdx.x; row < T; row += gridDim.x) {
        const int t = row & (S - 1), b = row >> 12;
        __syncthreads();
        unsigned word = 0u;
        if (tid < 128) { word = F.BM[(size_t)row * 128 + tid]; pcs[tid] = __popc(word); }
        qf[tid] = (float)F.Z[(size_t)row * ZP + ZC_AQ + tid];
        __syncthreads();
        if (tid < 128) {
            int off = 0; for (int i = 0; i < tid; ++i) off += pcs[i];
            if (tid == 127) *nselp = off + pcs[127];
            while (word) { const int bpos = __ffs(word) - 1; word &= word - 1; if (off < 288) sel[off] = 32 * tid + bpos; ++off; }
        }
        __syncthreads();
        const int nsel = min(*nselp, 256);
        float lg[4]; float mx = -INFINITY;
#pragma unroll
        for (int jj = 0; jj < 4; ++jj) {
            const int j = lane + 64 * jj; lg[jj] = -INFINITY;
            if (j < nsel) {
                const int s = sel[j]; const h16* kr = F.Z + ((size_t)b * S + s) * ZP + ZC_AK + hh * 64;
                float dot = 0.f;
#pragma unroll
                for (int c = 0; c < 8; ++c) { const h16x8 v = *(const h16x8*)(kr + 8 * c);
#pragma unroll
                    for (int i = 0; i < 8; ++i) dot += qf[hh * 64 + 8 * c + i] * (float)v[i]; }
                const int dist = t - s;
                lg[jj] = dot * 0.125f + btab[(dist < 127 ? dist : 127) * 8 + hh];
                mx = fmaxf(mx, lg[jj]);
            }
        }
        mx = wave_max(mx);
        float sum = 0.f;
#pragma unroll
        for (int jj = 0; jj < 4; ++jj) { const int j = lane + 64 * jj; const float ev = (j < nsel) ? __expf(lg[jj] - mx) : 0.f; sum += ev; p[hh * 256 + j] = ev; }
        sum = wave_sum(sum);
        __syncthreads();
        float acc = 0.f;
        for (int j = 0; j < nsel; ++j) acc += p[hh * 256 + j] * (float)F.Z[((size_t)b * S + sel[j]) * ZP + ZC_AV + hh * 64 + lane];
        F.MIX[(size_t)row * D + 512 + hh * 64 + lane] = (h16)(acc / sum);
    }
}

__device__ __forceinline__ void h2_phase(const Frame& F) {
    const int gw = blockIdx.x * 8 + F.wave, NGW = gridDim.x * 8;
    for (int m = gw; m < T; m += NGW) rms_row_to_h16(F.out + (size_t)m * D, F.norm_ffn, F.XN + (size_t)m * D, F.lane);
}
__device__ __forceinline__ void act_phase(const Frame& F, int row_lo, int row_hi) {
    const size_t total = (size_t)(row_hi - row_lo) * DFF;
    for (size_t i = (size_t)blockIdx.x * NTHR + F.tid; i < total; i += (size_t)gridDim.x * NTHR) {
        const int r = (int)(i / DFF), c = (int)(i % DFF); const int row = row_lo + r, t = row & (S - 1);
        const int pc = 256 * (c >> 7) + (c & 127);
        float ug = F.ffn_conv_b[c], uv = F.ffn_conv_b[DFF + c];
#pragma unroll
        for (int j = 0; j < 3; ++j) { const int tt = t - 2 + j; if (tt >= 0) {
            const h16* yr = F.Y + (size_t)(r - 2 + j) * NUP + pc;
            ug += F.ffn_conv_w[j * NUP + c] * (float)yr[0]; uv += F.ffn_conv_w[j * NUP + DFF + c] * (float)yr[128]; } }
        F.ACT[(size_t)row * DFF + c] = (h16)(ug * sigmoidf_(ug) * uv);
    }
}
__device__ __forceinline__ void final_norm_phase(const Frame& F) {
    const int gw = blockIdx.x * 8 + F.wave, NGW = gridDim.x * 8;
    for (int m = gw; m < T; m += NGW) {
        float* xr = F.out + (size_t)m * D; f32x4 v[4]; float s = 0.f;
#pragma unroll
        for (int j = 0; j < 4; ++j) { v[j] = *(const f32x4*)(xr + 4 * F.lane + 256 * j); s += (v[j].x * v[j].x + v[j].y * v[j].y) + (v[j].z * v[j].z + v[j].w * v[j].w); }
        const float r = 1.f / sqrtf(wave_sum(s) * (1.f / D) + EPS);
#pragma unroll
        for (int j = 0; j < 4; ++j) { const f32x4 g = *(const f32x4*)(F.norm_final + 4 * F.lane + 256 * j); *(f32x4*)(xr + 4 * F.lane + 256 * j) = (f32x4){v[j].x * r * g.x, v[j].y * r * g.y, v[j].z * r * g.z, v[j].w * r * g.w}; }
    }
}


#ifndef MK_N_LAUNCHES
#define MK_N_LAUNCHES 1
#endif
constexpr int N_PHASES = 13;
constexpr int RING_BYTES = 131072, MISC_OFF = RING_BYTES + 320, LDS_BYTES = 147456;
constexpr int CW_BAR = 4096;
constexpr size_t CTL_ZERO_BYTES = 64 * 1024;
__global__ void __launch_bounds__(NTHR, 2) mk_fwd(Args a) {
    extern __shared__ __attribute__((aligned(16))) unsigned char lds_raw[];
    LAS unsigned char* lds = (LAS unsigned char*)lds_raw;
    Frame F;
    F.x = a.in[0]; F.norm_mix = a.in[1]; F.w_in = a.in[2]; F.conv_w = a.in[3]; F.conv_b = a.in[4]; F.i_bias = a.in[5]; F.f_bias = a.in[6]; F.mlstm_norm = a.in[7];
    F.idx_k_norm = a.in[8]; F.rel_bias = a.in[9]; F.w_out = a.in[10]; F.norm_ffn = a.in[11]; F.w_up = a.in[12]; F.ffn_conv_w = a.in[13]; F.ffn_conv_b = a.in[14];
    F.w_down = a.in[15]; F.norm_final = a.in[16]; F.out = a.out;
    unsigned char* ws = a.ws;
    F.WIN = (h16*)(ws + WS_WIN); F.WOUT = (h16*)(ws + WS_WOUT); F.WUP = (h16*)(ws + WS_WUP); F.WDN = (h16*)(ws + WS_WDN);
    F.GATES = (float*)(ws + WS_GATES); F.XN = (h16*)(ws + WS_XN); F.Z = (h16*)(ws + WS_Z); F.MIX = (h16*)(ws + WS_MIX); F.KN = (h16*)(ws + WS_KN);
    F.BM = (unsigned*)(ws + WS_BM); F.Y = (h16*)(ws + WS_Y); F.ACT = (h16*)(ws + WS_ACT);
    F.tid = threadIdx.x; F.lane = F.tid & 63; F.wave = __builtin_amdgcn_readfirstlane(F.tid >> 6);
    volatile LAS unsigned* MISC = (volatile LAS unsigned*)(lds + MISC_OFF);
    for (int u = F.tid; u < (LDS_BYTES - RING_BYTES) / 4; u += NTHR) ((LAS unsigned*)(lds + RING_BYTES))[u] = 0u;
    __syncthreads();
    XcdBarrier bar; bar.bar = (unsigned*)(ws + WS_CTL) + CW_BAR; bar.x = 0; bar.st = nullptr;
    if (MK_N_LAUNCHES == 1) bar = xcd_barrier_post((unsigned*)(ws + WS_CTL) + CW_BAR, MISC + 8);
    const int lo = a.ph_lo, hi = a.ph_hi, G = gridDim.x;
#define IN(k) (lo <= (k) && (k) < hi)
#define SEAM(k) do { if (IN(k) && IN((k) + 1)) xcd_barrier(bar); } while (0)
    if (IN(0)) p0_prologue(F, lds);
    SEAM(0);
    if (IN(1)) { pg8::Gemm g{(const pg8::bf16_t*)F.XN, (const pg8::bf16_t*)F.WIN, T, ZP, D}; pg8::StaticOrder So; So.init(T, ZP, G, (int)blockIdx.x);
        pg8::EpiH16 E{F.Z, ZP, 0, F.GATES, ZC_G}; pg8::gemm_phase<pg8::EpiH16, pg8::StaticOrder, true, true>(lds, g, So, E); }
    SEAM(1);
    if (IN(2)) { kn_phase(F); mlstm_naive(F, lds); }
    SEAM(2);
    if (IN(3)) index_naive(F, lds);
    SEAM(3);
    if (IN(4)) attn_naive(F, lds);
    SEAM(4);
    if (IN(5)) { pg8::Gemm g{(const pg8::bf16_t*)F.MIX, (const pg8::bf16_t*)F.WOUT, T, D, D}; pg8::StaticOrder So; So.init(T, D, G, (int)blockIdx.x);
        pg8::EpiRes32 E{F.x, F.out, D}; pg8::gemm_phase<pg8::EpiRes32, pg8::StaticOrder, true, true>(lds, g, So, E); }
    SEAM(5);
    if (IN(6)) h2_phase(F);
    SEAM(6);
    if (IN(7)) { pg8::Gemm g{(const pg8::bf16_t*)F.XN, (const pg8::bf16_t*)F.WUP, T / 2, NUP, D}; pg8::StaticOrder So; So.init(T / 2, NUP, G, (int)blockIdx.x);
        pg8::EpiH16 E{F.Y, NUP, 0, nullptr, 0}; pg8::gemm_phase<pg8::EpiH16, pg8::StaticOrder, true, true>(lds, g, So, E); }
    SEAM(7);
    if (IN(8)) act_phase(F, 0, T / 2);
    SEAM(8);
    if (IN(9)) { pg8::Gemm g{(const pg8::bf16_t*)(F.XN + (size_t)(T / 2) * D), (const pg8::bf16_t*)F.WUP, T / 2, NUP, D}; pg8::StaticOrder So; So.init(T / 2, NUP, G, (int)blockIdx.x);
        pg8::EpiH16 E{F.Y, NUP, 0, nullptr, 0}; pg8::gemm_phase<pg8::EpiH16, pg8::StaticOrder, true, true>(lds, g, So, E); }
    SEAM(9);
    if (IN(10)) act_phase(F, T / 2, T);
    SEAM(10);
    if (IN(11)) { pg8::Gemm g{(const pg8::bf16_t*)F.ACT, (const pg8::bf16_t*)F.WDN, T, D, DFF}; pg8::StaticOrder So; So.init(T, D, G, (int)blockIdx.x);
        pg8::EpiRes32 E{F.out, F.out, D}; pg8::gemm_phase<pg8::EpiRes32, pg8::StaticOrder, true, true>(lds, g, So, E); }
    SEAM(11);
    if (IN(12)) final_norm_phase(F);
#undef IN
#undef SEAM
}

extern "C" void kernel_launch(void* const* d_in, const int* in_sizes, int n_in, void* d_out, int out_size, void* d_ws, size_t ws_size, hipStream_t stream) {
    static int grid = 0;
    if (grid == 0) {
        if (n_in != 17 || in_sizes[0] != T * D || out_size != T * D || ws_size < WS_END) { fprintf(stderr, "kernel_launch: unexpected shapes (n_in %d, in0 %d, out %d, ws %zu)\n", n_in, n_in > 0 ? in_sizes[0] : -1, out_size, ws_size); grid = -1; return; }
        int dev = 0, cus = 0, per_cu = 0;
        if (hipGetDevice(&dev) != hipSuccess || hipDeviceGetAttribute(&cus, hipDeviceAttributeMultiprocessorCount, dev) != hipSuccess) { fprintf(stderr, "kernel_launch: device query failed\n"); grid = -1; return; }
        if (hipFuncSetAttribute((const void*)mk_fwd, hipFuncAttributeMaxDynamicSharedMemorySize, LDS_BYTES) != hipSuccess) { fprintf(stderr, "kernel_launch: hipFuncSetAttribute failed\n"); grid = -1; return; }
        if (hipOccupancyMaxActiveBlocksPerMultiprocessor(&per_cu, (const void*)mk_fwd, NTHR, LDS_BYTES) != hipSuccess || per_cu < 1) fprintf(stderr, "kernel_launch: note: occupancy query reports %d workgroups per CU\n", per_cu);
        (void)hipGetLastError();
        grid = cus;
    }
    if (grid < 0) return;
    if (hipMemsetAsync((char*)d_ws + WS_CTL, 0, CTL_ZERO_BYTES, stream) != hipSuccess) { fprintf(stderr, "kernel_launch: memset failed\n"); return; }
    Args a{};
    for (int i = 0; i < 17; ++i) a.in[i] = (const float*)d_in[i];
    a.out = (float*)d_out; a.ws = (unsigned char*)d_ws;
    if (MK_N_LAUNCHES == 1) { a.ph_lo = 0; a.ph_hi = N_PHASES; hipLaunchKernelGGL(mk_fwd, dim3(grid), dim3(NTHR), LDS_BYTES, stream, a); }
    else for (int ph = 0; ph < N_PHASES; ++ph) { a.ph_lo = ph; a.ph_hi = ph + 1; hipLaunchKernelGGL(mk_fwd, dim3(grid), dim3(NTHR), LDS_BYTES, stream, a); }
}
```

```cpp
#include <hip/hip_runtime.h>
#include <cstdio>
#include <cstdint>

#define LAS __attribute__((address_space(3)))
typedef _Float16 h16;
typedef _Float16 h16x8 __attribute__((ext_vector_type(8)));
typedef float f32x4 __attribute__((ext_vector_type(4)));
typedef unsigned u32x4 __attribute__((ext_vector_type(4)));

constexpr int NB = 8, S = 4096, T = NB * S, D = 1024;
constexpr int ZP = 3840;
constexpr int DFF = 2816, NUP = 2 * DFF;
constexpr int ZC_MQ = 0, ZC_MK = 256, ZC_MV = 512, ZC_MO = 1024, ZC_AQ = 1536, ZC_AK = 2048, ZC_AV = 2560, ZC_IQ = 3072, ZC_IK = 3584, ZC_G = 3648;
constexpr int TOPK = 256;
constexpr float EPS = 1e-6f;
constexpr int NTHR = 512;

constexpr size_t MiB = 1u << 20;
constexpr size_t WS_CTL = 0;
constexpr size_t WS_WIN = 2 * MiB;
constexpr size_t WS_WOUT = 10 * MiB;
constexpr size_t WS_WUP = 12 * MiB;
constexpr size_t WS_WDN = 23 * MiB;
constexpr size_t WS_GATES = 29 * MiB;
constexpr size_t WS_XN = 32 * MiB;
constexpr size_t WS_Z = 96 * MiB;
constexpr size_t WS_MIX = 336 * MiB;
constexpr size_t WS_KN = 400 * MiB;
constexpr size_t WS_BM = 404 * MiB;
constexpr size_t WS_Y = 96 * MiB;
constexpr size_t WS_ACT = 272 * MiB;
constexpr size_t WS_KVT = 420 * MiB;
constexpr size_t WS_KS = 484 * MiB;
constexpr size_t WS_GML = 485 * MiB;
constexpr size_t WS_END = 486 * MiB;

struct Args { const float* in[17]; float* out; unsigned char* ws; int ph_lo, ph_hi; };

struct Frame {
    const float *x, *norm_mix, *w_in, *conv_w, *conv_b, *i_bias, *f_bias, *mlstm_norm, *idx_k_norm, *rel_bias, *w_out, *norm_ffn, *w_up, *ffn_conv_w, *ffn_conv_b, *w_down, *norm_final;
    float* out;
    h16 *WIN, *WOUT, *WUP, *WDN, *XN, *Z, *MIX, *KN, *Y, *ACT;
    float* GATES; unsigned* BM;
    float *KVT, *KS, *G, *MLOC, *MPREV;
    int tid, lane, wave;
};

__device__ __forceinline__ float wave_sum(float v) {
#pragma unroll
    for (int o = 1; o < 64; o <<= 1) v += __shfl_xor(v, o);
    return v;
}
__device__ __forceinline__ float wave_max(float v) {
#pragma unroll
    for (int o = 1; o < 64; o <<= 1) v = fmaxf(v, __shfl_xor(v, o));
    return v;
}
__device__ __forceinline__ int wave_isum(int v) {
#pragma unroll
    for (int o = 1; o < 64; o <<= 1) v += __shfl_xor(v, o);
    return v;
}
__device__ __forceinline__ float sigmoidf_(float x) { return 1.f / (1.f + __expf(-x)); }

__device__ __forceinline__ int src_col_in(int n) { return n < 1536 ? n : n < 3648 ? n + 8 : n < 3656 ? n - 3648 + 1536 : n < 3664 ? n : -1; }
__device__ __forceinline__ int src_col_up(int n) { const int pn = n >> 8, r = n & 255; return (r >> 7) * DFF + pn * 128 + (r & 127); }

template <int MODE>
__device__ __forceinline__ void transpose_item(const float* W, int K, int N, h16* WT, int NOUT, LAS float* scr, int item, int lane) {
    const int nblk = NOUT / 32, kb = item / nblk, nb = item % nblk, k0 = 64 * kb, n0 = 32 * nb;
    const int n = n0 + (lane & 31);
    const int sc = MODE == 1 ? src_col_in(n) : MODE == 2 ? src_col_up(n) : n;
#pragma unroll 8
    for (int i = 0; i < 32; ++i) { const int kk = 2 * i + (lane >> 5); scr[kk * 33 + (lane & 31)] = sc >= 0 ? W[(size_t)(k0 + kk) * N + sc] : 0.f; }
    __builtin_amdgcn_s_waitcnt(0xc07f); __builtin_amdgcn_wave_barrier();
    const int c = lane & 7;
#pragma unroll
    for (int j = 0; j < 4; ++j) {
        const int nn = (lane >> 3) + 8 * j; const LAS float* s = scr + (8 * c) * 33 + nn;
        h16x8 o;
#pragma unroll
        for (int i = 0; i < 8; ++i) o[i] = (h16)s[i * 33];
        *(h16x8*)(WT + (size_t)(n0 + nn) * K + k0 + 8 * c) = o;
    }
    __builtin_amdgcn_s_waitcnt(0xc07f); __builtin_amdgcn_wave_barrier();
}

__device__ __forceinline__ void rms_row_to_h16(const float* xrow, const float* g, h16* orow, int lane) {
    f32x4 v[4]; float s = 0.f;
#pragma unroll
    for (int j = 0; j < 4; ++j) { v[j] = *(const f32x4*)(xrow + 4 * lane + 256 * j); s += (v[j].x * v[j].x + v[j].y * v[j].y) + (v[j].z * v[j].z + v[j].w * v[j].w); }
    const float r = 1.f / sqrtf(wave_sum(s) * (1.f / D) + EPS);
#pragma unroll
    for (int j = 0; j < 4; ++j) {
        const f32x4 gg = *(const f32x4*)(g + 4 * lane + 256 * j);
        typedef _Float16 h16x4 __attribute__((ext_vector_type(4)));
        h16x4 o; o[0] = (h16)(v[j].x * r * gg.x); o[1] = (h16)(v[j].y * r * gg.y); o[2] = (h16)(v[j].z * r * gg.z); o[3] = (h16)(v[j].w * r * gg.w);
        *(h16x4*)(orow + 4 * lane + 256 * j) = o;
    }
}

__device__ __forceinline__ void p0_prologue(const Frame& F, LAS unsigned char* lds) {
    LAS float* scr = (LAS float*)lds + F.wave * (64 * 33);
    const int gw = blockIdx.x * 8 + F.wave, NGW = gridDim.x * 8;
    constexpr int I_IN = 16 * (ZP / 32), I_OUT = 16 * (D / 32), I_UP = 16 * (NUP / 32), I_DN = (DFF / 64) * (D / 32);
    for (int it = gw; it < I_IN + I_OUT + I_UP + I_DN; it += NGW) {
        int r = it;
        if (r < I_IN) { transpose_item<1>(F.w_in, D, 3664, F.WIN, ZP, scr, r, F.lane); continue; } r -= I_IN;
        if (r < I_OUT) { transpose_item<0>(F.w_out, D, D, F.WOUT, D, scr, r, F.lane); continue; } r -= I_OUT;
        if (r < I_UP) { transpose_item<2>(F.w_up, D, NUP, F.WUP, NUP, scr, r, F.lane); continue; } r -= I_UP;
        transpose_item<0>(F.w_down, DFF, D, F.WDN, D, scr, r, F.lane);
    }
    for (int m = gw; m < T; m += NGW) rms_row_to_h16(F.x + (size_t)m * D, F.norm_mix, F.XN + (size_t)m * D, F.lane);
}

namespace pg8 {
#define PG8_LAS __attribute__((address_space(3)))
typedef unsigned short bf16_t;
typedef short bf16x8 __attribute__((ext_vector_type(8)));
typedef float f32x4 __attribute__((ext_vector_type(4)));
typedef unsigned u32x4 __attribute__((ext_vector_type(4)));
constexpr int BM = 256, BK = 64, HALF = 128, HTB = HALF * BK * 2  , STAGE_BYTES = 8 * HTB, NXCD = 8, WGM = 8;

__host__ __device__ __forceinline__ int lds_byte(int r, int c) { const int st = (r >> 4) * 2 + (c >> 5), rr = r & 15, cc = c & 31, ob = rr * 64 + cc * 2; return st * 1024 + (ob ^ (((ob >> 9) & 1) << 5)); }
__host__ __device__ __forceinline__ void stage_rc(int b, int& R, int& C) { const int st = b / 1024, sb = b % 1024, swz = sb ^ (((sb >> 9) & 1) << 5); R = (st >> 1) * 16 + swz / 64; C = (st & 1) * 32 + (swz % 64) / 2; }
__host__ __device__ __forceinline__ int perm32(int rho) { const int n = rho >> 4, i = rho & 15; return 8 * (i >> 2) + 4 * n + (i & 3); }

struct Unit { int pm, pn; };
struct Gemm { const bf16_t* A; const bf16_t* Bt; int M, N, K; };

struct StaticOrder {
    int nM, nN, nwg, G, c;
    __host__ __device__ void init(int M, int N, int G_, int c_) { nM = M / BM; nN = N / BM; nwg = nM * nN; G = G_; c = c_; }
    __host__ __device__ bool next(int i, Unit& u) const {
        const long L = (long)i * G + c; if (L >= nwg) return false;
        int wgid = (int)L; { const int q = nwg / NXCD, r = nwg % NXCD, xcd = wgid % NXCD, off = wgid / NXCD; wgid = (xcd < r ? xcd * (q + 1) : r * (q + 1) + (xcd - r) * q) + off; }
        const int nig = WGM * nN, gid = wgid / nig, fm = gid * WGM, gsz = (nM - fm) < WGM ? (nM - fm) : WGM;
        u.pm = fm + ((wgid % nig) % gsz); u.pn = (wgid % nig) / gsz; return true;
    }
    __device__ __forceinline__ void a_ready(const Unit&) const {}
    __device__ __forceinline__ void done(const Unit&) const {}
};

typedef _Float16 f16x8 __attribute__((ext_vector_type(8)));
struct EpiH16 {
    static constexpr bool PERM = true, AFTER_DRAIN = false;
    _Float16* O; int ldc; int row_off; float* G; int gc0;
    __device__ __forceinline__ void operator()(const f32x4 (&acc)[2][2][4][2], const Unit& u, int wr, int wc, int fr, int fq) const {
        const int row0 = row_off + u.pm * BM + wr * 64 + fr, col0 = u.pn * BM + wc * 32 + 8 * fq;
#pragma unroll
        for (int ai = 0; ai < 2; ++ai)
#pragma unroll
            for (int m = 0; m < 4; ++m) { const size_t r = (size_t)(row0 + ai * HALF + m * 16);
#pragma unroll
                for (int bj = 0; bj < 2; ++bj) { const int c = col0 + bj * HALF; const f32x4 v0 = acc[ai][bj][m][0], v1 = acc[ai][bj][m][1];
                    f16x8 o; o[0] = (_Float16)v0[0]; o[1] = (_Float16)v0[1]; o[2] = (_Float16)v0[2]; o[3] = (_Float16)v0[3]; o[4] = (_Float16)v1[0]; o[5] = (_Float16)v1[1]; o[6] = (_Float16)v1[2]; o[7] = (_Float16)v1[3];
                    *(f16x8*)(O + r * ldc + c) = o;
                    if (G && c >= gc0 && c < gc0 + 16) { *(f32x4*)(G + r * 16 + (c - gc0)) = v0; *(f32x4*)(G + r * 16 + (c - gc0) + 4) = v1; } } }
    }
};
struct EpiRes32 {
    static constexpr bool PERM = false, AFTER_DRAIN = false;
    const float* base; float* out; int ldc;
    __device__ __forceinline__ void operator()(const f32x4 (&acc)[2][2][4][2], const Unit& u, int wr, int wc, int fr, int fq) const {
        const int row0 = u.pm * BM + wr * 64 + fr, col0 = u.pn * BM + wc * 32 + 4 * fq;
#pragma unroll
        for (int ai = 0; ai < 2; ++ai)
#pragma unroll
            for (int m = 0; m < 4; ++m) { const size_t off = (size_t)(row0 + ai * HALF + m * 16) * ldc + col0;
#pragma unroll
                for (int bj = 0; bj < 2; ++bj)
#pragma unroll
                    for (int n = 0; n < 2; ++n) { const f32x4 b = *(const f32x4*)(base + off + bj * HALF + n * 16); *(f32x4*)(out + off + bj * HALF + n * 16) = b + acc[ai][bj][m][n]; } }
    }
};
template <class Epi, class Sched, bool ALIGN_EPI = false, bool SP2 = false>
__device__ __forceinline__ void gemm_phase(PG8_LAS unsigned char* lds, const Gemm g, const Sched& S, const Epi& E) {
    const int tid = threadIdx.x, wid = __builtin_amdgcn_readfirstlane(tid >> 6), lane = tid & 63, wr = wid >> 2, wc = wid & 3, fr = lane & 15, fq = lane >> 4;
    const int K = g.K, nt = K / BK;
    unsigned voffA[2], voffB[2];
#pragma unroll
    for (int i = 0; i < 2; ++i) { int R, C; stage_rc(tid * 16 + i * 8192, R, C); const int Rb = Epi::PERM ? ((R & ~31) + perm32(R & 31)) : R;
        voffA[i] = (unsigned)(R * K + C) * 2u; voffB[i] = (unsigned)(Rb * K + C) * 2u; }
    const size_t kstep = (size_t)(BK * 2);
    const size_t hstep = (size_t)HALF * K * 2;
    const size_t tstep = 2 * hstep;
    const unsigned ldsw = (unsigned)wid * 1024u;
    const int aoff = lds_byte(wr * 64 + fr, fq * 8), boff = lds_byte(wc * 32 + fr, fq * 8);
#define PG8_SA(b, h) (((b) * 2 + (h)) * HTB)
#define PG8_SB(b, h) ((4 + (b) * 2 + (h)) * HTB)
#define PG8_STAGE(bufoff, gbase, voff) do { _Pragma("unroll") for (int _i = 0; _i < 2; ++_i) \
        __builtin_amdgcn_global_load_lds((const unsigned*)((const char*)(gbase) + (voff)[_i]), (PG8_LAS unsigned*)(lds + (bufoff) + ldsw + _i * 8192), 16, 0, 0); } while (0)
#define PG8_LDA(dst, b, h) do { _Pragma("unroll") for (int m = 0; m < 4; ++m) _Pragma("unroll") for (int k = 0; k < 2; ++k) dst[m][k] = *(const PG8_LAS bf16x8*)(lds + PG8_SA(b, h) + aoff + m * 2048 + k * 1024); } while (0)
#define PG8_LDB(dst, b, h) do { _Pragma("unroll") for (int n = 0; n < 2; ++n) _Pragma("unroll") for (int k = 0; k < 2; ++k) dst[n][k] = *(const PG8_LAS bf16x8*)(lds + PG8_SB(b, h) + boff + n * 2048 + k * 1024); } while (0)
#define PG8_MMA(ai, bj, At, Bt) do { __builtin_amdgcn_s_setprio(1); _Pragma("unroll") for (int m = 0; m < 4; ++m) _Pragma("unroll") for (int n = 0; n < 2; ++n) _Pragma("unroll") for (int k = 0; k < 2; ++k) \
        acc[ai][bj][m][n] = __builtin_amdgcn_mfma_f32_16x16x32_f16(__builtin_bit_cast(f16x8, Bt[n][k]), __builtin_bit_cast(f16x8, At[m][k]), acc[ai][bj][m][n], 0, 0, 0); __builtin_amdgcn_s_setprio(0); } while (0)
#define PG8_WAIT_V(n) asm volatile("s_waitcnt vmcnt(" #n ")" ::: "memory")
#define PG8_WAIT_L(n) asm volatile("s_waitcnt lgkmcnt(" #n ")" ::: "memory")
#define PG8_BAR __builtin_amdgcn_s_barrier()
#define PG8_SCHED __builtin_amdgcn_sched_barrier(0)
    Unit cur, nxt; int ui = 0;
    if (!S.next(0, cur)) return;
    f32x4 acc[2][2][4][2];
#pragma unroll
    for (int a = 0; a < 2; ++a)
#pragma unroll
        for (int b = 0; b < 2; ++b)
#pragma unroll
            for (int m = 0; m < 4; ++m)
#pragma unroll
                for (int n = 0; n < 2; ++n) acc[a][b][m][n] = (f32x4){0.f, 0.f, 0.f, 0.f};
    bf16x8 At[4][2], B0[2][2], B1[2][2];
    const char* cA = (const char*)g.A + (size_t)cur.pm * tstep; const char* cB = (const char*)g.Bt + (size_t)cur.pn * tstep;
    S.a_ready(cur);
    if constexpr (SP2) {
        PG8_STAGE(PG8_SB(0, 0), cB, voffB); PG8_STAGE(PG8_SB(0, 1), cB + hstep, voffB); PG8_STAGE(PG8_SA(0, 0), cA, voffA); PG8_STAGE(PG8_SA(0, 1), cA + hstep, voffA);
        if (wr == 1) PG8_BAR;
        PG8_WAIT_V(2); PG8_BAR;
        PG8_STAGE(PG8_SB(1, 0), cB + kstep, voffB); PG8_STAGE(PG8_SA(1, 0), cA + kstep, voffA); PG8_STAGE(PG8_SB(1, 1), cB + hstep + kstep, voffB);
        PG8_WAIT_V(6); PG8_BAR;
    } else {
        PG8_STAGE(PG8_SB(0, 0), cB, voffB); PG8_STAGE(PG8_SA(0, 0), cA, voffA); PG8_STAGE(PG8_SB(0, 1), cB + hstep, voffB); PG8_STAGE(PG8_SA(0, 1), cA + hstep, voffA);
        if (wr == 1) PG8_BAR;
        PG8_WAIT_V(4); PG8_BAR;
        PG8_STAGE(PG8_SB(1, 0), cB + kstep, voffB); PG8_STAGE(PG8_SA(1, 0), cA + kstep, voffA); PG8_STAGE(PG8_SB(1, 1), cB + hstep + kstep, voffB);
        PG8_WAIT_V(6); PG8_BAR;
    }
    for (;;) {
        const bool has_next = S.next(ui + 1, nxt);
        const char* nA = has_next ? (const char*)g.A + (size_t)nxt.pm * tstep : cA; const char* nB = has_next ? (const char*)g.Bt + (size_t)nxt.pn * tstep : cB;
        for (int t = 0; t < nt; t += 2) {
            const bool last = (t == nt - 2);
            const char* a1 = cA + (size_t)(t + 1) * kstep;
            const char* a2 = last ? nA : cA + (size_t)(t + 2) * kstep; const char* b2 = last ? nB : cB + (size_t)(t + 2) * kstep;
            const char* a3 = a2 + kstep; const char* b3 = b2 + kstep;
            if (last && has_next) S.a_ready(nxt);
            if constexpr (SP2) {
            PG8_LDB(B0, 0, 0); PG8_LDB(B1, 0, 1); PG8_SCHED; PG8_LDA(At, 0, 0); PG8_STAGE(PG8_SA(1, 1), a1 + hstep, voffA);
            PG8_WAIT_V(8); PG8_WAIT_L(0); PG8_BAR; PG8_MMA(0, 0, At, B0); PG8_MMA(0, 1, At, B1); PG8_BAR; PG8_SCHED;
            PG8_LDA(At, 0, 1); PG8_STAGE(PG8_SB(0, 0), b2, voffB); PG8_STAGE(PG8_SB(0, 1), b2 + hstep, voffB); PG8_STAGE(PG8_SA(0, 0), a2, voffA);
            PG8_WAIT_V(8); PG8_WAIT_L(0); PG8_BAR; PG8_MMA(1, 0, At, B0); PG8_MMA(1, 1, At, B1); PG8_BAR; PG8_SCHED;
            PG8_LDB(B0, 1, 0); PG8_LDB(B1, 1, 1); PG8_SCHED; PG8_LDA(At, 1, 0); PG8_STAGE(PG8_SA(0, 1), a2 + hstep, voffA);
            PG8_WAIT_V(8); PG8_WAIT_L(0); PG8_BAR; PG8_MMA(0, 0, At, B0); PG8_MMA(0, 1, At, B1); PG8_BAR; PG8_SCHED;
            PG8_LDA(At, 1, 1); PG8_STAGE(PG8_SB(1, 0), b3, voffB); PG8_STAGE(PG8_SB(1, 1), b3 + hstep, voffB); PG8_STAGE(PG8_SA(1, 0), a3, voffA);
            PG8_WAIT_V(8); PG8_WAIT_L(0); PG8_BAR; PG8_MMA(1, 0, At, B0); PG8_MMA(1, 1, At, B1); PG8_BAR; PG8_SCHED;
            } else {
            PG8_LDB(B0, 0, 0); PG8_SCHED; PG8_LDA(At, 0, 0); PG8_STAGE(PG8_SA(1, 1), a1 + hstep, voffA);
            PG8_WAIT_L(8); PG8_BAR; PG8_WAIT_L(0); PG8_MMA(0, 0, At, B0); PG8_BAR; PG8_SCHED;
            PG8_LDB(B1, 0, 1); PG8_STAGE(PG8_SB(0, 0), b2, voffB);
            PG8_BAR; PG8_WAIT_L(0); PG8_MMA(0, 1, At, B1); PG8_BAR;
            PG8_LDA(At, 0, 1); PG8_STAGE(PG8_SA(0, 0), a2, voffA);
            PG8_BAR; PG8_WAIT_L(0); PG8_MMA(1, 0, At, B0); PG8_BAR; PG8_SCHED;
            PG8_STAGE(PG8_SB(0, 1), b2 + hstep, voffB);
            PG8_WAIT_V(6); PG8_BAR; PG8_MMA(1, 1, At, B1); PG8_BAR;
            PG8_LDB(B0, 1, 0); PG8_SCHED; PG8_LDA(At, 1, 0); PG8_STAGE(PG8_SA(0, 1), a2 + hstep, voffA);
            PG8_WAIT_L(8); PG8_BAR; PG8_WAIT_L(0); PG8_MMA(0, 0, At, B0); PG8_BAR; PG8_SCHED;
            PG8_LDB(B1, 1, 1); PG8_STAGE(PG8_SB(1, 0), b3, voffB);
            PG8_BAR; PG8_WAIT_L(0); PG8_MMA(0, 1, At, B1); PG8_BAR;
            PG8_LDA(At, 1, 1); PG8_STAGE(PG8_SA(1, 0), a3, voffA);
            PG8_BAR; PG8_WAIT_L(0); PG8_MMA(1, 0, At, B0); PG8_BAR; PG8_SCHED;
            PG8_STAGE(PG8_SB(1, 1), b3 + hstep, voffB);
            PG8_WAIT_V(6); PG8_BAR; PG8_MMA(1, 1, At, B1); PG8_BAR;
            }
        }
        if constexpr (ALIGN_EPI) { if (wr == 0) PG8_BAR; }
        if constexpr (!Epi::AFTER_DRAIN) { E(acc, cur, wr, wc, fr, fq); S.done(cur); }
        if (!has_next) break;
#pragma unroll
        for (int a = 0; a < 2; ++a)
#pragma unroll
            for (int b = 0; b < 2; ++b)
#pragma unroll
                for (int m = 0; m < 4; ++m)
#pragma unroll
                    for (int n = 0; n < 2; ++n) acc[a][b][m][n] = (f32x4){0.f, 0.f, 0.f, 0.f};
        cur = nxt; cA = nA; cB = nB; ++ui;
        if constexpr (ALIGN_EPI) { if (wr == 1) PG8_BAR; }
    }
    PG8_WAIT_V(0);
    if constexpr (!ALIGN_EPI) { if (wr == 0) PG8_BAR; }
    PG8_BAR;
    if constexpr (Epi::AFTER_DRAIN) { E.fused(acc, cur, wr, wc, fr, fq, lds, wid, lane); S.done(cur); }
#undef PG8_SA
#undef PG8_SB
#undef PG8_STAGE
#undef PG8_LDA
#undef PG8_LDB
#undef PG8_MMA
#undef PG8_WAIT_V
#undef PG8_WAIT_L
#undef PG8_BAR
#undef PG8_SCHED
}
}


#define XB_TMO      128
#define XB_XCNT(j)  (256  + 64 * (j))
#define XB_XSUB(j)  (1280 + 64 * (j))
#define XB_XGEN(j)  (2304 + 64 * (j))
#define XB_TOP      3328
#define XB_TOPGEN   3392
#define XCD_BAR_WORDS 3456
#define XB_SPIN_CAP (1u << 18)

__device__ __forceinline__ unsigned xb_ld(unsigned* p)              { return __hip_atomic_load(p, __ATOMIC_RELAXED, __HIP_MEMORY_SCOPE_AGENT); }
__device__ __forceinline__ unsigned xb_add(unsigned* p, unsigned v) { return __hip_atomic_fetch_add(p, v, __ATOMIC_RELAXED, __HIP_MEMORY_SCOPE_AGENT); }
__device__ __forceinline__ unsigned xb_xcc_id() { return (unsigned)__builtin_amdgcn_s_getreg((3 << 11) | 20) & 0xFu; }
#define XB_SPIN(cond, bar) do { unsigned _sp = 0; while (cond) { __builtin_amdgcn_s_sleep(1); \
    if ((++_sp & 255u) == 0u) { if (xb_ld(&(bar)[XB_TMO])) break; if (_sp > XB_SPIN_CAP) { atomicAdd(&(bar)[XB_TMO], 1u); break; } } } } while (0)

struct XcdBarrier {
    unsigned* bar; unsigned x;
    volatile LAS unsigned* st;
};

__device__ __forceinline__ XcdBarrier xcd_barrier_post(unsigned* bar, volatile LAS unsigned* st) {
    XcdBarrier b; b.bar = bar; b.x = xb_xcc_id(); b.st = st;
    if (threadIdx.x == 0) (void)xb_add(&bar[XB_XCNT(b.x)], 1u);
    return b;
}
__device__ __forceinline__ void xcd_barrier_complete(unsigned* bar, unsigned x, unsigned& nloc, unsigned& nx) {
    const unsigned G = gridDim.x * gridDim.y * gridDim.z;
    unsigned sum, cnt, mine, sp = 0u;
    for (;;) {
        sum = 0u; cnt = 0u; mine = 0u;
#pragma unroll
        for (unsigned j = 0; j < 16; ++j) { const unsigned c = xb_ld(&bar[XB_XCNT(j)]); sum += c; cnt += (c > 0u) ? 1u : 0u; mine = (j == x) ? c : mine; }
        if (sum == G) break;
        __builtin_amdgcn_s_sleep(1);
        if ((++sp & 255u) == 0u) { if (xb_ld(&bar[XB_TMO])) break; if (sp > XB_SPIN_CAP) { atomicAdd(&bar[XB_TMO], 1u); break; } }
    }
    nloc = mine > 0u ? mine : 1u; nx = cnt > 0u ? cnt : 1u;
}

__device__ __forceinline__ void xcd_barrier(const XcdBarrier& b) {
    asm volatile("s_waitcnt vmcnt(0)" ::: "memory");
    __syncthreads();
    if (threadIdx.x == 0) {
        unsigned* bar = b.bar;
        __builtin_amdgcn_s_waitcnt(0);
        unsigned nloc = b.st[0], nx = b.st[1];
        if (nloc == 0u) { xcd_barrier_complete(bar, b.x, nloc, nx); b.st[0] = nloc; b.st[1] = nx; }
        const unsigned old = xb_add(&bar[XB_XSUB(b.x)], 1u);
        const unsigned gen = old / nloc;
        if (old + 1u == (gen + 1u) * nloc) {
            __builtin_amdgcn_fence(__ATOMIC_RELEASE, "agent");
            asm volatile("s_waitcnt vmcnt(0)" ::: "memory");
            const unsigned og = xb_add(&bar[XB_TOP], 1u);
            const unsigned tg = og / nx;
            if (og + 1u == (tg + 1u) * nx) xb_add(&bar[XB_TOPGEN], 1u);
            else XB_SPIN(xb_ld(&bar[XB_TOPGEN]) == tg, bar);
            __builtin_amdgcn_fence(__ATOMIC_ACQUIRE, "agent");
            xb_add(&bar[XB_XGEN(b.x)], 1u);
            asm volatile("s_waitcnt vmcnt(0)" ::: "memory");
        } else {
            XB_SPIN(xb_ld(&bar[XB_XGEN(b.x)]) == gen, bar);
            __builtin_amdgcn_fence(__ATOMIC_ACQUIRE, "agent");
            asm volatile("s_waitcnt vmcnt(0)" ::: "memory");
        }
    }
    __syncthreads();
}

__device__ __forceinline__ void mlstm_naive(const Frame& F, LAS unsigned char* lds) {
    LAS float* qs = (LAS float*)lds; LAS float* ks = qs + 64; LAS float* part = ks + 64; LAS float* red = part + 512;
    const int tid = F.tid, e = tid & 127, qd = tid >> 7;
    for (int unit = blockIdx.x; unit < NB * 4; unit += gridDim.x) {
        const int b = unit >> 2, h = unit & 3;
        float C[16]; float n_d = 0.f, m = 0.f;
#pragma unroll
        for (int i = 0; i < 16; ++i) C[i] = 0.f;
        const float ib = F.i_bias[h], fb = F.f_bias[h];
        for (int t = 0; t < S; ++t) {
            const size_t row = (size_t)b * S + t;
            if (tid < 128) {
                const int cc = (tid < 64) ? (h * 64 + tid) : (256 + h * 64 + (tid - 64));
                float a = F.conv_b[cc];
#pragma unroll
                for (int j = 0; j < 4; ++j) { const int tt = t - 3 + j; if (tt >= 0) a += F.conv_w[j * 512 + cc] * (float)F.Z[(row - 3 + j) * ZP + cc]; }
                float v = a * sigmoidf_(a);
                if (tid < 64) qs[tid] = v * 0.125f; else ks[tid - 64] = v;
            }
            const float ig = F.GATES[row * 16 + h] + ib, fp = F.GATES[row * 16 + 4 + h] + fb;
            const float logf = fminf(fp, 0.f) - log1pf(__expf(-fabsf(fp)));
            const float m_new = fmaxf(logf + m, ig), fs = __expf(logf + m - m_new), is = __expf(ig - m_new); m = m_new;
            __syncthreads();
            const float ve = (float)F.Z[row * ZP + ZC_MV + h * 128 + e];
            float pn = 0.f;
#pragma unroll
            for (int i = 0; i < 16; ++i) { const int d = qd * 16 + i; C[i] = fs * C[i] + is * ks[d] * ve; pn += qs[d] * C[i]; }
            part[qd * 128 + e] = pn;
            if (tid < 64) { n_d = fs * n_d + is * ks[tid]; const float dn = wave_sum(qs[tid] * n_d); if (tid == 0) red[0] = dn; }
            __syncthreads();
            float hv = 0.f;
            if (tid < 128) {
                const float num = (part[e] + part[128 + e]) + (part[256 + e] + part[384 + e]), den = red[0];
                hv = num / fmaxf(fabsf(den), __expf(-m));
                const float sq = wave_sum(hv * hv); if (F.lane == 0) red[1 + F.wave] = sq;
            }
            __syncthreads();
            if (tid < 128) {
                const float r = 1.f / sqrtf((red[1] + red[2]) * (1.f / 128.f) + EPS);
                const float og = (float)F.Z[row * ZP + ZC_MO + h * 128 + e];
                F.MIX[row * D + h * 128 + e] = (h16)(hv * r * F.mlstm_norm[h * 128 + e] * sigmoidf_(og));
            }
        }
        __syncthreads();
    }
}

constexpr int LQ = 72;
constexpr int LW = 136;
typedef _Float16 h16x4 __attribute__((ext_vector_type(4)));

__device__ __forceinline__ void conv_silu8(const Frame& F, size_t row, int t, int cb, float (&o)[8]) {
#pragma unroll
    for (int i = 0; i < 8; ++i) o[i] = F.conv_b[cb + i];
#pragma unroll
    for (int j = 0; j < 4; ++j) {
        if (t - 3 + j >= 0) {
            const h16x8 z = *(const h16x8*)(F.Z + (row - 3 + j) * ZP + cb);
#pragma unroll
            for (int i = 0; i < 8; ++i) o[i] += F.conv_w[j * 512 + cb + i] * (float)z[i];
        }
    }
#pragma unroll
    for (int i = 0; i < 8; ++i) o[i] = o[i] * sigmoidf_(o[i]);
}
__device__ __forceinline__ float wave_scan_add(float x, int lane) {
#pragma unroll
    for (int o = 1; o < 64; o <<= 1) { const float v = __shfl_up(x, o); if (lane >= o) x += v; }
    return x;
}
__device__ __forceinline__ float wave_scan_max(float x, int lane) {
#pragma unroll
    for (int o = 1; o < 64; o <<= 1) { const float v = __shfl_up(x, o); if (lane >= o) x = fmaxf(x, v); }
    return x;
}

__device__ __forceinline__ void mlstm_A(const Frame& F, LAS unsigned char* lds) {
    LAS h16* KT = (LAS h16*)lds;
    LAS h16* VT = KT + 64 * LQ;
    LAS float* wg = (LAS float*)(VT + 128 * LQ);
    const int tid = F.tid, lane = F.lane, w = F.wave, fr = lane & 15, fq = lane >> 4;
    for (int u = blockIdx.x; u < NB * 4 * 64; u += gridDim.x) {
        const int c = u & 63, h = (u >> 6) & 3, b = u >> 8; const size_t row0 = (size_t)b * S + c * 64;
        if (w == 0) {
            const float ig = F.GATES[(row0 + lane) * 16 + h] + F.i_bias[h], fp = F.GATES[(row0 + lane) * 16 + 4 + h] + F.f_bias[h];
            const float logf = fminf(fp, 0.f) - log1pf(__expf(-fabsf(fp)));
            const float bl = wave_scan_add(logf, lane), g = __shfl(bl, 63);
            const float a = g - bl + ig, ml = wave_max(a);
            wg[lane] = __expf(a - ml);
            if (lane == 0) { F.G[u] = g; F.MLOC[u] = ml; }
        }
        __syncthreads();
        { const int l = tid >> 3, c8 = (tid & 7) * 8; float o[8]; conv_silu8(F, row0 + l, c * 64 + l, ZC_MK + h * 64 + c8, o);
#pragma unroll
          for (int i = 0; i < 8; ++i) KT[(c8 + i) * LQ + l] = (h16)o[i]; }
#pragma unroll
        for (int j = 0; j < 2; ++j) { const int id = tid + 512 * j, l = id >> 4, e8 = (id & 15) * 8; const float wl = wg[l];
            const h16x8 v = *(const h16x8*)(F.Z + (row0 + l) * ZP + ZC_MV + h * 128 + e8);
#pragma unroll
            for (int i = 0; i < 8; ++i) VT[(e8 + i) * LQ + l] = (h16)((float)v[i] * wl); }
        __syncthreads();
        f32x4 acc[4];
#pragma unroll
        for (int db = 0; db < 4; ++db) acc[db] = (f32x4){0.f, 0.f, 0.f, 0.f};
#pragma unroll
        for (int ks = 0; ks < 2; ++ks) {
            const h16x8 a = *(const LAS h16x8*)(VT + (16 * w + fr) * LQ + 32 * ks + 8 * fq);
#pragma unroll
            for (int db = 0; db < 4; ++db) { const h16x8 bb = *(const LAS h16x8*)(KT + (16 * db + fr) * LQ + 32 * ks + 8 * fq);
                acc[db] = __builtin_amdgcn_mfma_f32_16x16x32_f16(a, bb, acc[db], 0, 0, 0); }
        }
        float* kvt = F.KVT + (size_t)u * 8192;
#pragma unroll
        for (int db = 0; db < 4; ++db)
#pragma unroll
            for (int i = 0; i < 4; ++i) kvt[(16 * w + 4 * fq + i) * 64 + 16 * db + fr] = acc[db][i];
        if (tid < 64) { float s = 0.f; for (int l = 0; l < 64; ++l) s += wg[l] * (float)KT[tid * LQ + l]; F.KS[(size_t)u * 64 + tid] = s; }
        __syncthreads();
    }
}

__device__ __forceinline__ void mlstm_B(const Frame& F) {
    typedef float f32x2 __attribute__((ext_vector_type(2)));
    const int tid = F.tid;
    for (int slot = blockIdx.x; slot < 256; slot += gridDim.x) {
        const int bh = slot >> 3, part = slot & 7; const int idx = part * 1024 + tid * 2;
        float* base = F.KVT + (size_t)bh * 64 * 8192 + idx;
        const bool do_n = (part == 0 && tid < 64);
        f32x2 st = (f32x2){0.f, 0.f}; float nst = 0.f, m = 0.f;
        for (int c0 = 0; c0 < 64; c0 += 8) {
            f32x2 kv[8]; float ksv[8];
#pragma unroll
            for (int j = 0; j < 8; ++j) { kv[j] = *(const f32x2*)(base + (size_t)(c0 + j) * 8192); ksv[j] = do_n ? F.KS[(size_t)(bh * 64 + c0 + j) * 64 + tid] : 0.f; }
#pragma unroll
            for (int j = 0; j < 8; ++j) {
                const int u = bh * 64 + c0 + j; const float g = F.G[u], ml = F.MLOC[u];
                *(f32x2*)(base + (size_t)(c0 + j) * 8192) = st;
                if (do_n) F.KS[(size_t)u * 64 + tid] = nst;
                if (part == 0 && tid == 0) F.MPREV[u] = m;
                const float mn = fmaxf(g + m, ml), dec = __expf(g + m - mn), sc = __expf(ml - mn);
                st = dec * st + sc * kv[j]; nst = dec * nst + sc * ksv[j]; m = mn;
            }
        }
    }
}

__device__ __forceinline__ void mlstm_C(const Frame& F, LAS unsigned char* lds) {
    LAS h16* Qs = (LAS h16*)lds;
    LAS h16* Ks = Qs + 64 * LQ;
    LAS h16* QS = Ks + 64 * LQ;
    LAS h16* BT = QS + 64 * LW;
    LAS float* fa = (LAS float*)(BT + 128 * LW);
    LAS float *ul = fa, *wl = fa + 64, *iw = fa + 128, *emt = fa + 192, *den = fa + 256, *nb = fa + 320, *rowsq = fa + 384;
    const int tid = F.tid, lane = F.lane, w = F.wave, fr = lane & 15, fq = lane >> 4;
    for (int u = blockIdx.x; u < NB * 4 * 64; u += gridDim.x) {
        const int c = u & 63, h = (u >> 6) & 3, b = u >> 8; const size_t row0 = (size_t)b * S + c * 64;
        if (w == 0) {
            const float ig = F.GATES[(row0 + lane) * 16 + h] + F.i_bias[h], fp = F.GATES[(row0 + lane) * 16 + 4 + h] + F.f_bias[h];
            const float logf = fminf(fp, 0.f) - log1pf(__expf(-fabsf(fp)));
            const float bl = wave_scan_add(logf, lane), ww = ig - bl, pm = wave_scan_max(ww, lane);
            const float il = bl + F.MPREV[u], mt = fmaxf(il, bl + pm);
            ul[lane] = bl - mt; wl[lane] = ww; iw[lane] = __expf(il - mt); emt[lane] = __expf(-mt);
        }
        if (tid < 64) nb[tid] = F.KS[(size_t)u * 64 + tid];
        { const int l = tid >> 3, c8 = (tid & 7) * 8; float o[8];
          conv_silu8(F, row0 + l, c * 64 + l, ZC_MQ + h * 64 + c8, o);
          h16x8 hv;
#pragma unroll
          for (int i = 0; i < 8; ++i) hv[i] = (h16)(o[i] * 0.125f);
          *(LAS h16x8*)(Qs + l * LQ + c8) = hv;
          conv_silu8(F, row0 + l, c * 64 + l, ZC_MK + h * 64 + c8, o);
#pragma unroll
          for (int i = 0; i < 8; ++i) hv[i] = (h16)o[i];
          *(LAS h16x8*)(Ks + l * LQ + c8) = hv; }
#pragma unroll
        for (int j = 0; j < 2; ++j) { const int id = tid + 512 * j;
            { const int l = id >> 4, e8 = (id & 15) * 8; const h16x8 v = *(const h16x8*)(F.Z + (row0 + l) * ZP + ZC_MV + h * 128 + e8);
#pragma unroll
              for (int i = 0; i < 8; ++i) BT[(e8 + i) * LW + 64 + l] = v[i]; }
            { const int e = id >> 3, d8 = (id & 7) * 8; const float* cp = F.KVT + (size_t)u * 8192 + e * 64 + d8; const f32x4 c0 = *(const f32x4*)cp, c1 = *(const f32x4*)(cp + 4);
              h16x8 hv; hv[0] = (h16)c0[0]; hv[1] = (h16)c0[1]; hv[2] = (h16)c0[2]; hv[3] = (h16)c0[3]; hv[4] = (h16)c1[0]; hv[5] = (h16)c1[1]; hv[6] = (h16)c1[2]; hv[7] = (h16)c1[3];
              *(LAS h16x8*)(BT + e * LW + d8) = hv; } }
        __syncthreads();
        { const int l = tid >> 3, c8 = (tid & 7) * 8; const h16x8 q = *(const LAS h16x8*)(Qs + l * LQ + c8); const float s = iw[l]; h16x8 hv;
#pragma unroll
          for (int i = 0; i < 8; ++i) hv[i] = (h16)((float)q[i] * s);
          *(LAS h16x8*)(QS + l * LW + c8) = hv; }
#pragma unroll
        for (int tt = 0; tt < 2; ++tt) {
            const int lb = w & 3, sb = 2 * (w >> 2) + tt;
            f32x4 acc = (f32x4){0.f, 0.f, 0.f, 0.f};
            if (sb <= lb) {
#pragma unroll
                for (int ks = 0; ks < 2; ++ks) { const h16x8 a = *(const LAS h16x8*)(Qs + (16 * lb + fr) * LQ + 32 * ks + 8 * fq), bb = *(const LAS h16x8*)(Ks + (16 * sb + fr) * LQ + 32 * ks + 8 * fq);
                    acc = __builtin_amdgcn_mfma_f32_16x16x32_f16(a, bb, acc, 0, 0, 0); }
            }
            const int s = 16 * sb + fr; const float ws = wl[s];
#pragma unroll
            for (int i = 0; i < 4; ++i) { const int l = 16 * lb + 4 * fq + i; const float v = (s <= l) ? acc[i] * __expf(ul[l] + ws) : 0.f; QS[l * LW + 64 + s] = (h16)v; }
        }
        __syncthreads();
        { const int l = tid >> 3, part = tid & 7; float s = 0.f;
#pragma unroll
          for (int j = 0; j < 2; ++j) { const h16x8 q = *(const LAS h16x8*)(QS + l * LW + 16 * part + 8 * j);
#pragma unroll
              for (int i = 0; i < 8; ++i) { const int k = 16 * part + 8 * j + i; s += (float)q[i] * (k < 64 ? nb[k] : 1.f); } }
          s += __shfl_xor(s, 1); s += __shfl_xor(s, 2); s += __shfl_xor(s, 4);
          if (part == 0) den[l] = s; }
        f32x4 acc[4];
#pragma unroll
        for (int lb = 0; lb < 4; ++lb) acc[lb] = (f32x4){0.f, 0.f, 0.f, 0.f};
#pragma unroll
        for (int ks = 0; ks < 4; ++ks) { const h16x8 bb = *(const LAS h16x8*)(BT + (16 * w + fr) * LW + 32 * ks + 8 * fq);
#pragma unroll
            for (int lb = 0; lb < 4; ++lb) { const h16x8 a = *(const LAS h16x8*)(QS + (16 * lb + fr) * LW + 32 * ks + 8 * fq);
                acc[lb] = __builtin_amdgcn_mfma_f32_16x16x32_f16(a, bb, acc[lb], 0, 0, 0); } }
        __syncthreads();
#pragma unroll
        for (int lb = 0; lb < 4; ++lb)
#pragma unroll
            for (int i = 0; i < 4; ++i) { const int l = 16 * lb + 4 * fq + i; const float hv = acc[lb][i] / fmaxf(fabsf(den[l]), emt[l]); acc[lb][i] = hv;
                float sq = hv * hv; sq += __shfl_xor(sq, 1); sq += __shfl_xor(sq, 2); sq += __shfl_xor(sq, 4); sq += __shfl_xor(sq, 8);
                if (fr == 0) rowsq[w * 64 + l] = sq; }
        __syncthreads();
        const int e = 16 * w + fr; const float gn = F.mlstm_norm[h * 128 + e];
#pragma unroll
        for (int lb = 0; lb < 4; ++lb)
#pragma unroll
            for (int i = 0; i < 4; ++i) { const int l = 16 * lb + 4 * fq + i; float tot = 0.f;
#pragma unroll
                for (int ww = 0; ww < 8; ++ww) tot += rowsq[ww * 64 + l];
                const float r = 1.f / sqrtf(tot * (1.f / 128.f) + EPS);
                const float og = (float)F.Z[(row0 + l) * ZP + ZC_MO + h * 128 + e];
                F.MIX[(row0 + l) * D + h * 128 + e] = (h16)(acc[lb][i] * r * gn * sigmoidf_(og)); }
        __syncthreads();
    }
}

__device__ __forceinline__ void kn_phase(const Frame& F) {
    const int gw = blockIdx.x * 8 + F.wave, NGW = gridDim.x * 8;
    const float g = F.idx_k_norm[F.lane];
    for (int m = gw; m < T; m += NGW) {
        const float v = (float)F.Z[(size_t)m * ZP + ZC_IK + F.lane];
        const float r = 1.f / sqrtf(wave_sum(v * v) * (1.f / 64.f) + EPS);
        F.KN[(size_t)m * 64 + F.lane] = (h16)(v * r * g);
    }
}

__device__ __forceinline__ unsigned ord_key(float f) { const unsigned u = __float_as_uint(f); return (u & 0x80000000u) ? ~u : (u | 0x80000000u); }

__device__ __forceinline__ void index_naive(const Frame& F, LAS unsigned char* lds) {
    LAS float* qf = (LAS float*)lds;
    LAS float* wq = qf + 512;
    LAS unsigned* cnt = (LAS unsigned*)(wq + 8);
    LAS unsigned* keys = cnt + 40;
    const int tid = F.tid;
    for (int row = blockIdx.x; row < T; row += gridDim.x) {
        const int t = row & (S - 1), b = row >> 12;
        __syncthreads();
        qf[tid] = (float)F.Z[(size_t)row * ZP + ZC_IQ + tid];
        if (tid < 8) wq[tid] = F.GATES[(size_t)row * 16 + 8 + tid] * 0.35355339059327373f;
        if (tid < 40) cnt[tid] = 0u;
        __syncthreads();
        unsigned kk[8];
#pragma unroll
        for (int j = 0; j < 8; ++j) {
            const int s = tid + 512 * j; kk[j] = 0u;
            if (s <= t) {
                const h16* kr = F.KN + ((size_t)b * S + s) * 64;
                float kf[64];
#pragma unroll
                for (int c = 0; c < 8; ++c) { const h16x8 v = *(const h16x8*)(kr + 8 * c);
#pragma unroll
                    for (int i = 0; i < 8; ++i) kf[8 * c + i] = (float)v[i]; }
                float score = 0.f;
#pragma unroll
                for (int hh = 0; hh < 8; ++hh) { float dot = 0.f;
#pragma unroll
                    for (int d = 0; d < 64; ++d) dot += qf[hh * 64 + d] * kf[d];
                    score += fmaxf(dot * 0.125f, 0.f) * wq[hh]; }
                kk[j] = ord_key(score); keys[s] = kk[j];
            }
        }
        unsigned vstar = 0u;
        if (t >= TOPK) {
            unsigned prefix = 0u;
            for (int bit = 31; bit >= 0; --bit) {
                const unsigned cand = prefix | (1u << bit); int c = 0;
#pragma unroll
                for (int j = 0; j < 8; ++j) c += (kk[j] >= cand) ? 1 : 0;
                c = wave_isum(c); if (F.lane == 0) atomicAdd((unsigned*)&cnt[bit], (unsigned)c);
                __syncthreads();
                if (cnt[bit] >= (unsigned)TOPK) prefix = cand;
            }
            vstar = prefix;
            int cg = 0, ce = 0;
#pragma unroll
            for (int j = 0; j < 8; ++j) { cg += (kk[j] > vstar) ? 1 : 0; ce += (kk[j] == vstar) ? 1 : 0; }
            cg = wave_isum(cg); ce = wave_isum(ce);
            if (F.lane == 0) { atomicAdd((unsigned*)&cnt[32], (unsigned)cg); atomicAdd((unsigned*)&cnt[33], (unsigned)ce); }
            __syncthreads();
            const int need = TOPK - (int)cnt[32];
            if ((int)cnt[33] > need) {
                if (tid == 0) { int nd = need; for (int s = 0; s <= t; ++s) if (keys[s] == vstar) { if (nd > 0) --nd; else keys[s] = 0u; } }
            }
        }
        __syncthreads();
        if (tid < 128) {
            unsigned word = 0u;
            for (int i = 0; i < 32; ++i) { const int s = 32 * tid + i; if (s <= t && keys[s] >= vstar) word |= (1u << i); }
            F.BM[(size_t)row * 128 + tid] = word;
        }
    }
}

__device__ __forceinline__ void attn_naive(const Frame& F, LAS unsigned char* lds) {
    LAS float* qf = (LAS float*)lds;
    LAS float* p = qf + 512;
    LAS int* sel = (LAS int*)(p + 2048);
    LAS int* pcs = sel + 288;
    LAS float* btab = (LAS float*)(pcs + 128);
    LAS int* nselp = (LAS int*)(btab + 1024);
    const int tid = F.tid, hh = F.wave, lane = F.lane;
    for (int i = tid; i < 1024; i += NTHR) {
        const int dist = i >> 3, h = i & 7; int bk;
        if (dist < 16) bk = dist; else { bk = 16 + (int)(log((double)dist / 16.0) / log(8.0) * 16.0); if (bk > 31) bk = 31; }
        btab[i] = F.rel_bias[bk * 8 + h];
    }
    for (int row = blockIdx.x; row < T; row += gridDim.x) {
        const int t = row & (S - 1), b = row >> 12;
        __syncthreads();
        unsigned word = 0u;
        if (tid < 128) { word = F.BM[(size_t)row * 128 + tid]; pcs[tid] = __popc(word); }
        qf[tid] = (float)F.Z[(size_t)row * ZP + ZC_AQ + tid];
        __syncthreads();
        if (tid < 128) {
            int off = 0; for (int i = 0; i < tid; ++i) off += pcs[i];
            if (tid == 127) *nselp = off + pcs[127];
            while (word) { const int bpos = __ffs(word) - 1; word &= word - 1; if (off < 288) sel[off] = 32 * tid + bpos; ++off; }
        }
        __syncthreads();
        const int nsel = min(*nselp, 256);
        float lg[4]; float mx = -INFINITY;
#pragma unroll
        for (int jj = 0; jj < 4; ++jj) {
            const int j = lane + 64 * jj; lg[jj] = -INFINITY;
            if (j < nsel) {
                const int s = sel[j]; const h16* kr = F.Z + ((size_t)b * S + s) * ZP + ZC_AK + hh * 64;
                float dot = 0.f;
#pragma unroll
                for (int c = 0; c < 8; ++c) { const h16x8 v = *(const h16x8*)(kr + 8 * c);
#pragma unroll
                    for (int i = 0; i < 8; ++i) dot += qf[hh * 64 + 8 * c + i] * (float)v[i]; }
                const int dist = t - s;
                lg[jj] = dot * 0.125f + btab[(dist < 127 ? dist : 127) * 8 + hh];
                mx = fmaxf(mx, lg[jj]);
            }
        }
        mx = wave_max(mx);
        float sum = 0.f;
#pragma unroll
        for (int jj = 0; jj < 4; ++jj) { const int j = lane + 64 * jj; const float ev = (j < nsel) ? __expf(lg[jj] - mx) : 0.f; sum += ev; p[hh * 256 + j] = ev; }
        sum = wave_sum(sum);
        __syncthreads();
        float acc = 0.f;
        for (int j = 0; j < nsel; ++j) acc += p[hh * 256 + j] * (float)F.Z[((size_t)b * S + sel[j]) * ZP + ZC_AV + hh * 64 + lane];
        F.MIX[(size_t)row * D + 512 + hh * 64 + lane] = (h16)(acc / sum);
    }
}

__device__ __forceinline__ void h2_phase(const Frame& F) {
    const int gw = blockIdx.x * 8 + F.wave, NGW = gridDim.x * 8;
    for (int m = gw; m < T; m += NGW) rms_row_to_h16(F.out + (size_t)m * D, F.norm_ffn, F.XN + (size_t)m * D, F.lane);
}
__device__ __forceinline__ void act_phase(const Frame& F, int row_lo, int row_hi) {
    const size_t total = (size_t)(row_hi - row_lo) * DFF;
    for (size_t i = (size_t)blockIdx.x * NTHR + F.tid; i < total; i += (size_t)gridDim.x * NTHR) {
        const int r = (int)(i / DFF), c = (int)(i % DFF); const int row = row_lo + r, t = row & (S - 1);
        const int pc = 256 * (c >> 7) + (c & 127);
        float ug = F.ffn_conv_b[c], uv = F.ffn_conv_b[DFF + c];
#pragma unroll
        for (int j = 0; j < 3; ++j) { const int tt = t - 2 + j; if (tt >= 0) {
            const h16* yr = F.Y + (size_t)(r - 2 + j) * NUP + pc;
            ug += F.ffn_conv_w[j * NUP + c] * (float)yr[0]; uv += F.ffn_conv_w[j * NUP + DFF + c] * (float)yr[128]; } }
        F.ACT[(size_t)row * DFF + c] = (h16)(ug * sigmoidf_(ug) * uv);
    }
}
__device__ __forceinline__ void final_norm_phase(const Frame& F) {
    const int gw = blockIdx.x * 8 + F.wave, NGW = gridDim.x * 8;
    for (int m = gw; m < T; m += NGW) {
        float* xr = F.out + (size_t)m * D; f32x4 v[4]; float s = 0.f;
#pragma unroll
        for (int j = 0; j < 4; ++j) { v[j] = *(const f32x4*)(xr + 4 * F.lane + 256 * j); s += (v[j].x * v[j].x + v[j].y * v[j].y) + (v[j].z * v[j].z + v[j].w * v[j].w); }
        const float r = 1.f / sqrtf(wave_sum(s) * (1.f / D) + EPS);
#pragma unroll
        for (int j = 0; j < 4; ++j) { const f32x4 g = *(const f32x4*)(F.norm_final + 4 * F.lane + 256 * j); *(f32x4*)(xr + 4 * F.lane + 256 * j) = (f32x4){v[j].x * r * g.x, v[j].y * r * g.y, v[j].z * r * g.z, v[j].w * r * g.w}; }
    }
}


#ifndef MK_N_LAUNCHES
#define MK_N_LAUNCHES 1
#endif
constexpr int N_PHASES = 14;
constexpr int RING_BYTES = 131072, MISC_OFF = RING_BYTES + 320, LDS_BYTES = 147456;
constexpr int CW_BAR = 4096;
constexpr size_t CTL_ZERO_BYTES = 64 * 1024;
__global__ void __launch_bounds__(NTHR, 2) mk_fwd(Args a) {
    extern __shared__ __attribute__((aligned(16))) unsigned char lds_raw[];
    LAS unsigned char* lds = (LAS unsigned char*)lds_raw;
    Frame F;
    F.x = a.in[0]; F.norm_mix = a.in[1]; F.w_in = a.in[2]; F.conv_w = a.in[3]; F.conv_b = a.in[4]; F.i_bias = a.in[5]; F.f_bias = a.in[6]; F.mlstm_norm = a.in[7];
    F.idx_k_norm = a.in[8]; F.rel_bias = a.in[9]; F.w_out = a.in[10]; F.norm_ffn = a.in[11]; F.w_up = a.in[12]; F.ffn_conv_w = a.in[13]; F.ffn_conv_b = a.in[14];
    F.w_down = a.in[15]; F.norm_final = a.in[16]; F.out = a.out;
    unsigned char* ws = a.ws;
    F.WIN = (h16*)(ws + WS_WIN); F.WOUT = (h16*)(ws + WS_WOUT); F.WUP = (h16*)(ws + WS_WUP); F.WDN = (h16*)(ws + WS_WDN);
    F.GATES = (float*)(ws + WS_GATES); F.XN = (h16*)(ws + WS_XN); F.Z = (h16*)(ws + WS_Z); F.MIX = (h16*)(ws + WS_MIX); F.KN = (h16*)(ws + WS_KN);
    F.BM = (unsigned*)(ws + WS_BM); F.KVT = (float*)(ws + WS_KVT); F.KS = (float*)(ws + WS_KS); F.G = (float*)(ws + WS_GML); F.MLOC = F.G + 2048; F.MPREV = F.G + 4096; F.Y = (h16*)(ws + WS_Y); F.ACT = (h16*)(ws + WS_ACT);
    F.tid = threadIdx.x; F.lane = F.tid & 63; F.wave = __builtin_amdgcn_readfirstlane(F.tid >> 6);
    volatile LAS unsigned* MISC = (volatile LAS unsigned*)(lds + MISC_OFF);
    for (int u = F.tid; u < (LDS_BYTES - RING_BYTES) / 4; u += NTHR) ((LAS unsigned*)(lds + RING_BYTES))[u] = 0u;
    __syncthreads();
    XcdBarrier bar; bar.bar = (unsigned*)(ws + WS_CTL) + CW_BAR; bar.x = 0; bar.st = nullptr;
    if (MK_N_LAUNCHES == 1) bar = xcd_barrier_post((unsigned*)(ws + WS_CTL) + CW_BAR, MISC + 8);
    const int lo = a.ph_lo, hi = a.ph_hi, G = gridDim.x;
#define IN(k) (lo <= (k) && (k) < hi)
#define SEAM(k) do { if (IN(k) && IN((k) + 1)) xcd_barrier(bar); } while (0)
    if (IN(0)) p0_prologue(F, lds);
    SEAM(0);
    if (IN(1)) { pg8::Gemm g{(const pg8::bf16_t*)F.XN, (const pg8::bf16_t*)F.WIN, T, ZP, D}; pg8::StaticOrder So; So.init(T, ZP, G, (int)blockIdx.x);
        pg8::EpiH16 E{F.Z, ZP, 0, F.GATES, ZC_G}; pg8::gemm_phase<pg8::EpiH16, pg8::StaticOrder, true, true>(lds, g, So, E); }
    SEAM(1);
    if (IN(2)) { kn_phase(F); mlstm_A(F, lds); }
    SEAM(2);
    if (IN(3)) mlstm_B(F);
    SEAM(3);
    if (IN(4)) { mlstm_C(F, lds); index_naive(F, lds); }
    SEAM(4);
    if (IN(5)) attn_naive(F, lds);
    SEAM(5);
    if (IN(6)) { pg8::Gemm g{(const pg8::bf16_t*)F.MIX, (const pg8::bf16_t*)F.WOUT, T, D, D}; pg8::StaticOrder So; So.init(T, D, G, (int)blockIdx.x);
        pg8::EpiRes32 E{F.x, F.out, D}; pg8::gemm_phase<pg8::EpiRes32, pg8::StaticOrder, true, true>(lds, g, So, E); }
    SEAM(6);
    if (IN(7)) h2_phase(F);
    SEAM(7);
    if (IN(8)) { pg8::Gemm g{(const pg8::bf16_t*)F.XN, (const pg8::bf16_t*)F.WUP, T / 2, NUP, D}; pg8::StaticOrder So; So.init(T / 2, NUP, G, (int)blockIdx.x);
        pg8::EpiH16 E{F.Y, NUP, 0, nullptr, 0}; pg8::gemm_phase<pg8::EpiH16, pg8::StaticOrder, true, true>(lds, g, So, E); }
    SEAM(8);
    if (IN(9)) act_phase(F, 0, T / 2);
    SEAM(9);
    if (IN(10)) { pg8::Gemm g{(const pg8::bf16_t*)(F.XN + (size_t)(T / 2) * D), (const pg8::bf16_t*)F.WUP, T / 2, NUP, D}; pg8::StaticOrder So; So.init(T / 2, NUP, G, (int)blockIdx.x);
        pg8::EpiH16 E{F.Y, NUP, 0, nullptr, 0}; pg8::gemm_phase<pg8::EpiH16, pg8::StaticOrder, true, true>(lds, g, So, E); }
    SEAM(10);
    if (IN(11)) act_phase(F, T / 2, T);
    SEAM(11);
    if (IN(12)) { pg8::Gemm g{(const pg8::bf16_t*)F.ACT, (const pg8::bf16_t*)F.WDN, T, D, DFF}; pg8::StaticOrder So; So.init(T, D, G, (int)blockIdx.x);
        pg8::EpiRes32 E{F.out, F.out, D}; pg8::gemm_phase<pg8::EpiRes32, pg8::StaticOrder, true, true>(lds, g, So, E); }
    SEAM(12);
    if (IN(13)) final_norm_phase(F);
#undef IN
#undef SEAM
}

extern "C" void kernel_launch(void* const* d_in, const int* in_sizes, int n_in, void* d_out, int out_size, void* d_ws, size_t ws_size, hipStream_t stream) {
    static int grid = 0;
    if (grid == 0) {
        if (n_in != 17 || in_sizes[0] != T * D || out_size != T * D || ws_size < WS_END) { fprintf(stderr, "kernel_launch: unexpected shapes (n_in %d, in0 %d, out %d, ws %zu)\n", n_in, n_in > 0 ? in_sizes[0] : -1, out_size, ws_size); grid = -1; return; }
        int dev = 0, cus = 0, per_cu = 0;
        if (hipGetDevice(&dev) != hipSuccess || hipDeviceGetAttribute(&cus, hipDeviceAttributeMultiprocessorCount, dev) != hipSuccess) { fprintf(stderr, "kernel_launch: device query failed\n"); grid = -1; return; }
        if (hipFuncSetAttribute((const void*)mk_fwd, hipFuncAttributeMaxDynamicSharedMemorySize, LDS_BYTES) != hipSuccess) { fprintf(stderr, "kernel_launch: hipFuncSetAttribute failed\n"); grid = -1; return; }
        if (hipOccupancyMaxActiveBlocksPerMultiprocessor(&per_cu, (const void*)mk_fwd, NTHR, LDS_BYTES) != hipSuccess || per_cu < 1) fprintf(stderr, "kernel_launch: note: occupancy query reports %d workgroups per CU\n", per_cu);
        (void)hipGetLastError();
        grid = cus;
    }
    if (grid < 0) return;
    if (hipMemsetAsync((char*)d_ws + WS_CTL, 0, CTL_ZERO_BYTES, stream) != hipSuccess) { fprintf(stderr, "kernel_launch: memset failed\n"); return; }
    Args a{};
    for (int i = 0; i < 17; ++i) a.in[i] = (const float*)d_in[i];
    a.out = (float*)d_out; a.ws = (unsigned char*)d_ws;
    if (MK_N_LAUNCHES == 1) { a.ph_lo = 0; a.ph_hi = N_PHASES; hipLaunchKernelGGL(mk_fwd, dim3(grid), dim3(NTHR), LDS_BYTES, stream, a); }
    else for (int ph = 0; ph < N_PHASES; ++ph) { a.ph_lo = ph; a.ph_hi = ph + 1; hipLaunchKernelGGL(mk_fwd, dim3(grid), dim3(NTHR), LDS_BYTES, stream, a); }
}
```

```cpp
#include <hip/hip_runtime.h>
#include <cstdio>
#include <cstdint>

#define LAS __attribute__((address_space(3)))
typedef _Float16 h16;
typedef _Float16 h16x8 __attribute__((ext_vector_type(8)));
typedef float f32x4 __attribute__((ext_vector_type(4)));
typedef unsigned u32x4 __attribute__((ext_vector_type(4)));

constexpr int NB = 8, S = 4096, T = NB * S, D = 1024;
constexpr int ZP = 3840;
constexpr int DFF = 2816, NUP = 2 * DFF;
constexpr int ZC_MQ = 0, ZC_MK = 256, ZC_MV = 512, ZC_MO = 1024, ZC_AQ = 1536, ZC_AK = 2048, ZC_AV = 2560, ZC_IQ = 3072, ZC_IK = 3584, ZC_G = 3648;
constexpr int TOPK = 256;
constexpr float EPS = 1e-6f;
constexpr int NTHR = 512;

constexpr size_t MiB = 1u << 20;
constexpr size_t WS_CTL = 0;
constexpr size_t WS_WIN = 2 * MiB;
constexpr size_t WS_WOUT = 10 * MiB;
constexpr size_t WS_WUP = 12 * MiB;
constexpr size_t WS_WDN = 23 * MiB;
constexpr size_t WS_GATES = 29 * MiB;
constexpr size_t WS_XN = 32 * MiB;
constexpr size_t WS_Z = 96 * MiB;
constexpr size_t WS_MIX = 336 * MiB;
constexpr size_t WS_KN = 400 * MiB;
constexpr size_t WS_BM = 404 * MiB;
constexpr size_t WS_Y = 96 * MiB;
constexpr size_t WS_ACT = 272 * MiB;
constexpr size_t WS_KVT = 420 * MiB;
constexpr size_t WS_KS = 484 * MiB;
constexpr size_t WS_GML = 485 * MiB;
constexpr size_t WS_END = 486 * MiB;

struct Args { const float* in[17]; float* out; unsigned char* ws; int ph_lo, ph_hi; };

struct Frame {
    const float *x, *norm_mix, *w_in, *conv_w, *conv_b, *i_bias, *f_bias, *mlstm_norm, *idx_k_norm, *rel_bias, *w_out, *norm_ffn, *w_up, *ffn_conv_w, *ffn_conv_b, *w_down, *norm_final;
    float* out;
    h16 *WIN, *WOUT, *WUP, *WDN, *XN, *Z, *MIX, *KN, *Y, *ACT;
    float* GATES; unsigned* BM;
    float *KVT, *KS, *G, *MLOC, *MPREV;
    int tid, lane, wave;
};

__device__ __forceinline__ float wave_sum(float v) {
#pragma unroll
    for (int o = 1; o < 64; o <<= 1) v += __shfl_xor(v, o);
    return v;
}
__device__ __forceinline__ float wave_max(float v) {
#pragma unroll
    for (int o = 1; o < 64; o <<= 1) v = fmaxf(v, __shfl_xor(v, o));
    return v;
}
__device__ __forceinline__ int wave_isum(int v) {
#pragma unroll
    for (int o = 1; o < 64; o <<= 1) v += __shfl_xor(v, o);
    return v;
}
__device__ __forceinline__ float sigmoidf_(float x) { return 1.f / (1.f + __expf(-x)); }

__device__ __forceinline__ int src_col_in(int n) { return n < 1536 ? n : n < 3648 ? n + 8 : n < 3656 ? n - 3648 + 1536 : n < 3664 ? n : -1; }
__device__ __forceinline__ int src_col_up(int n) { const int pn = n >> 8, r = n & 255; return (r >> 7) * DFF + pn * 128 + (r & 127); }

template <int MODE>
__device__ __forceinline__ void transpose_item(const float* W, int K, int N, h16* WT, int NOUT, LAS float* scr, int item, int lane) {
    const int nblk = NOUT / 32, kb = item / nblk, nb = item % nblk, k0 = 64 * kb, n0 = 32 * nb;
    const int n = n0 + (lane & 31);
    const int sc = MODE == 1 ? src_col_in(n) : MODE == 2 ? src_col_up(n) : n;
#pragma unroll 8
    for (int i = 0; i < 32; ++i) { const int kk = 2 * i + (lane >> 5); scr[kk * 33 + (lane & 31)] = sc >= 0 ? W[(size_t)(k0 + kk) * N + sc] : 0.f; }
    __builtin_amdgcn_s_waitcnt(0xc07f); __builtin_amdgcn_wave_barrier();
    const int c = lane & 7;
#pragma unroll
    for (int j = 0; j < 4; ++j) {
        const int nn = (lane >> 3) + 8 * j; const LAS float* s = scr + (8 * c) * 33 + nn;
        h16x8 o;
#pragma unroll
        for (int i = 0; i < 8; ++i) o[i] = (h16)s[i * 33];
        *(h16x8*)(WT + (size_t)(n0 + nn) * K + k0 + 8 * c) = o;
    }
    __builtin_amdgcn_s_waitcnt(0xc07f); __builtin_amdgcn_wave_barrier();
}

__device__ __forceinline__ void rms_row_to_h16(const float* xrow, const float* g, h16* orow, int lane) {
    f32x4 v[4]; float s = 0.f;
#pragma unroll
    for (int j = 0; j < 4; ++j) { v[j] = *(const f32x4*)(xrow + 4 * lane + 256 * j); s += (v[j].x * v[j].x + v[j].y * v[j].y) + (v[j].z * v[j].z + v[j].w * v[j].w); }
    const float r = 1.f / sqrtf(wave_sum(s) * (1.f / D) + EPS);
#pragma unroll
    for (int j = 0; j < 4; ++j) {
        const f32x4 gg = *(const f32x4*)(g + 4 * lane + 256 * j);
        typedef _Float16 h16x4 __attribute__((ext_vector_type(4)));
        h16x4 o; o[0] = (h16)(v[j].x * r * gg.x); o[1] = (h16)(v[j].y * r * gg.y); o[2] = (h16)(v[j].z * r * gg.z); o[3] = (h16)(v[j].w * r * gg.w);
        *(h16x4*)(orow + 4 * lane + 256 * j) = o;
    }
}

__device__ __forceinline__ void p0_prologue(const Frame& F, LAS unsigned char* lds) {
    LAS float* scr = (LAS float*)lds + F.wave * (64 * 33);
    const int gw = blockIdx.x * 8 + F.wave, NGW = gridDim.x * 8;
    constexpr int I_IN = 16 * (ZP / 32), I_OUT = 16 * (D / 32), I_UP = 16 * (NUP / 32), I_DN = (DFF / 64) * (D / 32);
    for (int it = gw; it < I_IN + I_OUT + I_UP + I_DN; it += NGW) {
        int r = it;
        if (r < I_IN) { transpose_item<1>(F.w_in, D, 3664, F.WIN, ZP, scr, r, F.lane); continue; } r -= I_IN;
        if (r < I_OUT) { transpose_item<0>(F.w_out, D, D, F.WOUT, D, scr, r, F.lane); continue; } r -= I_OUT;
        if (r < I_UP) { transpose_item<2>(F.w_up, D, NUP, F.WUP, NUP, scr, r, F.lane); continue; } r -= I_UP;
        transpose_item<0>(F.w_down, DFF, D, F.WDN, D, scr, r, F.lane);
    }
    for (int m = gw; m < T; m += NGW) rms_row_to_h16(F.x + (size_t)m * D, F.norm_mix, F.XN + (size_t)m * D, F.lane);
}

namespace pg8 {
#define PG8_LAS __attribute__((address_space(3)))
typedef unsigned short bf16_t;
typedef short bf16x8 __attribute__((ext_vector_type(8)));
typedef float f32x4 __attribute__((ext_vector_type(4)));
typedef unsigned u32x4 __attribute__((ext_vector_type(4)));
constexpr int BM = 256, BK = 64, HALF = 128, HTB = HALF * BK * 2  , STAGE_BYTES = 8 * HTB, NXCD = 8, WGM = 8;

__host__ __device__ __forceinline__ int lds_byte(int r, int c) { const int st = (r >> 4) * 2 + (c >> 5), rr = r & 15, cc = c & 31, ob = rr * 64 + cc * 2; return st * 1024 + (ob ^ (((ob >> 9) & 1) << 5)); }
__host__ __device__ __forceinline__ void stage_rc(int b, int& R, int& C) { const int st = b / 1024, sb = b % 1024, swz = sb ^ (((sb >> 9) & 1) << 5); R = (st >> 1) * 16 + swz / 64; C = (st & 1) * 32 + (swz % 64) / 2; }
__host__ __device__ __forceinline__ int perm32(int rho) { const int n = rho >> 4, i = rho & 15; return 8 * (i >> 2) + 4 * n + (i & 3); }

struct Unit { int pm, pn; };
struct Gemm { const bf16_t* A; const bf16_t* Bt; int M, N, K; };

struct StaticOrder {
    int nM, nN, nwg, G, c;
    __host__ __device__ void init(int M, int N, int G_, int c_) { nM = M / BM; nN = N / BM; nwg = nM * nN; G = G_; c = c_; }
    __host__ __device__ bool next(int i, Unit& u) const {
        const long L = (long)i * G + c; if (L >= nwg) return false;
        int wgid = (int)L; { const int q = nwg / NXCD, r = nwg % NXCD, xcd = wgid % NXCD, off = wgid / NXCD; wgid = (xcd < r ? xcd * (q + 1) : r * (q + 1) + (xcd - r) * q) + off; }
        const int nig = WGM * nN, gid = wgid / nig, fm = gid * WGM, gsz = (nM - fm) < WGM ? (nM - fm) : WGM;
        u.pm = fm + ((wgid % nig) % gsz); u.pn = (wgid % nig) / gsz; return true;
    }
    __device__ __forceinline__ void a_ready(const Unit&) const {}
    __device__ __forceinline__ void done(const Unit&) const {}
};

typedef _Float16 f16x8 __attribute__((ext_vector_type(8)));
struct EpiH16 {
    static constexpr bool PERM = true, AFTER_DRAIN = false;
    _Float16* O; int ldc; int row_off; float* G; int gc0;
    __device__ __forceinline__ void operator()(const f32x4 (&acc)[2][2][4][2], const Unit& u, int wr, int wc, int fr, int fq) const {
        const int row0 = row_off + u.pm * BM + wr * 64 + fr, col0 = u.pn * BM + wc * 32 + 8 * fq;
#pragma unroll
        for (int ai = 0; ai < 2; ++ai)
#pragma unroll
            for (int m = 0; m < 4; ++m) { const size_t r = (size_t)(row0 + ai * HALF + m * 16);
#pragma unroll
                for (int bj = 0; bj < 2; ++bj) { const int c = col0 + bj * HALF; const f32x4 v0 = acc[ai][bj][m][0], v1 = acc[ai][bj][m][1];
                    f16x8 o; o[0] = (_Float16)v0[0]; o[1] = (_Float16)v0[1]; o[2] = (_Float16)v0[2]; o[3] = (_Float16)v0[3]; o[4] = (_Float16)v1[0]; o[5] = (_Float16)v1[1]; o[6] = (_Float16)v1[2]; o[7] = (_Float16)v1[3];
                    *(f16x8*)(O + r * ldc + c) = o;
                    if (G && c >= gc0 && c < gc0 + 16) { *(f32x4*)(G + r * 16 + (c - gc0)) = v0; *(f32x4*)(G + r * 16 + (c - gc0) + 4) = v1; } } }
    }
};
struct EpiRes32 {
    static constexpr bool PERM = false, AFTER_DRAIN = false;
    const float* base; float* out; int ldc;
    __device__ __forceinline__ void operator()(const f32x4 (&acc)[2][2][4][2], const Unit& u, int wr, int wc, int fr, int fq) const {
        const int row0 = u.pm * BM + wr * 64 + fr, col0 = u.pn * BM + wc * 32 + 4 * fq;
#pragma unroll
        for (int ai = 0; ai < 2; ++ai)
#pragma unroll
            for (int m = 0; m < 4; ++m) { const size_t off = (size_t)(row0 + ai * HALF + m * 16) * ldc + col0;
#pragma unroll
                for (int bj = 0; bj < 2; ++bj)
#pragma unroll
                    for (int n = 0; n < 2; ++n) { const f32x4 b = *(const f32x4*)(base + off + bj * HALF + n * 16); *(f32x4*)(out + off + bj * HALF + n * 16) = b + acc[ai][bj][m][n]; } }
    }
};
template <class Epi, class Sched, bool ALIGN_EPI = false, bool SP2 = false>
__device__ __forceinline__ void gemm_phase(PG8_LAS unsigned char* lds, const Gemm g, const Sched& S, const Epi& E) {
    const int tid = threadIdx.x, wid = __builtin_amdgcn_readfirstlane(tid >> 6), lane = tid & 63, wr = wid >> 2, wc = wid & 3, fr = lane & 15, fq = lane >> 4;
    const int K = g.K, nt = K / BK;
    unsigned voffA[2], voffB[2];
#pragma unroll
    for (int i = 0; i < 2; ++i) { int R, C; stage_rc(tid * 16 + i * 8192, R, C); const int Rb = Epi::PERM ? ((R & ~31) + perm32(R & 31)) : R;
        voffA[i] = (unsigned)(R * K + C) * 2u; voffB[i] = (unsigned)(Rb * K + C) * 2u; }
    const size_t kstep = (size_t)(BK * 2);
    const size_t hstep = (size_t)HALF * K * 2;
    const size_t tstep = 2 * hstep;
    const unsigned ldsw = (unsigned)wid * 1024u;
    const int aoff = lds_byte(wr * 64 + fr, fq * 8), boff = lds_byte(wc * 32 + fr, fq * 8);
#define PG8_SA(b, h) (((b) * 2 + (h)) * HTB)
#define PG8_SB(b, h) ((4 + (b) * 2 + (h)) * HTB)
#define PG8_STAGE(bufoff, gbase, voff) do { _Pragma("unroll") for (int _i = 0; _i < 2; ++_i) \
        __builtin_amdgcn_global_load_lds((const unsigned*)((const char*)(gbase) + (voff)[_i]), (PG8_LAS unsigned*)(lds + (bufoff) + ldsw + _i * 8192), 16, 0, 0); } while (0)
#define PG8_LDA(dst, b, h) do { _Pragma("unroll") for (int m = 0; m < 4; ++m) _Pragma("unroll") for (int k = 0; k < 2; ++k) dst[m][k] = *(const PG8_LAS bf16x8*)(lds + PG8_SA(b, h) + aoff + m * 2048 + k * 1024); } while (0)
#define PG8_LDB(dst, b, h) do { _Pragma("unroll") for (int n = 0; n < 2; ++n) _Pragma("unroll") for (int k = 0; k < 2; ++k) dst[n][k] = *(const PG8_LAS bf16x8*)(lds + PG8_SB(b, h) + boff + n * 2048 + k * 1024); } while (0)
#define PG8_MMA(ai, bj, At, Bt) do { __builtin_amdgcn_s_setprio(1); _Pragma("unroll") for (int m = 0; m < 4; ++m) _Pragma("unroll") for (int n = 0; n < 2; ++n) _Pragma("unroll") for (int k = 0; k < 2; ++k) \
        acc[ai][bj][m][n] = __builtin_amdgcn_mfma_f32_16x16x32_f16(__builtin_bit_cast(f16x8, Bt[n][k]), __builtin_bit_cast(f16x8, At[m][k]), acc[ai][bj][m][n], 0, 0, 0); __builtin_amdgcn_s_setprio(0); } while (0)
#define PG8_WAIT_V(n) asm volatile("s_waitcnt vmcnt(" #n ")" ::: "memory")
#define PG8_WAIT_L(n) asm volatile("s_waitcnt lgkmcnt(" #n ")" ::: "memory")
#define PG8_BAR __builtin_amdgcn_s_barrier()
#define PG8_SCHED __builtin_amdgcn_sched_barrier(0)
    Unit cur, nxt; int ui = 0;
    if (!S.next(0, cur)) return;
    f32x4 acc[2][2][4][2];
#pragma unroll
    for (int a = 0; a < 2; ++a)
#pragma unroll
        for (int b = 0; b < 2; ++b)
#pragma unroll
            for (int m = 0; m < 4; ++m)
#pragma unroll
                for (int n = 0; n < 2; ++n) acc[a][b][m][n] = (f32x4){0.f, 0.f, 0.f, 0.f};
    bf16x8 At[4][2], B0[2][2], B1[2][2];
    const char* cA = (const char*)g.A + (size_t)cur.pm * tstep; const char* cB = (const char*)g.Bt + (size_t)cur.pn * tstep;
    S.a_ready(cur);
    if constexpr (SP2) {
        PG8_STAGE(PG8_SB(0, 0), cB, voffB); PG8_STAGE(PG8_SB(0, 1), cB + hstep, voffB); PG8_STAGE(PG8_SA(0, 0), cA, voffA); PG8_STAGE(PG8_SA(0, 1), cA + hstep, voffA);
        if (wr == 1) PG8_BAR;
        PG8_WAIT_V(2); PG8_BAR;
        PG8_STAGE(PG8_SB(1, 0), cB + kstep, voffB); PG8_STAGE(PG8_SA(1, 0), cA + kstep, voffA); PG8_STAGE(PG8_SB(1, 1), cB + hstep + kstep, voffB);
        PG8_WAIT_V(6); PG8_BAR;
    } else {
        PG8_STAGE(PG8_SB(0, 0), cB, voffB); PG8_STAGE(PG8_SA(0, 0), cA, voffA); PG8_STAGE(PG8_SB(0, 1), cB + hstep, voffB); PG8_STAGE(PG8_SA(0, 1), cA + hstep, voffA);
        if (wr == 1) PG8_BAR;
        PG8_WAIT_V(4); PG8_BAR;
        PG8_STAGE(PG8_SB(1, 0), cB + kstep, voffB); PG8_STAGE(PG8_SA(1, 0), cA + kstep, voffA); PG8_STAGE(PG8_SB(1, 1), cB + hstep + kstep, voffB);
        PG8_WAIT_V(6); PG8_BAR;
    }
    for (;;) {
        const bool has_next = S.next(ui + 1, nxt);
        const char* nA = has_next ? (const char*)g.A + (size_t)nxt.pm * tstep : cA; const char* nB = has_next ? (const char*)g.Bt + (size_t)nxt.pn * tstep : cB;
        for (int t = 0; t < nt; t += 2) {
            const bool last = (t == nt - 2);
            const char* a1 = cA + (size_t)(t + 1) * kstep;
            const char* a2 = last ? nA : cA + (size_t)(t + 2) * kstep; const char* b2 = last ? nB : cB + (size_t)(t + 2) * kstep;
            const char* a3 = a2 + kstep; const char* b3 = b2 + kstep;
            if (last && has_next) S.a_ready(nxt);
            if constexpr (SP2) {
            PG8_LDB(B0, 0, 0); PG8_LDB(B1, 0, 1); PG8_SCHED; PG8_LDA(At, 0, 0); PG8_STAGE(PG8_SA(1, 1), a1 + hstep, voffA);
            PG8_WAIT_V(8); PG8_WAIT_L(0); PG8_BAR; PG8_MMA(0, 0, At, B0); PG8_MMA(0, 1, At, B1); PG8_BAR; PG8_SCHED;
            PG8_LDA(At, 0, 1); PG8_STAGE(PG8_SB(0, 0), b2, voffB); PG8_STAGE(PG8_SB(0, 1), b2 + hstep, voffB); PG8_STAGE(PG8_SA(0, 0), a2, voffA);
            PG8_WAIT_V(8); PG8_WAIT_L(0); PG8_BAR; PG8_MMA(1, 0, At, B0); PG8_MMA(1, 1, At, B1); PG8_BAR; PG8_SCHED;
            PG8_LDB(B0, 1, 0); PG8_LDB(B1, 1, 1); PG8_SCHED; PG8_LDA(At, 1, 0); PG8_STAGE(PG8_SA(0, 1), a2 + hstep, voffA);
            PG8_WAIT_V(8); PG8_WAIT_L(0); PG8_BAR; PG8_MMA(0, 0, At, B0); PG8_MMA(0, 1, At, B1); PG8_BAR; PG8_SCHED;
            PG8_LDA(At, 1, 1); PG8_STAGE(PG8_SB(1, 0), b3, voffB); PG8_STAGE(PG8_SB(1, 1), b3 + hstep, voffB); PG8_STAGE(PG8_SA(1, 0), a3, voffA);
            PG8_WAIT_V(8); PG8_WAIT_L(0); PG8_BAR; PG8_MMA(1, 0, At, B0); PG8_MMA(1, 1, At, B1); PG8_BAR; PG8_SCHED;
            } else {
            PG8_LDB(B0, 0, 0); PG8_SCHED; PG8_LDA(At, 0, 0); PG8_STAGE(PG8_SA(1, 1), a1 + hstep, voffA);
            PG8_WAIT_L(8); PG8_BAR; PG8_WAIT_L(0); PG8_MMA(0, 0, At, B0); PG8_BAR; PG8_SCHED;
            PG8_LDB(B1, 0, 1); PG8_STAGE(PG8_SB(0, 0), b2, voffB);
            PG8_BAR; PG8_WAIT_L(0); PG8_MMA(0, 1, At, B1); PG8_BAR;
            PG8_LDA(At, 0, 1); PG8_STAGE(PG8_SA(0, 0), a2, voffA);
            PG8_BAR; PG8_WAIT_L(0); PG8_MMA(1, 0, At, B0); PG8_BAR; PG8_SCHED;
            PG8_STAGE(PG8_SB(0, 1), b2 + hstep, voffB);
            PG8_WAIT_V(6); PG8_BAR; PG8_MMA(1, 1, At, B1); PG8_BAR;
            PG8_LDB(B0, 1, 0); PG8_SCHED; PG8_LDA(At, 1, 0); PG8_STAGE(PG8_SA(0, 1), a2 + hstep, voffA);
            PG8_WAIT_L(8); PG8_BAR; PG8_WAIT_L(0); PG8_MMA(0, 0, At, B0); PG8_BAR; PG8_SCHED;
            PG8_LDB(B1, 1, 1); PG8_STAGE(PG8_SB(1, 0), b3, voffB);
            PG8_BAR; PG8_WAIT_L(0); PG8_MMA(0, 1, At, B1); PG8_BAR;
            PG8_LDA(At, 1, 1); PG8_STAGE(PG8_SA(1, 0), a3, voffA);
            PG8_BAR; PG8_WAIT_L(0); PG8_MMA(1, 0, At, B0); PG8_BAR; PG8_SCHED;
            PG8_STAGE(PG8_SB(1, 1), b3 + hstep, voffB);
            PG8_WAIT_V(6); PG8_BAR; PG8_MMA(1, 1, At, B1); PG8_BAR;
            }
        }
        if constexpr (ALIGN_EPI) { if (wr == 0) PG8_BAR; }
        if constexpr (!Epi::AFTER_DRAIN) { E(acc, cur, wr, wc, fr, fq); S.done(cur); }
        if (!has_next) break;
#pragma unroll
        for (int a = 0; a < 2; ++a)
#pragma unroll
            for (int b = 0; b < 2; ++b)
#pragma unroll
                for (int m = 0; m < 4; ++m)
#pragma unroll
                    for (int n = 0; n < 2; ++n) acc[a][b][m][n] = (f32x4){0.f, 0.f, 0.f, 0.f};
        cur = nxt; cA = nA; cB = nB; ++ui;
        if constexpr (ALIGN_EPI) { if (wr == 1) PG8_BAR; }
    }
    PG8_WAIT_V(0);
    if constexpr (!ALIGN_EPI) { if (wr == 0) PG8_BAR; }
    PG8_BAR;
    if constexpr (Epi::AFTER_DRAIN) { E.fused(acc, cur, wr, wc, fr, fq, lds, wid, lane); S.done(cur); }
#undef PG8_SA
#undef PG8_SB
#undef PG8_STAGE
#undef PG8_LDA
#undef PG8_LDB
#undef PG8_MMA
#undef PG8_WAIT_V
#undef PG8_WAIT_L
#undef PG8_BAR
#undef PG8_SCHED
}
}


#define XB_TMO      128
#define XB_XCNT(j)  (256  + 64 * (j))
#define XB_XSUB(j)  (1280 + 64 * (j))
#define XB_XGEN(j)  (2304 + 64 * (j))
#define XB_TOP      3328
#define XB_TOPGEN   3392
#define XCD_BAR_WORDS 3456
#define XB_SPIN_CAP (1u << 18)

__device__ __forceinline__ unsigned xb_ld(unsigned* p)              { return __hip_atomic_load(p, __ATOMIC_RELAXED, __HIP_MEMORY_SCOPE_AGENT); }
__device__ __forceinline__ unsigned xb_add(unsigned* p, unsigned v) { return __hip_atomic_fetch_add(p, v, __ATOMIC_RELAXED, __HIP_MEMORY_SCOPE_AGENT); }
__device__ __forceinline__ unsigned xb_xcc_id() { return (unsigned)__builtin_amdgcn_s_getreg((3 << 11) | 20) & 0xFu; }
#define XB_SPIN(cond, bar) do { unsigned _sp = 0; while (cond) { __builtin_amdgcn_s_sleep(1); \
    if ((++_sp & 255u) == 0u) { if (xb_ld(&(bar)[XB_TMO])) break; if (_sp > XB_SPIN_CAP) { atomicAdd(&(bar)[XB_TMO], 1u); break; } } } } while (0)

struct XcdBarrier {
    unsigned* bar; unsigned x;
    volatile LAS unsigned* st;
};

__device__ __forceinline__ XcdBarrier xcd_barrier_post(unsigned* bar, volatile LAS unsigned* st) {
    XcdBarrier b; b.bar = bar; b.x = xb_xcc_id(); b.st = st;
    if (threadIdx.x == 0) (void)xb_add(&bar[XB_XCNT(b.x)], 1u);
    return b;
}
__device__ __forceinline__ void xcd_barrier_complete(unsigned* bar, unsigned x, unsigned& nloc, unsigned& nx) {
    const unsigned G = gridDim.x * gridDim.y * gridDim.z;
    unsigned sum, cnt, mine, sp = 0u;
    for (;;) {
        sum = 0u; cnt = 0u; mine = 0u;
#pragma unroll
        for (unsigned j = 0; j < 16; ++j) { const unsigned c = xb_ld(&bar[XB_XCNT(j)]); sum += c; cnt += (c > 0u) ? 1u : 0u; mine = (j == x) ? c : mine; }
        if (sum == G) break;
        __builtin_amdgcn_s_sleep(1);
        if ((++sp & 255u) == 0u) { if (xb_ld(&bar[XB_TMO])) break; if (sp > XB_SPIN_CAP) { atomicAdd(&bar[XB_TMO], 1u); break; } }
    }
    nloc = mine > 0u ? mine : 1u; nx = cnt > 0u ? cnt : 1u;
}

__device__ __forceinline__ void xcd_barrier(const XcdBarrier& b) {
    asm volatile("s_waitcnt vmcnt(0)" ::: "memory");
    __syncthreads();
    if (threadIdx.x == 0) {
        unsigned* bar = b.bar;
        __builtin_amdgcn_s_waitcnt(0);
        unsigned nloc = b.st[0], nx = b.st[1];
        if (nloc == 0u) { xcd_barrier_complete(bar, b.x, nloc, nx); b.st[0] = nloc; b.st[1] = nx; }
        const unsigned old = xb_add(&bar[XB_XSUB(b.x)], 1u);
        const unsigned gen = old / nloc;
        if (old + 1u == (gen + 1u) * nloc) {
            __builtin_amdgcn_fence(__ATOMIC_RELEASE, "agent");
            asm volatile("s_waitcnt vmcnt(0)" ::: "memory");
            const unsigned og = xb_add(&bar[XB_TOP], 1u);
            const unsigned tg = og / nx;
            if (og + 1u == (tg + 1u) * nx) xb_add(&bar[XB_TOPGEN], 1u);
            else XB_SPIN(xb_ld(&bar[XB_TOPGEN]) == tg, bar);
            __builtin_amdgcn_fence(__ATOMIC_ACQUIRE, "agent");
            xb_add(&bar[XB_XGEN(b.x)], 1u);
            asm volatile("s_waitcnt vmcnt(0)" ::: "memory");
        } else {
            XB_SPIN(xb_ld(&bar[XB_XGEN(b.x)]) == gen, bar);
            __builtin_amdgcn_fence(__ATOMIC_ACQUIRE, "agent");
            asm volatile("s_waitcnt vmcnt(0)" ::: "memory");
        }
    }
    __syncthreads();
}

__device__ __forceinline__ void mlstm_naive(const Frame& F, LAS unsigned char* lds) {
    LAS float* qs = (LAS float*)lds; LAS float* ks = qs + 64; LAS float* part = ks + 64; LAS float* red = part + 512;
    const int tid = F.tid, e = tid & 127, qd = tid >> 7;
    for (int unit = blockIdx.x; unit < NB * 4; unit += gridDim.x) {
        const int b = unit >> 2, h = unit & 3;
        float C[16]; float n_d = 0.f, m = 0.f;
#pragma unroll
        for (int i = 0; i < 16; ++i) C[i] = 0.f;
        const float ib = F.i_bias[h], fb = F.f_bias[h];
        for (int t = 0; t < S; ++t) {
            const size_t row = (size_t)b * S + t;
            if (tid < 128) {
                const int cc = (tid < 64) ? (h * 64 + tid) : (256 + h * 64 + (tid - 64));
                float a = F.conv_b[cc];
#pragma unroll
                for (int j = 0; j < 4; ++j) { const int tt = t - 3 + j; if (tt >= 0) a += F.conv_w[j * 512 + cc] * (float)F.Z[(row - 3 + j) * ZP + cc]; }
                float v = a * sigmoidf_(a);
                if (tid < 64) qs[tid] = v * 0.125f; else ks[tid - 64] = v;
            }
            const float ig = F.GATES[row * 16 + h] + ib, fp = F.GATES[row * 16 + 4 + h] + fb;
            const float logf = fminf(fp, 0.f) - log1pf(__expf(-fabsf(fp)));
            const float m_new = fmaxf(logf + m, ig), fs = __expf(logf + m - m_new), is = __expf(ig - m_new); m = m_new;
            __syncthreads();
            const float ve = (float)F.Z[row * ZP + ZC_MV + h * 128 + e];
            float pn = 0.f;
#pragma unroll
            for (int i = 0; i < 16; ++i) { const int d = qd * 16 + i; C[i] = fs * C[i] + is * ks[d] * ve; pn += qs[d] * C[i]; }
            part[qd * 128 + e] = pn;
            if (tid < 64) { n_d = fs * n_d + is * ks[tid]; const float dn = wave_sum(qs[tid] * n_d); if (tid == 0) red[0] = dn; }
            __syncthreads();
            float hv = 0.f;
            if (tid < 128) {
                const float num = (part[e] + part[128 + e]) + (part[256 + e] + part[384 + e]), den = red[0];
                hv = num / fmaxf(fabsf(den), __expf(-m));
                const float sq = wave_sum(hv * hv); if (F.lane == 0) red[1 + F.wave] = sq;
            }
            __syncthreads();
            if (tid < 128) {
                const float r = 1.f / sqrtf((red[1] + red[2]) * (1.f / 128.f) + EPS);
                const float og = (float)F.Z[row * ZP + ZC_MO + h * 128 + e];
                F.MIX[row * D + h * 128 + e] = (h16)(hv * r * F.mlstm_norm[h * 128 + e] * sigmoidf_(og));
            }
        }
        __syncthreads();
    }
}

constexpr int LQ = 72;
constexpr int LW = 136;
typedef _Float16 h16x4 __attribute__((ext_vector_type(4)));

__device__ __forceinline__ void conv_silu8(const Frame& F, size_t row, int t, int cb, float (&o)[8]) {
#pragma unroll
    for (int i = 0; i < 8; ++i) o[i] = F.conv_b[cb + i];
#pragma unroll
    for (int j = 0; j < 4; ++j) {
        if (t - 3 + j >= 0) {
            const h16x8 z = *(const h16x8*)(F.Z + (row - 3 + j) * ZP + cb);
#pragma unroll
            for (int i = 0; i < 8; ++i) o[i] += F.conv_w[j * 512 + cb + i] * (float)z[i];
        }
    }
#pragma unroll
    for (int i = 0; i < 8; ++i) o[i] = o[i] * sigmoidf_(o[i]);
}
__device__ __forceinline__ float wave_scan_add(float x, int lane) {
#pragma unroll
    for (int o = 1; o < 64; o <<= 1) { const float v = __shfl_up(x, o); if (lane >= o) x += v; }
    return x;
}
__device__ __forceinline__ float wave_scan_max(float x, int lane) {
#pragma unroll
    for (int o = 1; o < 64; o <<= 1) { const float v = __shfl_up(x, o); if (lane >= o) x = fmaxf(x, v); }
    return x;
}

__device__ __forceinline__ void mlstm_A(const Frame& F, LAS unsigned char* lds) {
    LAS h16* KT = (LAS h16*)lds;
    LAS h16* VT = KT + 64 * LQ;
    LAS float* wg = (LAS float*)(VT + 128 * LQ);
    const int tid = F.tid, lane = F.lane, w = F.wave, fr = lane & 15, fq = lane >> 4;
    for (int u = blockIdx.x; u < NB * 4 * 64; u += gridDim.x) {
        const int c = u & 63, h = (u >> 6) & 3, b = u >> 8; const size_t row0 = (size_t)b * S + c * 64;
        if (w == 0) {
            const float ig = F.GATES[(row0 + lane) * 16 + h] + F.i_bias[h], fp = F.GATES[(row0 + lane) * 16 + 4 + h] + F.f_bias[h];
            const float logf = fminf(fp, 0.f) - log1pf(__expf(-fabsf(fp)));
            const float bl = wave_scan_add(logf, lane), g = __shfl(bl, 63);
            const float a = g - bl + ig, ml = wave_max(a);
            wg[lane] = __expf(a - ml);
            if (lane == 0) { F.G[u] = g; F.MLOC[u] = ml; }
        }
        __syncthreads();
        { const int l = tid >> 3, c8 = (tid & 7) * 8; float o[8]; conv_silu8(F, row0 + l, c * 64 + l, ZC_MK + h * 64 + c8, o);
#pragma unroll
          for (int i = 0; i < 8; ++i) KT[(c8 + i) * LQ + l] = (h16)o[i]; }
#pragma unroll
        for (int j = 0; j < 2; ++j) { const int id = tid + 512 * j, l = id >> 4, e8 = (id & 15) * 8; const float wl = wg[l];
            const h16x8 v = *(const h16x8*)(F.Z + (row0 + l) * ZP + ZC_MV + h * 128 + e8);
#pragma unroll
            for (int i = 0; i < 8; ++i) VT[(e8 + i) * LQ + l] = (h16)((float)v[i] * wl); }
        __syncthreads();
        f32x4 acc[4];
#pragma unroll
        for (int db = 0; db < 4; ++db) acc[db] = (f32x4){0.f, 0.f, 0.f, 0.f};
#pragma unroll
        for (int ks = 0; ks < 2; ++ks) {
            const h16x8 a = *(const LAS h16x8*)(VT + (16 * w + fr) * LQ + 32 * ks + 8 * fq);
#pragma unroll
            for (int db = 0; db < 4; ++db) { const h16x8 bb = *(const LAS h16x8*)(KT + (16 * db + fr) * LQ + 32 * ks + 8 * fq);
                acc[db] = __builtin_amdgcn_mfma_f32_16x16x32_f16(a, bb, acc[db], 0, 0, 0); }
        }
        float* kvt = F.KVT + (size_t)u * 8192;
#pragma unroll
        for (int db = 0; db < 4; ++db)
#pragma unroll
            for (int i = 0; i < 4; ++i) kvt[(16 * w + 4 * fq + i) * 64 + 16 * db + fr] = acc[db][i];
        if (tid < 64) { float s = 0.f; for (int l = 0; l < 64; ++l) s += wg[l] * (float)KT[tid * LQ + l]; F.KS[(size_t)u * 64 + tid] = s; }
        __syncthreads();
    }
}

__device__ __forceinline__ void mlstm_B(const Frame& F) {
    typedef float f32x2 __attribute__((ext_vector_type(2)));
    const int tid = F.tid;
    for (int slot = blockIdx.x; slot < 256; slot += gridDim.x) {
        const int bh = slot >> 3, part = slot & 7; const int idx = part * 1024 + tid * 2;
        float* base = F.KVT + (size_t)bh * 64 * 8192 + idx;
        const bool do_n = (part == 0 && tid < 64);
        f32x2 st = (f32x2){0.f, 0.f}; float nst = 0.f, m = 0.f;
        for (int c0 = 0; c0 < 64; c0 += 8) {
            f32x2 kv[8]; float ksv[8];
#pragma unroll
            for (int j = 0; j < 8; ++j) { kv[j] = *(const f32x2*)(base + (size_t)(c0 + j) * 8192); ksv[j] = do_n ? F.KS[(size_t)(bh * 64 + c0 + j) * 64 + tid] : 0.f; }
#pragma unroll
            for (int j = 0; j < 8; ++j) {
                const int u = bh * 64 + c0 + j; const float g = F.G[u], ml = F.MLOC[u];
                *(f32x2*)(base + (size_t)(c0 + j) * 8192) = st;
                if (do_n) F.KS[(size_t)u * 64 + tid] = nst;
                if (part == 0 && tid == 0) F.MPREV[u] = m;
                const float mn = fmaxf(g + m, ml), dec = __expf(g + m - mn), sc = __expf(ml - mn);
                st = dec * st + sc * kv[j]; nst = dec * nst + sc * ksv[j]; m = mn;
            }
        }
    }
}

__device__ __forceinline__ void mlstm_C(const Frame& F, LAS unsigned char* lds) {
    LAS h16* Qs = (LAS h16*)lds;
    LAS h16* Ks = Qs + 64 * LQ;
    LAS h16* QS = Ks + 64 * LQ;
    LAS h16* BT = QS + 64 * LW;
    LAS float* fa = (LAS float*)(BT + 128 * LW);
    LAS float *ul = fa, *wl = fa + 64, *iw = fa + 128, *emt = fa + 192, *den = fa + 256, *nb = fa + 320, *rowsq = fa + 384;
    const int tid = F.tid, lane = F.lane, w = F.wave, fr = lane & 15, fq = lane >> 4;
    for (int u = blockIdx.x; u < NB * 4 * 64; u += gridDim.x) {
        const int c = u & 63, h = (u >> 6) & 3, b = u >> 8; const size_t row0 = (size_t)b * S + c * 64;
        if (w == 0) {
            const float ig = F.GATES[(row0 + lane) * 16 + h] + F.i_bias[h], fp = F.GATES[(row0 + lane) * 16 + 4 + h] + F.f_bias[h];
            const float logf = fminf(fp, 0.f) - log1pf(__expf(-fabsf(fp)));
            const float bl = wave_scan_add(logf, lane), ww = ig - bl, pm = wave_scan_max(ww, lane);
            const float il = bl + F.MPREV[u], mt = fmaxf(il, bl + pm);
            ul[lane] = bl - mt; wl[lane] = ww; iw[lane] = __expf(il - mt); emt[lane] = __expf(-mt);
        }
        if (tid < 64) nb[tid] = F.KS[(size_t)u * 64 + tid];
        { const int l = tid >> 3, c8 = (tid & 7) * 8; float o[8];
          conv_silu8(F, row0 + l, c * 64 + l, ZC_MQ + h * 64 + c8, o);
          h16x8 hv;
#pragma unroll
          for (int i = 0; i < 8; ++i) hv[i] = (h16)(o[i] * 0.125f);
          *(LAS h16x8*)(Qs + l * LQ + c8) = hv;
          conv_silu8(F, row0 + l, c * 64 + l, ZC_MK + h * 64 + c8, o);
#pragma unroll
          for (int i = 0; i < 8; ++i) hv[i] = (h16)o[i];
          *(LAS h16x8*)(Ks + l * LQ + c8) = hv; }
#pragma unroll
        for (int j = 0; j < 2; ++j) { const int id = tid + 512 * j;
            { const int l = id >> 4, e8 = (id & 15) * 8; const h16x8 v = *(const h16x8*)(F.Z + (row0 + l) * ZP + ZC_MV + h * 128 + e8);
#pragma unroll
              for (int i = 0; i < 8; ++i) BT[(e8 + i) * LW + 64 + l] = v[i]; }
            { const int e = id >> 3, d8 = (id & 7) * 8; const float* cp = F.KVT + (size_t)u * 8192 + e * 64 + d8; const f32x4 c0 = *(const f32x4*)cp, c1 = *(const f32x4*)(cp + 4);
              h16x8 hv; hv[0] = (h16)c0[0]; hv[1] = (h16)c0[1]; hv[2] = (h16)c0[2]; hv[3] = (h16)c0[3]; hv[4] = (h16)c1[0]; hv[5] = (h16)c1[1]; hv[6] = (h16)c1[2]; hv[7] = (h16)c1[3];
              *(LAS h16x8*)(BT + e * LW + d8) = hv; } }
        __syncthreads();
        { const int l = tid >> 3, c8 = (tid & 7) * 8; const h16x8 q = *(const LAS h16x8*)(Qs + l * LQ + c8); const float s = iw[l]; h16x8 hv;
#pragma unroll
          for (int i = 0; i < 8; ++i) hv[i] = (h16)((float)q[i] * s);
          *(LAS h16x8*)(QS + l * LW + c8) = hv; }
#pragma unroll
        for (int tt = 0; tt < 2; ++tt) {
            const int lb = w & 3, sb = 2 * (w >> 2) + tt;
            f32x4 acc = (f32x4){0.f, 0.f, 0.f, 0.f};
            if (sb <= lb) {
#pragma unroll
                for (int ks = 0; ks < 2; ++ks) { const h16x8 a = *(const LAS h16x8*)(Qs + (16 * lb + fr) * LQ + 32 * ks + 8 * fq), bb = *(const LAS h16x8*)(Ks + (16 * sb + fr) * LQ + 32 * ks + 8 * fq);
                    acc = __builtin_amdgcn_mfma_f32_16x16x32_f16(a, bb, acc, 0, 0, 0); }
            }
            const int s = 16 * sb + fr; const float ws = wl[s];
#pragma unroll
            for (int i = 0; i < 4; ++i) { const int l = 16 * lb + 4 * fq + i; const float v = (s <= l) ? acc[i] * __expf(ul[l] + ws) : 0.f; QS[l * LW + 64 + s] = (h16)v; }
        }
        __syncthreads();
        { const int l = tid >> 3, part = tid & 7; float s = 0.f;
#pragma unroll
          for (int j = 0; j < 2; ++j) { const h16x8 q = *(const LAS h16x8*)(QS + l * LW + 16 * part + 8 * j);
#pragma unroll
              for (int i = 0; i < 8; ++i) { const int k = 16 * part + 8 * j + i; s += (float)q[i] * (k < 64 ? nb[k] : 1.f); } }
          s += __shfl_xor(s, 1); s += __shfl_xor(s, 2); s += __shfl_xor(s, 4);
          if (part == 0) den[l] = s; }
        f32x4 acc[4];
#pragma unroll
        for (int lb = 0; lb < 4; ++lb) acc[lb] = (f32x4){0.f, 0.f, 0.f, 0.f};
#pragma unroll
        for (int ks = 0; ks < 4; ++ks) { const h16x8 bb = *(const LAS h16x8*)(BT + (16 * w + fr) * LW + 32 * ks + 8 * fq);
#pragma unroll
            for (int lb = 0; lb < 4; ++lb) { const h16x8 a = *(const LAS h16x8*)(QS + (16 * lb + fr) * LW + 32 * ks + 8 * fq);
                acc[lb] = __builtin_amdgcn_mfma_f32_16x16x32_f16(a, bb, acc[lb], 0, 0, 0); } }
        __syncthreads();
#pragma unroll
        for (int lb = 0; lb < 4; ++lb)
#pragma unroll
            for (int i = 0; i < 4; ++i) { const int l = 16 * lb + 4 * fq + i; const float hv = acc[lb][i] / fmaxf(fabsf(den[l]), emt[l]); acc[lb][i] = hv;
                float sq = hv * hv; sq += __shfl_xor(sq, 1); sq += __shfl_xor(sq, 2); sq += __shfl_xor(sq, 4); sq += __shfl_xor(sq, 8);
                if (fr == 0) rowsq[w * 64 + l] = sq; }
        __syncthreads();
        const int e = 16 * w + fr; const float gn = F.mlstm_norm[h * 128 + e];
#pragma unroll
        for (int lb = 0; lb < 4; ++lb)
#pragma unroll
            for (int i = 0; i < 4; ++i) { const int l = 16 * lb + 4 * fq + i; float tot = 0.f;
#pragma unroll
                for (int ww = 0; ww < 8; ++ww) tot += rowsq[ww * 64 + l];
                const float r = 1.f / sqrtf(tot * (1.f / 128.f) + EPS);
                const float og = (float)F.Z[(row0 + l) * ZP + ZC_MO + h * 128 + e];
                F.MIX[(row0 + l) * D + h * 128 + e] = (h16)(acc[lb][i] * r * gn * sigmoidf_(og)); }
        __syncthreads();
    }
}

__device__ __forceinline__ void kn_phase(const Frame& F) {
    const int gw = blockIdx.x * 8 + F.wave, NGW = gridDim.x * 8;
    const float g = F.idx_k_norm[F.lane];
    for (int m = gw; m < T; m += NGW) {
        const float v = (float)F.Z[(size_t)m * ZP + ZC_IK + F.lane];
        const float r = 1.f / sqrtf(wave_sum(v * v) * (1.f / 64.f) + EPS);
        F.KN[(size_t)m * 64 + F.lane] = (h16)(v * r * g);
    }
}

__device__ __forceinline__ unsigned ord_key(float f) { const unsigned u = __float_as_uint(f); return (u & 0x80000000u) ? ~u : (u | 0x80000000u); }

__device__ __forceinline__ void index_naive(const Frame& F, LAS unsigned char* lds) {
    LAS float* qf = (LAS float*)lds;
    LAS float* wq = qf + 512;
    LAS unsigned* cnt = (LAS unsigned*)(wq + 8);
    LAS unsigned* keys = cnt + 40;
    const int tid = F.tid;
    for (int row = blockIdx.x; row < T; row += gridDim.x) {
        const int t = row & (S - 1), b = row >> 12;
        __syncthreads();
        qf[tid] = (float)F.Z[(size_t)row * ZP + ZC_IQ + tid];
        if (tid < 8) wq[tid] = F.GATES[(size_t)row * 16 + 8 + tid] * 0.35355339059327373f;
        if (tid < 40) cnt[tid] = 0u;
        __syncthreads();
        unsigned kk[8];
#pragma unroll
        for (int j = 0; j < 8; ++j) {
            const int s = tid + 512 * j; kk[j] = 0u;
            if (s <= t) {
                const h16* kr = F.KN + ((size_t)b * S + s) * 64;
                float kf[64];
#pragma unroll
                for (int c = 0; c < 8; ++c) { const h16x8 v = *(const h16x8*)(kr + 8 * c);
#pragma unroll
                    for (int i = 0; i < 8; ++i) kf[8 * c + i] = (float)v[i]; }
                float score = 0.f;
#pragma unroll
                for (int hh = 0; hh < 8; ++hh) { float dot = 0.f;
#pragma unroll
                    for (int d = 0; d < 64; ++d) dot += qf[hh * 64 + d] * kf[d];
                    score += fmaxf(dot * 0.125f, 0.f) * wq[hh]; }
                kk[j] = ord_key(score); keys[s] = kk[j];
            }
        }
        unsigned vstar = 0u;
        if (t >= TOPK) {
            unsigned prefix = 0u;
            for (int bit = 31; bit >= 0; --bit) {
                const unsigned cand = prefix | (1u << bit); int c = 0;
#pragma unroll
                for (int j = 0; j < 8; ++j) c += (kk[j] >= cand) ? 1 : 0;
                c = wave_isum(c); if (F.lane == 0) atomicAdd((unsigned*)&cnt[bit], (unsigned)c);
                __syncthreads();
                if (cnt[bit] >= (unsigned)TOPK) prefix = cand;
            }
            vstar = prefix;
            int cg = 0, ce = 0;
#pragma unroll
            for (int j = 0; j < 8; ++j) { cg += (kk[j] > vstar) ? 1 : 0; ce += (kk[j] == vstar) ? 1 : 0; }
            cg = wave_isum(cg); ce = wave_isum(ce);
            if (F.lane == 0) { atomicAdd((unsigned*)&cnt[32], (unsigned)cg); atomicAdd((unsigned*)&cnt[33], (unsigned)ce); }
            __syncthreads();
            const int need = TOPK - (int)cnt[32];
            if ((int)cnt[33] > need) {
                if (tid == 0) { int nd = need; for (int s = 0; s <= t; ++s) if (keys[s] == vstar) { if (nd > 0) --nd; else keys[s] = 0u; } }
            }
        }
        __syncthreads();
        if (tid < 128) {
            unsigned word = 0u;
            for (int i = 0; i < 32; ++i) { const int s = 32 * tid + i; if (s <= t && keys[s] >= vstar) word |= (1u << i); }
            F.BM[(size_t)row * 128 + tid] = word;
        }
    }
}

typedef float f32x16 __attribute__((ext_vector_type(16)));
__device__ __forceinline__ size_t bm_index(int b, int t, int kt) { return ((((size_t)(b * 128 + (t >> 5)) * 64 + kt) * 32) + (t & 31)) * 2; }

__device__ __forceinline__ void index_mfma(const Frame& F, LAS unsigned char* lds) {
    LAS unsigned* keys = (LAS unsigned*)lds;
    const int lane = F.lane, w = F.wave, c32 = lane & 31, hi = lane >> 5;
    const int qa = 2 * ((c32 >> 2) & 1) + ((((c32 & 3) + 4 * (c32 >> 3))) >> 3), ha = ((c32 & 3) + 4 * (c32 >> 3)) & 7;
    for (int unit = blockIdx.x; unit < NB * 512; unit += gridDim.x) {
        const int b = unit & 7, qg = unit >> 3, t0 = 8 * qg; const size_t rowbase = (size_t)b * S;
        const int ntile = (t0 + 7) / 32 + 1, L = 32 * ntile;
        h16x8 a[2][4]; float wv[2][16];
#pragma unroll
        for (int blk = 0; blk < 2; ++blk) {
#pragma unroll
            for (int ks = 0; ks < 4; ++ks) a[blk][ks] = *(const h16x8*)(F.Z + (rowbase + t0 + 4 * blk + qa) * ZP + ZC_IQ + ha * 64 + 16 * ks + 8 * hi);
#pragma unroll
            for (int qq = 0; qq < 2; ++qq) { const float* gp = F.GATES + (rowbase + t0 + 4 * blk + 2 * hi + qq) * 16 + 8; const f32x4 g0 = *(const f32x4*)gp, g1 = *(const f32x4*)(gp + 4);
#pragma unroll
                for (int i = 0; i < 4; ++i) { wv[blk][qq * 8 + i] = g0[i] * (0.125f * 0.35355339059327373f); wv[blk][qq * 8 + 4 + i] = g1[i] * (0.125f * 0.35355339059327373f); } }
        }
        for (int tile = w; tile < ntile; tile += 8) {
            const h16* kp = F.KN + (rowbase + 32 * tile + c32) * 64 + 8 * hi;
            h16x8 bf[4];
#pragma unroll
            for (int ks = 0; ks < 4; ++ks) bf[ks] = *(const h16x8*)(kp + 16 * ks);
            const int s = 32 * tile + c32;
#pragma unroll
            for (int blk = 0; blk < 2; ++blk) {
                f32x16 acc;
#pragma unroll
                for (int i = 0; i < 16; ++i) acc[i] = 0.f;
#pragma unroll
                for (int ks = 0; ks < 4; ++ks) acc = __builtin_amdgcn_mfma_f32_32x32x16_f16(a[blk][ks], bf[ks], acc, 0, 0, 0);
#pragma unroll
                for (int qq = 0; qq < 2; ++qq) { float sc = 0.f;
#pragma unroll
                    for (int hh = 0; hh < 8; ++hh) sc += fmaxf(acc[qq * 8 + hh], 0.f) * wv[blk][qq * 8 + hh];
                    const int ql = 4 * blk + 2 * hi + qq;
                    keys[ql * 4096 + s] = (s <= t0 + ql) ? ord_key(sc) : 0u; }
            }
        }
        __syncthreads();
        {
            const int t = t0 + w, nj = (L + 63) >> 6; const LAS unsigned* kr = keys + w * 4096;
            unsigned kk[64];
#pragma unroll
            for (int g = 0; g < 8; ++g) {
                if (8 * g < nj) {
#pragma unroll
                    for (int i = 0; i < 8; ++i) { const int s = 64 * (8 * g + i) + lane; kk[8 * g + i] = (s < L) ? kr[s] : 0u; }
                } else {
#pragma unroll
                    for (int i = 0; i < 8; ++i) kk[8 * g + i] = 0u;
                }
            }
            unsigned vstar = 0u; int allowed = 0;
            if (t >= TOPK) {
                unsigned prefix = 0u;
                for (int bit = 31; bit >= 0; --bit) {
                    const unsigned cand = prefix | (1u << bit); int cnt = 0;
#pragma unroll
                    for (int g = 0; g < 8; ++g) if (8 * g < nj) {
#pragma unroll
                        for (int i = 0; i < 8; ++i) cnt += __popcll(__ballot(kk[8 * g + i] >= cand)); }
                    if (cnt >= TOPK) prefix = cand;
                }
                vstar = prefix; int cgt = 0;
#pragma unroll
                for (int g = 0; g < 8; ++g) if (8 * g < nj) {
#pragma unroll
                    for (int i = 0; i < 8; ++i) cgt += __popcll(__ballot(kk[8 * g + i] > vstar)); }
                allowed = TOPK - cgt;
            }
            unsigned mlo = 0u, mhi = 0u;
#pragma unroll
            for (int j = 0; j < 64; ++j) {
                unsigned long long m = 0ull;
                if (j < nj) {
                    const unsigned long long gt = __ballot(kk[j] > vstar); unsigned long long eq = __ballot(kk[j] == vstar);
                    if (allowed <= 0) eq = 0ull;
                    else { while (__popcll(eq) > allowed) eq &= ~(1ull << (63 - __clzll(eq))); allowed -= __popcll(eq); }
                    m = gt | eq;
                }
                if (lane == j) { mlo = (unsigned)m; mhi = (unsigned)(m >> 32); }
            }
            typedef unsigned u32x2 __attribute__((ext_vector_type(2)));
            *(u32x2*)(F.BM + bm_index(b, t, lane)) = (u32x2){mlo, mhi};
        }
        __syncthreads();
    }
}

__device__ __forceinline__ void attn_naive(const Frame& F, LAS unsigned char* lds) {
    LAS float* qf = (LAS float*)lds;
    LAS float* p = qf + 512;
    LAS int* sel = (LAS int*)(p + 2048);
    LAS int* pcs = sel + 288;
    LAS float* btab = (LAS float*)(pcs + 128);
    LAS int* nselp = (LAS int*)(btab + 1024);
    const int tid = F.tid, hh = F.wave, lane = F.lane;
    for (int i = tid; i < 1024; i += NTHR) {
        const int dist = i >> 3, h = i & 7; int bk;
        if (dist < 16) bk = dist; else { bk = 16 + (int)(log((double)dist / 16.0) / log(8.0) * 16.0); if (bk > 31) bk = 31; }
        btab[i] = F.rel_bias[bk * 8 + h];
    }
    for (int row = blockIdx.x; row < T; row += gridDim.x) {
        const int t = row & (S - 1), b = row >> 12;
        __syncthreads();
        unsigned word = 0u;
        if (tid < 128) { word = F.BM[bm_index(b, t, tid >> 1) + (tid & 1)]; pcs[tid] = __popc(word); }
        qf[tid] = (float)F.Z[(size_t)row * ZP + ZC_AQ + tid];
        __syncthreads();
        if (tid < 128) {
            int off = 0; for (int i = 0; i < tid; ++i) off += pcs[i];
            if (tid == 127) *nselp = off + pcs[127];
            while (word) { const int bpos = __ffs(word) - 1; word &= word - 1; if (off < 288) sel[off] = 32 * tid + bpos; ++off; }
        }
        __syncthreads();
        const int nsel = min(*nselp, 256);
        float lg[4]; float mx = -INFINITY;
#pragma unroll
        for (int jj = 0; jj < 4; ++jj) {
            const int j = lane + 64 * jj; lg[jj] = -INFINITY;
            if (j < nsel) {
                const int s = sel[j]; const h16* kr = F.Z + ((size_t)b * S + s) * ZP + ZC_AK + hh * 64;
                float dot = 0.f;
#pragma unroll
                for (int c = 0; c < 8; ++c) { const h16x8 v = *(const h16x8*)(kr + 8 * c);
#pragma unroll
                    for (int i = 0; i < 8; ++i) dot += qf[hh * 64 + 8 * c + i] * (float)v[i]; }
                const int dist = t - s;
                lg[jj] = dot * 0.125f + btab[(dist < 127 ? dist : 127) * 8 + hh];
                mx = fmaxf(mx, lg[jj]);
            }
        }
        mx = wave_max(mx);
        float sum = 0.f;
#pragma unroll
        for (int jj = 0; jj < 4; ++jj) { const int j = lane + 64 * jj; const float ev = (j < nsel) ? __expf(lg[jj] - mx) : 0.f; sum += ev; p[hh * 256 + j] = ev; }
        sum = wave_sum(sum);
        __syncthreads();
        float acc = 0.f;
        for (int j = 0; j < nsel; ++j) acc += p[hh * 256 + j] * (float)F.Z[((size_t)b * S + sel[j]) * ZP + ZC_AV + hh * 64 + lane];
        F.MIX[(size_t)row * D + 512 + hh * 64 + lane] = (h16)(acc / sum);
    }
}

__device__ __forceinline__ void h2_phase(const Frame& F) {
    const int gw = blockIdx.x * 8 + F.wave, NGW = gridDim.x * 8;
    for (int m = gw; m < T; m += NGW) rms_row_to_h16(F.out + (size_t)m * D, F.norm_ffn, F.XN + (size_t)m * D, F.lane);
}
__device__ __forceinline__ void act_phase(const Frame& F, int row_lo, int row_hi) {
    const size_t total = (size_t)(row_hi - row_lo) * DFF;
    for (size_t i = (size_t)blockIdx.x * NTHR + F.tid; i < total; i += (size_t)gridDim.x * NTHR) {
        const int r = (int)(i / DFF), c = (int)(i % DFF); const int row = row_lo + r, t = row & (S - 1);
        const int pc = 256 * (c >> 7) + (c & 127);
        float ug = F.ffn_conv_b[c], uv = F.ffn_conv_b[DFF + c];
#pragma unroll
        for (int j = 0; j < 3; ++j) { const int tt = t - 2 + j; if (tt >= 0) {
            const h16* yr = F.Y + (size_t)(r - 2 + j) * NUP + pc;
            ug += F.ffn_conv_w[j * NUP + c] * (float)yr[0]; uv += F.ffn_conv_w[j * NUP + DFF + c] * (float)yr[128]; } }
        F.ACT[(size_t)row * DFF + c] = (h16)(ug * sigmoidf_(ug) * uv);
    }
}
__device__ __forceinline__ void final_norm_phase(const Frame& F) {
    const int gw = blockIdx.x * 8 + F.wave, NGW = gridDim.x * 8;
    for (int m = gw; m < T; m += NGW) {
        float* xr = F.out + (size_t)m * D; f32x4 v[4]; float s = 0.f;
#pragma unroll
        for (int j = 0; j < 4; ++j) { v[j] = *(const f32x4*)(xr + 4 * F.lane + 256 * j); s += (v[j].x * v[j].x + v[j].y * v[j].y) + (v[j].z * v[j].z + v[j].w * v[j].w); }
        const float r = 1.f / sqrtf(wave_sum(s) * (1.f / D) + EPS);
#pragma unroll
        for (int j = 0; j < 4; ++j) { const f32x4 g = *(const f32x4*)(F.norm_final + 4 * F.lane + 256 * j); *(f32x4*)(xr + 4 * F.lane + 256 * j) = (f32x4){v[j].x * r * g.x, v[j].y * r * g.y, v[j].z * r * g.z, v[j].w * r * g.w}; }
    }
}


#ifndef MK_N_LAUNCHES
#define MK_N_LAUNCHES 1
#endif
constexpr int N_PHASES = 14;
constexpr int RING_BYTES = 131072, MISC_OFF = RING_BYTES + 320, LDS_BYTES = 147456;
constexpr int CW_BAR = 4096;
constexpr size_t CTL_ZERO_BYTES = 64 * 1024;
__global__ void __launch_bounds__(NTHR, 2) mk_fwd(Args a) {
    extern __shared__ __attribute__((aligned(16))) unsigned char lds_raw[];
    LAS unsigned char* lds = (LAS unsigned char*)lds_raw;
    Frame F;
    F.x = a.in[0]; F.norm_mix = a.in[1]; F.w_in = a.in[2]; F.conv_w = a.in[3]; F.conv_b = a.in[4]; F.i_bias = a.in[5]; F.f_bias = a.in[6]; F.mlstm_norm = a.in[7];
    F.idx_k_norm = a.in[8]; F.rel_bias = a.in[9]; F.w_out = a.in[10]; F.norm_ffn = a.in[11]; F.w_up = a.in[12]; F.ffn_conv_w = a.in[13]; F.ffn_conv_b = a.in[14];
    F.w_down = a.in[15]; F.norm_final = a.in[16]; F.out = a.out;
    unsigned char* ws = a.ws;
    F.WIN = (h16*)(ws + WS_WIN); F.WOUT = (h16*)(ws + WS_WOUT); F.WUP = (h16*)(ws + WS_WUP); F.WDN = (h16*)(ws + WS_WDN);
    F.GATES = (float*)(ws + WS_GATES); F.XN = (h16*)(ws + WS_XN); F.Z = (h16*)(ws + WS_Z); F.MIX = (h16*)(ws + WS_MIX); F.KN = (h16*)(ws + WS_KN);
    F.BM = (unsigned*)(ws + WS_BM); F.KVT = (float*)(ws + WS_KVT); F.KS = (float*)(ws + WS_KS); F.G = (float*)(ws + WS_GML); F.MLOC = F.G + 2048; F.MPREV = F.G + 4096; F.Y = (h16*)(ws + WS_Y); F.ACT = (h16*)(ws + WS_ACT);
    F.tid = threadIdx.x; F.lane = F.tid & 63; F.wave = __builtin_amdgcn_readfirstlane(F.tid >> 6);
    volatile LAS unsigned* MISC = (volatile LAS unsigned*)(lds + MISC_OFF);
    for (int u = F.tid; u < (LDS_BYTES - RING_BYTES) / 4; u += NTHR) ((LAS unsigned*)(lds + RING_BYTES))[u] = 0u;
    __syncthreads();
    XcdBarrier bar; bar.bar = (unsigned*)(ws + WS_CTL) + CW_BAR; bar.x = 0; bar.st = nullptr;
    if (MK_N_LAUNCHES == 1) bar = xcd_barrier_post((unsigned*)(ws + WS_CTL) + CW_BAR, MISC + 8);
    const int lo = a.ph_lo, hi = a.ph_hi, G = gridDim.x;
#define IN(k) (lo <= (k) && (k) < hi)
#define SEAM(k) do { if (IN(k) && IN((k) + 1)) xcd_barrier(bar); } while (0)
    if (IN(0)) p0_prologue(F, lds);
    SEAM(0);
    if (IN(1)) { pg8::Gemm g{(const pg8::bf16_t*)F.XN, (const pg8::bf16_t*)F.WIN, T, ZP, D}; pg8::StaticOrder So; So.init(T, ZP, G, (int)blockIdx.x);
        pg8::EpiH16 E{F.Z, ZP, 0, F.GATES, ZC_G}; pg8::gemm_phase<pg8::EpiH16, pg8::StaticOrder, true, true>(lds, g, So, E); }
    SEAM(1);
    if (IN(2)) { kn_phase(F); mlstm_A(F, lds); }
    SEAM(2);
    if (IN(3)) mlstm_B(F);
    SEAM(3);
    if (IN(4)) { mlstm_C(F, lds); index_mfma(F, lds); }
    SEAM(4);
    if (IN(5)) attn_naive(F, lds);
    SEAM(5);
    if (IN(6)) { pg8::Gemm g{(const pg8::bf16_t*)F.MIX, (const pg8::bf16_t*)F.WOUT, T, D, D}; pg8::StaticOrder So; So.init(T, D, G, (int)blockIdx.x);
        pg8::EpiRes32 E{F.x, F.out, D}; pg8::gemm_phase<pg8::EpiRes32, pg8::StaticOrder, true, true>(lds, g, So, E); }
    SEAM(6);
    if (IN(7)) h2_phase(F);
    SEAM(7);
    if (IN(8)) { pg8::Gemm g{(const pg8::bf16_t*)F.XN, (const pg8::bf16_t*)F.WUP, T / 2, NUP, D}; pg8::StaticOrder So; So.init(T / 2, NUP, G, (int)blockIdx.x);
        pg8::EpiH16 E{F.Y, NUP, 0, nullptr, 0}; pg8::gemm_phase<pg8::EpiH16, pg8::StaticOrder, true, true>(lds, g, So, E); }
    SEAM(8);
    if (IN(9)) act_phase(F, 0, T / 2);
    SEAM(9);
    if (IN(10)) { pg8::Gemm g{(const pg8::bf16_t*)(F.XN + (size_t)(T / 2) * D), (const pg8::bf16_t*)F.WUP, T / 2, NUP, D}; pg8::StaticOrder So; So.init(T / 2, NUP, G, (int)blockIdx.x);
        pg8::EpiH16 E{F.Y, NUP, 0, nullptr, 0}; pg8::gemm_phase<pg8::EpiH16, pg8::StaticOrder, true, true>(lds, g, So, E); }
    SEAM(10);
    if (IN(11)) act_phase(F, T / 2, T);
    SEAM(11);
    if (IN(12)) { pg8::Gemm g{(const pg8::bf16_t*)F.ACT, (const pg8::bf16_t*)F.WDN, T, D, DFF}; pg8::StaticOrder So; So.init(T, D, G, (int)blockIdx.x);
        pg8::EpiRes32 E{F.out, F.out, D}; pg8::gemm_phase<pg8::EpiRes32, pg8::StaticOrder, true, true>(lds, g, So, E); }
    SEAM(12);
    if (IN(13)) final_norm_phase(F);
#undef IN
#undef SEAM
}

extern "C" void kernel_launch(void* const* d_in, const int* in_sizes, int n_in, void* d_out, int out_size, void* d_ws, size_t ws_size, hipStream_t stream) {
    static int grid = 0;
    if (grid == 0) {
        if (n_in != 17 || in_sizes[0] != T * D || out_size != T * D || ws_size < WS_END) { fprintf(stderr, "kernel_launch: unexpected shapes (n_in %d, in0 %d, out %d, ws %zu)\n", n_in, n_in > 0 ? in_sizes[0] : -1, out_size, ws_size); grid = -1; return; }
        int dev = 0, cus = 0, per_cu = 0;
        if (hipGetDevice(&dev) != hipSuccess || hipDeviceGetAttribute(&cus, hipDeviceAttributeMultiprocessorCount, dev) != hipSuccess) { fprintf(stderr, "kernel_launch: device query failed\n"); grid = -1; return; }
        if (hipFuncSetAttribute((const void*)mk_fwd, hipFuncAttributeMaxDynamicSharedMemorySize, LDS_BYTES) != hipSuccess) { fprintf(stderr, "kernel_launch: hipFuncSetAttribute failed\n"); grid = -1; return; }
        if (hipOccupancyMaxActiveBlocksPerMultiprocessor(&per_cu, (const void*)mk_fwd, NTHR, LDS_BYTES) != hipSuccess || per_cu < 1) fprintf(stderr, "kernel_launch: note: occupancy query reports %d workgroups per CU\n", per_cu);
        (void)hipGetLastError();
        grid = cus;
    }
    if (grid < 0) return;
    if (hipMemsetAsync((char*)d_ws + WS_CTL, 0, CTL_ZERO_BYTES, stream) != hipSuccess) { fprintf(stderr, "kernel_launch: memset failed\n"); return; }
    Args a{};
    for (int i = 0; i < 17; ++i) a.in[i] = (const float*)d_in[i];
    a.out = (float*)d_out; a.ws = (unsigned char*)d_ws;
    if (MK_N_LAUNCHES == 1) { a.ph_lo = 0; a.ph_hi = N_PHASES; hipLaunchKernelGGL(mk_fwd, dim3(grid), dim3(NTHR), LDS_BYTES, stream, a); }
    else for (int ph = 0; ph < N_PHASES; ++ph) { a.ph_lo = ph; a.ph_hi = ph + 1; hipLaunchKernelGGL(mk_fwd, dim3(grid), dim3(NTHR), LDS_BYTES, stream, a); }
}
```

```cpp
#include <hip/hip_runtime.h>
#include <cstdio>
#include <cstdint>

#define LAS __attribute__((address_space(3)))
typedef _Float16 h16;
typedef _Float16 h16x8 __attribute__((ext_vector_type(8)));
typedef float f32x4 __attribute__((ext_vector_type(4)));
typedef unsigned u32x4 __attribute__((ext_vector_type(4)));

constexpr int NB = 8, S = 4096, T = NB * S, D = 1024;
constexpr int ZP = 3840;
constexpr int DFF = 2816, NUP = 2 * DFF;
constexpr int ZC_MQ = 0, ZC_MK = 256, ZC_MV = 512, ZC_MO = 1024, ZC_AQ = 1536, ZC_AK = 2048, ZC_AV = 2560, ZC_IQ = 3072, ZC_IK = 3584, ZC_G = 3648;
constexpr int TOPK = 256;
constexpr float EPS = 1e-6f;
constexpr int NTHR = 512;

constexpr size_t MiB = 1u << 20;
constexpr size_t WS_CTL = 0;
constexpr size_t WS_WIN = 2 * MiB;
constexpr size_t WS_WOUT = 10 * MiB;
constexpr size_t WS_WUP = 12 * MiB;
constexpr size_t WS_WDN = 23 * MiB;
constexpr size_t WS_GATES = 29 * MiB;
constexpr size_t WS_XN = 32 * MiB;
constexpr size_t WS_Z = 96 * MiB;
constexpr size_t WS_MIX = 336 * MiB;
constexpr size_t WS_KN = 400 * MiB;
constexpr size_t WS_BM = 404 * MiB;
constexpr size_t WS_Y = 96 * MiB;
constexpr size_t WS_ACT = 272 * MiB;
constexpr size_t WS_KVT = 420 * MiB;
constexpr size_t WS_KS = 484 * MiB;
constexpr size_t WS_GML = 485 * MiB;
constexpr size_t WS_END = 486 * MiB;

struct Args { const float* in[17]; float* out; unsigned char* ws; int ph_lo, ph_hi; };

struct Frame {
    const float *x, *norm_mix, *w_in, *conv_w, *conv_b, *i_bias, *f_bias, *mlstm_norm, *idx_k_norm, *rel_bias, *w_out, *norm_ffn, *w_up, *ffn_conv_w, *ffn_conv_b, *w_down, *norm_final;
    float* out;
    h16 *WIN, *WOUT, *WUP, *WDN, *XN, *Z, *MIX, *KN, *Y, *ACT;
    float* GATES; unsigned* BM;
    float *KVT, *KS, *G, *MLOC, *MPREV;
    int tid, lane, wave;
};

__device__ __forceinline__ float wave_sum(float v) {
#pragma unroll
    for (int o = 1; o < 64; o <<= 1) v += __shfl_xor(v, o);
    return v;
}
__device__ __forceinline__ float wave_max(float v) {
#pragma unroll
    for (int o = 1; o < 64; o <<= 1) v = fmaxf(v, __shfl_xor(v, o));
    return v;
}
__device__ __forceinline__ int wave_isum(int v) {
#pragma unroll
    for (int o = 1; o < 64; o <<= 1) v += __shfl_xor(v, o);
    return v;
}
__device__ __forceinline__ float sigmoidf_(float x) { return 1.f / (1.f + __expf(-x)); }

__device__ __forceinline__ int src_col_in(int n) { return n < 1536 ? n : n < 3648 ? n + 8 : n < 3656 ? n - 3648 + 1536 : n < 3664 ? n : -1; }
__device__ __forceinline__ int src_col_up(int n) { const int pn = n >> 8, r = n & 255; return (r >> 7) * DFF + pn * 128 + (r & 127); }

template <int MODE>
__device__ __forceinline__ void transpose_item(const float* W, int K, int N, h16* WT, int NOUT, LAS float* scr, int item, int lane) {
    const int nblk = NOUT / 32, kb = item / nblk, nb = item % nblk, k0 = 64 * kb, n0 = 32 * nb;
    const int n = n0 + (lane & 31);
    const int sc = MODE == 1 ? src_col_in(n) : MODE == 2 ? src_col_up(n) : n;
#pragma unroll 8
    for (int i = 0; i < 32; ++i) { const int kk = 2 * i + (lane >> 5); scr[kk * 33 + (lane & 31)] = sc >= 0 ? W[(size_t)(k0 + kk) * N + sc] : 0.f; }
    __builtin_amdgcn_s_waitcnt(0xc07f); __builtin_amdgcn_wave_barrier();
    const int c = lane & 7;
#pragma unroll
    for (int j = 0; j < 4; ++j) {
        const int nn = (lane >> 3) + 8 * j; const LAS float* s = scr + (8 * c) * 33 + nn;
        h16x8 o;
#pragma unroll
        for (int i = 0; i < 8; ++i) o[i] = (h16)s[i * 33];
        *(h16x8*)(WT + (size_t)(n0 + nn) * K + k0 + 8 * c) = o;
    }
    __builtin_amdgcn_s_waitcnt(0xc07f); __builtin_amdgcn_wave_barrier();
}

__device__ __forceinline__ void rms_row_to_h16(const float* xrow, const float* g, h16* orow, int lane) {
    f32x4 v[4]; float s = 0.f;
#pragma unroll
    for (int j = 0; j < 4; ++j) { v[j] = *(const f32x4*)(xrow + 4 * lane + 256 * j); s += (v[j].x * v[j].x + v[j].y * v[j].y) + (v[j].z * v[j].z + v[j].w * v[j].w); }
    const float r = 1.f / sqrtf(wave_sum(s) * (1.f / D) + EPS);
#pragma unroll
    for (int j = 0; j < 4; ++j) {
        const f32x4 gg = *(const f32x4*)(g + 4 * lane + 256 * j);
        typedef _Float16 h16x4 __attribute__((ext_vector_type(4)));
        h16x4 o; o[0] = (h16)(v[j].x * r * gg.x); o[1] = (h16)(v[j].y * r * gg.y); o[2] = (h16)(v[j].z * r * gg.z); o[3] = (h16)(v[j].w * r * gg.w);
        *(h16x4*)(orow + 4 * lane + 256 * j) = o;
    }
}

__device__ __forceinline__ void p0_prologue(const Frame& F, LAS unsigned char* lds) {
    LAS float* scr = (LAS float*)lds + F.wave * (64 * 33);
    const int gw = blockIdx.x * 8 + F.wave, NGW = gridDim.x * 8;
    constexpr int I_IN = 16 * (ZP / 32), I_OUT = 16 * (D / 32), I_UP = 16 * (NUP / 32), I_DN = (DFF / 64) * (D / 32);
    for (int it = gw; it < I_IN + I_OUT + I_UP + I_DN; it += NGW) {
        int r = it;
        if (r < I_IN) { transpose_item<1>(F.w_in, D, 3664, F.WIN, ZP, scr, r, F.lane); continue; } r -= I_IN;
        if (r < I_OUT) { transpose_item<0>(F.w_out, D, D, F.WOUT, D, scr, r, F.lane); continue; } r -= I_OUT;
        if (r < I_UP) { transpose_item<2>(F.w_up, D, NUP, F.WUP, NUP, scr, r, F.lane); continue; } r -= I_UP;
        transpose_item<0>(F.w_down, DFF, D, F.WDN, D, scr, r, F.lane);
    }
    for (int m = gw; m < T; m += NGW) rms_row_to_h16(F.x + (size_t)m * D, F.norm_mix, F.XN + (size_t)m * D, F.lane);
}

namespace pg8 {
#define PG8_LAS __attribute__((address_space(3)))
typedef unsigned short bf16_t;
typedef short bf16x8 __attribute__((ext_vector_type(8)));
typedef float f32x4 __attribute__((ext_vector_type(4)));
typedef unsigned u32x4 __attribute__((ext_vector_type(4)));
constexpr int BM = 256, BK = 64, HALF = 128, HTB = HALF * BK * 2  , STAGE_BYTES = 8 * HTB, NXCD = 8, WGM = 8;

__host__ __device__ __forceinline__ int lds_byte(int r, int c) { const int st = (r >> 4) * 2 + (c >> 5), rr = r & 15, cc = c & 31, ob = rr * 64 + cc * 2; return st * 1024 + (ob ^ (((ob >> 9) & 1) << 5)); }
__host__ __device__ __forceinline__ void stage_rc(int b, int& R, int& C) { const int st = b / 1024, sb = b % 1024, swz = sb ^ (((sb >> 9) & 1) << 5); R = (st >> 1) * 16 + swz / 64; C = (st & 1) * 32 + (swz % 64) / 2; }
__host__ __device__ __forceinline__ int perm32(int rho) { const int n = rho >> 4, i = rho & 15; return 8 * (i >> 2) + 4 * n + (i & 3); }

struct Unit { int pm, pn; };
struct Gemm { const bf16_t* A; const bf16_t* Bt; int M, N, K; };

struct StaticOrder {
    int nM, nN, nwg, G, c;
    __host__ __device__ void init(int M, int N, int G_, int c_) { nM = M / BM; nN = N / BM; nwg = nM * nN; G = G_; c = c_; }
    __host__ __device__ bool next(int i, Unit& u) const {
        const long L = (long)i * G + c; if (L >= nwg) return false;
        int wgid = (int)L; { const int q = nwg / NXCD, r = nwg % NXCD, xcd = wgid % NXCD, off = wgid / NXCD; wgid = (xcd < r ? xcd * (q + 1) : r * (q + 1) + (xcd - r) * q) + off; }
        const int nig = WGM * nN, gid = wgid / nig, fm = gid * WGM, gsz = (nM - fm) < WGM ? (nM - fm) : WGM;
        u.pm = fm + ((wgid % nig) % gsz); u.pn = (wgid % nig) / gsz; return true;
    }
    __device__ __forceinline__ void a_ready(const Unit&) const {}
    __device__ __forceinline__ void done(const Unit&) const {}
};

typedef _Float16 f16x8 __attribute__((ext_vector_type(8)));
struct EpiH16 {
    static constexpr bool PERM = true, AFTER_DRAIN = false;
    _Float16* O; int ldc; int row_off; float* G; int gc0;
    __device__ __forceinline__ void operator()(const f32x4 (&acc)[2][2][4][2], const Unit& u, int wr, int wc, int fr, int fq) const {
        const int row0 = row_off + u.pm * BM + wr * 64 + fr, col0 = u.pn * BM + wc * 32 + 8 * fq;
#pragma unroll
        for (int ai = 0; ai < 2; ++ai)
#pragma unroll
            for (int m = 0; m < 4; ++m) { const size_t r = (size_t)(row0 + ai * HALF + m * 16);
#pragma unroll
                for (int bj = 0; bj < 2; ++bj) { const int c = col0 + bj * HALF; const f32x4 v0 = acc[ai][bj][m][0], v1 = acc[ai][bj][m][1];
                    f16x8 o; o[0] = (_Float16)v0[0]; o[1] = (_Float16)v0[1]; o[2] = (_Float16)v0[2]; o[3] = (_Float16)v0[3]; o[4] = (_Float16)v1[0]; o[5] = (_Float16)v1[1]; o[6] = (_Float16)v1[2]; o[7] = (_Float16)v1[3];
                    *(f16x8*)(O + r * ldc + c) = o;
                    if (G && c >= gc0 && c < gc0 + 16) { *(f32x4*)(G + r * 16 + (c - gc0)) = v0; *(f32x4*)(G + r * 16 + (c - gc0) + 4) = v1; } } }
    }
};
struct EpiRes32 {
    static constexpr bool PERM = false, AFTER_DRAIN = false;
    const float* base; float* out; int ldc;
    __device__ __forceinline__ void operator()(const f32x4 (&acc)[2][2][4][2], const Unit& u, int wr, int wc, int fr, int fq) const {
        const int row0 = u.pm * BM + wr * 64 + fr, col0 = u.pn * BM + wc * 32 + 4 * fq;
#pragma unroll
        for (int ai = 0; ai < 2; ++ai)
#pragma unroll
            for (int m = 0; m < 4; ++m) { const size_t off = (size_t)(row0 + ai * HALF + m * 16) * ldc + col0;
#pragma unroll
                for (int bj = 0; bj < 2; ++bj)
#pragma unroll
                    for (int n = 0; n < 2; ++n) { const f32x4 b = *(const f32x4*)(base + off + bj * HALF + n * 16); *(f32x4*)(out + off + bj * HALF + n * 16) = b + acc[ai][bj][m][n]; } }
    }
};
template <class Epi, class Sched, bool ALIGN_EPI = false, bool SP2 = false>
__device__ __forceinline__ void gemm_phase(PG8_LAS unsigned char* lds, const Gemm g, const Sched& S, const Epi& E) {
    const int tid = threadIdx.x, wid = __builtin_amdgcn_readfirstlane(tid >> 6), lane = tid & 63, wr = wid >> 2, wc = wid & 3, fr = lane & 15, fq = lane >> 4;
    const int K = g.K, nt = K / BK;
    unsigned voffA[2], voffB[2];
#pragma unroll
    for (int i = 0; i < 2; ++i) { int R, C; stage_rc(tid * 16 + i * 8192, R, C); const int Rb = Epi::PERM ? ((R & ~31) + perm32(R & 31)) : R;
        voffA[i] = (unsigned)(R * K + C) * 2u; voffB[i] = (unsigned)(Rb * K + C) * 2u; }
    const size_t kstep = (size_t)(BK * 2);
    const size_t hstep = (size_t)HALF * K * 2;
    const size_t tstep = 2 * hstep;
    const unsigned ldsw = (unsigned)wid * 1024u;
    const int aoff = lds_byte(wr * 64 + fr, fq * 8), boff = lds_byte(wc * 32 + fr, fq * 8);
#define PG8_SA(b, h) (((b) * 2 + (h)) * HTB)
#define PG8_SB(b, h) ((4 + (b) * 2 + (h)) * HTB)
#define PG8_STAGE(bufoff, gbase, voff) do { _Pragma("unroll") for (int _i = 0; _i < 2; ++_i) \
        __builtin_amdgcn_global_load_lds((const unsigned*)((const char*)(gbase) + (voff)[_i]), (PG8_LAS unsigned*)(lds + (bufoff) + ldsw + _i * 8192), 16, 0, 0); } while (0)
#define PG8_LDA(dst, b, h) do { _Pragma("unroll") for (int m = 0; m < 4; ++m) _Pragma("unroll") for (int k = 0; k < 2; ++k) dst[m][k] = *(const PG8_LAS bf16x8*)(lds + PG8_SA(b, h) + aoff + m * 2048 + k * 1024); } while (0)
#define PG8_LDB(dst, b, h) do { _Pragma("unroll") for (int n = 0; n < 2; ++n) _Pragma("unroll") for (int k = 0; k < 2; ++k) dst[n][k] = *(const PG8_LAS bf16x8*)(lds + PG8_SB(b, h) + boff + n * 2048 + k * 1024); } while (0)
#define PG8_MMA(ai, bj, At, Bt) do { __builtin_amdgcn_s_setprio(1); _Pragma("unroll") for (int m = 0; m < 4; ++m) _Pragma("unroll") for (int n = 0; n < 2; ++n) _Pragma("unroll") for (int k = 0; k < 2; ++k) \
        acc[ai][bj][m][n] = __builtin_amdgcn_mfma_f32_16x16x32_f16(__builtin_bit_cast(f16x8, Bt[n][k]), __builtin_bit_cast(f16x8, At[m][k]), acc[ai][bj][m][n], 0, 0, 0); __builtin_amdgcn_s_setprio(0); } while (0)
#define PG8_WAIT_V(n) asm volatile("s_waitcnt vmcnt(" #n ")" ::: "memory")
#define PG8_WAIT_L(n) asm volatile("s_waitcnt lgkmcnt(" #n ")" ::: "memory")
#define PG8_BAR __builtin_amdgcn_s_barrier()
#define PG8_SCHED __builtin_amdgcn_sched_barrier(0)
    Unit cur, nxt; int ui = 0;
    if (!S.next(0, cur)) return;
    f32x4 acc[2][2][4][2];
#pragma unroll
    for (int a = 0; a < 2; ++a)
#pragma unroll
        for (int b = 0; b < 2; ++b)
#pragma unroll
            for (int m = 0; m < 4; ++m)
#pragma unroll
                for (int n = 0; n < 2; ++n) acc[a][b][m][n] = (f32x4){0.f, 0.f, 0.f, 0.f};
    bf16x8 At[4][2], B0[2][2], B1[2][2];
    const char* cA = (const char*)g.A + (size_t)cur.pm * tstep; const char* cB = (const char*)g.Bt + (size_t)cur.pn * tstep;
    S.a_ready(cur);
    if constexpr (SP2) {
        PG8_STAGE(PG8_SB(0, 0), cB, voffB); PG8_STAGE(PG8_SB(0, 1), cB + hstep, voffB); PG8_STAGE(PG8_SA(0, 0), cA, voffA); PG8_STAGE(PG8_SA(0, 1), cA + hstep, voffA);
        if (wr == 1) PG8_BAR;
        PG8_WAIT_V(2); PG8_BAR;
        PG8_STAGE(PG8_SB(1, 0), cB + kstep, voffB); PG8_STAGE(PG8_SA(1, 0), cA + kstep, voffA); PG8_STAGE(PG8_SB(1, 1), cB + hstep + kstep, voffB);
        PG8_WAIT_V(6); PG8_BAR;
    } else {
        PG8_STAGE(PG8_SB(0, 0), cB, voffB); PG8_STAGE(PG8_SA(0, 0), cA, voffA); PG8_STAGE(PG8_SB(0, 1), cB + hstep, voffB); PG8_STAGE(PG8_SA(0, 1), cA + hstep, voffA);
        if (wr == 1) PG8_BAR;
        PG8_WAIT_V(4); PG8_BAR;
        PG8_STAGE(PG8_SB(1, 0), cB + kstep, voffB); PG8_STAGE(PG8_SA(1, 0), cA + kstep, voffA); PG8_STAGE(PG8_SB(1, 1), cB + hstep + kstep, voffB);
        PG8_WAIT_V(6); PG8_BAR;
    }
    for (;;) {
        const bool has_next = S.next(ui + 1, nxt);
        const char* nA = has_next ? (const char*)g.A + (size_t)nxt.pm * tstep : cA; const char* nB = has_next ? (const char*)g.Bt + (size_t)nxt.pn * tstep : cB;
        for (int t = 0; t < nt; t += 2) {
            const bool last = (t == nt - 2);
            const char* a1 = cA + (size_t)(t + 1) * kstep;
            const char* a2 = last ? nA : cA + (size_t)(t + 2) * kstep; const char* b2 = last ? nB : cB + (size_t)(t + 2) * kstep;
            const char* a3 = a2 + kstep; const char* b3 = b2 + kstep;
            if (last && has_next) S.a_ready(nxt);
            if constexpr (SP2) {
            PG8_LDB(B0, 0, 0); PG8_LDB(B1, 0, 1); PG8_SCHED; PG8_LDA(At, 0, 0); PG8_STAGE(PG8_SA(1, 1), a1 + hstep, voffA);
            PG8_WAIT_V(8); PG8_WAIT_L(0); PG8_BAR; PG8_MMA(0, 0, At, B0); PG8_MMA(0, 1, At, B1); PG8_BAR; PG8_SCHED;
            PG8_LDA(At, 0, 1); PG8_STAGE(PG8_SB(0, 0), b2, voffB); PG8_STAGE(PG8_SB(0, 1), b2 + hstep, voffB); PG8_STAGE(PG8_SA(0, 0), a2, voffA);
            PG8_WAIT_V(8); PG8_WAIT_L(0); PG8_BAR; PG8_MMA(1, 0, At, B0); PG8_MMA(1, 1, At, B1); PG8_BAR; PG8_SCHED;
            PG8_LDB(B0, 1, 0); PG8_LDB(B1, 1, 1); PG8_SCHED; PG8_LDA(At, 1, 0); PG8_STAGE(PG8_SA(0, 1), a2 + hstep, voffA);
            PG8_WAIT_V(8); PG8_WAIT_L(0); PG8_BAR; PG8_MMA(0, 0, At, B0); PG8_MMA(0, 1, At, B1); PG8_BAR; PG8_SCHED;
            PG8_LDA(At, 1, 1); PG8_STAGE(PG8_SB(1, 0), b3, voffB); PG8_STAGE(PG8_SB(1, 1), b3 + hstep, voffB); PG8_STAGE(PG8_SA(1, 0), a3, voffA);
            PG8_WAIT_V(8); PG8_WAIT_L(0); PG8_BAR; PG8_MMA(1, 0, At, B0); PG8_MMA(1, 1, At, B1); PG8_BAR; PG8_SCHED;
            } else {
            PG8_LDB(B0, 0, 0); PG8_SCHED; PG8_LDA(At, 0, 0); PG8_STAGE(PG8_SA(1, 1), a1 + hstep, voffA);
            PG8_WAIT_L(8); PG8_BAR; PG8_WAIT_L(0); PG8_MMA(0, 0, At, B0); PG8_BAR; PG8_SCHED;
            PG8_LDB(B1, 0, 1); PG8_STAGE(PG8_SB(0, 0), b2, voffB);
            PG8_BAR; PG8_WAIT_L(0); PG8_MMA(0, 1, At, B1); PG8_BAR;
            PG8_LDA(At, 0, 1); PG8_STAGE(PG8_SA(0, 0), a2, voffA);
            PG8_BAR; PG8_WAIT_L(0); PG8_MMA(1, 0, At, B0); PG8_BAR; PG8_SCHED;
            PG8_STAGE(PG8_SB(0, 1), b2 + hstep, voffB);
            PG8_WAIT_V(6); PG8_BAR; PG8_MMA(1, 1, At, B1); PG8_BAR;
            PG8_LDB(B0, 1, 0); PG8_SCHED; PG8_LDA(At, 1, 0); PG8_STAGE(PG8_SA(0, 1), a2 + hstep, voffA);
            PG8_WAIT_L(8); PG8_BAR; PG8_WAIT_L(0); PG8_MMA(0, 0, At, B0); PG8_BAR; PG8_SCHED;
            PG8_LDB(B1, 1, 1); PG8_STAGE(PG8_SB(1, 0), b3, voffB);
            PG8_BAR; PG8_WAIT_L(0); PG8_MMA(0, 1, At, B1); PG8_BAR;
            PG8_LDA(At, 1, 1); PG8_STAGE(PG8_SA(1, 0), a3, voffA);
            PG8_BAR; PG8_WAIT_L(0); PG8_MMA(1, 0, At, B0); PG8_BAR; PG8_SCHED;
            PG8_STAGE(PG8_SB(1, 1), b3 + hstep, voffB);
            PG8_WAIT_V(6); PG8_BAR; PG8_MMA(1, 1, At, B1); PG8_BAR;
            }
        }
        if constexpr (ALIGN_EPI) { if (wr == 0) PG8_BAR; }
        if constexpr (!Epi::AFTER_DRAIN) { E(acc, cur, wr, wc, fr, fq); S.done(cur); }
        if (!has_next) break;
#pragma unroll
        for (int a = 0; a < 2; ++a)
#pragma unroll
            for (int b = 0; b < 2; ++b)
#pragma unroll
                for (int m = 0; m < 4; ++m)
#pragma unroll
                    for (int n = 0; n < 2; ++n) acc[a][b][m][n] = (f32x4){0.f, 0.f, 0.f, 0.f};
        cur = nxt; cA = nA; cB = nB; ++ui;
        if constexpr (ALIGN_EPI) { if (wr == 1) PG8_BAR; }
    }
    PG8_WAIT_V(0);
    if constexpr (!ALIGN_EPI) { if (wr == 0) PG8_BAR; }
    PG8_BAR;
    if constexpr (Epi::AFTER_DRAIN) { E.fused(acc, cur, wr, wc, fr, fq, lds, wid, lane); S.done(cur); }
#undef PG8_SA
#undef PG8_SB
#undef PG8_STAGE
#undef PG8_LDA
#undef PG8_LDB
#undef PG8_MMA
#undef PG8_WAIT_V
#undef PG8_WAIT_L
#undef PG8_BAR
#undef PG8_SCHED
}
}


#define XB_TMO      128
#define XB_XCNT(j)  (256  + 64 * (j))
#define XB_XSUB(j)  (1280 + 64 * (j))
#define XB_XGEN(j)  (2304 + 64 * (j))
#define XB_TOP      3328
#define XB_TOPGEN   3392
#define XCD_BAR_WORDS 3456
#define XB_SPIN_CAP (1u << 18)

__device__ __forceinline__ unsigned xb_ld(unsigned* p)              { return __hip_atomic_load(p, __ATOMIC_RELAXED, __HIP_MEMORY_SCOPE_AGENT); }
__device__ __forceinline__ unsigned xb_add(unsigned* p, unsigned v) { return __hip_atomic_fetch_add(p, v, __ATOMIC_RELAXED, __HIP_MEMORY_SCOPE_AGENT); }
__device__ __forceinline__ unsigned xb_xcc_id() { return (unsigned)__builtin_amdgcn_s_getreg((3 << 11) | 20) & 0xFu; }
#define XB_SPIN(cond, bar) do { unsigned _sp = 0; while (cond) { __builtin_amdgcn_s_sleep(1); \
    if ((++_sp & 255u) == 0u) { if (xb_ld(&(bar)[XB_TMO])) break; if (_sp > XB_SPIN_CAP) { atomicAdd(&(bar)[XB_TMO], 1u); break; } } } } while (0)

struct XcdBarrier {
    unsigned* bar; unsigned x;
    volatile LAS unsigned* st;
};

__device__ __forceinline__ XcdBarrier xcd_barrier_post(unsigned* bar, volatile LAS unsigned* st) {
    XcdBarrier b; b.bar = bar; b.x = xb_xcc_id(); b.st = st;
    if (threadIdx.x == 0) (void)xb_add(&bar[XB_XCNT(b.x)], 1u);
    return b;
}
__device__ __forceinline__ void xcd_barrier_complete(unsigned* bar, unsigned x, unsigned& nloc, unsigned& nx) {
    const unsigned G = gridDim.x * gridDim.y * gridDim.z;
    unsigned sum, cnt, mine, sp = 0u;
    for (;;) {
        sum = 0u; cnt = 0u; mine = 0u;
#pragma unroll
        for (unsigned j = 0; j < 16; ++j) { const unsigned c = xb_ld(&bar[XB_XCNT(j)]); sum += c; cnt += (c > 0u) ? 1u : 0u; mine = (j == x) ? c : mine; }
        if (sum == G) break;
        __builtin_amdgcn_s_sleep(1);
        if ((++sp & 255u) == 0u) { if (xb_ld(&bar[XB_TMO])) break; if (sp > XB_SPIN_CAP) { atomicAdd(&bar[XB_TMO], 1u); break; } }
    }
    nloc = mine > 0u ? mine : 1u; nx = cnt > 0u ? cnt : 1u;
}

__device__ __forceinline__ void xcd_barrier(const XcdBarrier& b) {
    asm volatile("s_waitcnt vmcnt(0)" ::: "memory");
    __syncthreads();
    if (threadIdx.x == 0) {
        unsigned* bar = b.bar;
        __builtin_amdgcn_s_waitcnt(0);
        unsigned nloc = b.st[0], nx = b.st[1];
        if (nloc == 0u) { xcd_barrier_complete(bar, b.x, nloc, nx); b.st[0] = nloc; b.st[1] = nx; }
        const unsigned old = xb_add(&bar[XB_XSUB(b.x)], 1u);
        const unsigned gen = old / nloc;
        if (old + 1u == (gen + 1u) * nloc) {
            __builtin_amdgcn_fence(__ATOMIC_RELEASE, "agent");
            asm volatile("s_waitcnt vmcnt(0)" ::: "memory");
            const unsigned og = xb_add(&bar[XB_TOP], 1u);
            const unsigned tg = og / nx;
            if (og + 1u == (tg + 1u) * nx) xb_add(&bar[XB_TOPGEN], 1u);
            else XB_SPIN(xb_ld(&bar[XB_TOPGEN]) == tg, bar);
            __builtin_amdgcn_fence(__ATOMIC_ACQUIRE, "agent");
            xb_add(&bar[XB_XGEN(b.x)], 1u);
            asm volatile("s_waitcnt vmcnt(0)" ::: "memory");
        } else {
            XB_SPIN(xb_ld(&bar[XB_XGEN(b.x)]) == gen, bar);
            __builtin_amdgcn_fence(__ATOMIC_ACQUIRE, "agent");
            asm volatile("s_waitcnt vmcnt(0)" ::: "memory");
        }
    }
    __syncthreads();
}

__device__ __forceinline__ void mlstm_naive(const Frame& F, LAS unsigned char* lds) {
    LAS float* qs = (LAS float*)lds; LAS float* ks = qs + 64; LAS float* part = ks + 64; LAS float* red = part + 512;
    const int tid = F.tid, e = tid & 127, qd = tid >> 7;
    for (int unit = blockIdx.x; unit < NB * 4; unit += gridDim.x) {
        const int b = unit >> 2, h = unit & 3;
        float C[16]; float n_d = 0.f, m = 0.f;
#pragma unroll
        for (int i = 0; i < 16; ++i) C[i] = 0.f;
        const float ib = F.i_bias[h], fb = F.f_bias[h];
        for (int t = 0; t < S; ++t) {
            const size_t row = (size_t)b * S + t;
            if (tid < 128) {
                const int cc = (tid < 64) ? (h * 64 + tid) : (256 + h * 64 + (tid - 64));
                float a = F.conv_b[cc];
#pragma unroll
                for (int j = 0; j < 4; ++j) { const int tt = t - 3 + j; if (tt >= 0) a += F.conv_w[j * 512 + cc] * (float)F.Z[(row - 3 + j) * ZP + cc]; }
                float v = a * sigmoidf_(a);
                if (tid < 64) qs[tid] = v * 0.125f; else ks[tid - 64] = v;
            }
            const float ig = F.GATES[row * 16 + h] + ib, fp = F.GATES[row * 16 + 4 + h] + fb;
            const float logf = fminf(fp, 0.f) - log1pf(__expf(-fabsf(fp)));
            const float m_new = fmaxf(logf + m, ig), fs = __expf(logf + m - m_new), is = __expf(ig - m_new); m = m_new;
            __syncthreads();
            const float ve = (float)F.Z[row * ZP + ZC_MV + h * 128 + e];
            float pn = 0.f;
#pragma unroll
            for (int i = 0; i < 16; ++i) { const int d = qd * 16 + i; C[i] = fs * C[i] + is * ks[d] * ve; pn += qs[d] * C[i]; }
            part[qd * 128 + e] = pn;
            if (tid < 64) { n_d = fs * n_d + is * ks[tid]; const float dn = wave_sum(qs[tid] * n_d); if (tid == 0) red[0] = dn; }
            __syncthreads();
            float hv = 0.f;
            if (tid < 128) {
                const float num = (part[e] + part[128 + e]) + (part[256 + e] + part[384 + e]), den = red[0];
                hv = num / fmaxf(fabsf(den), __expf(-m));
                const float sq = wave_sum(hv * hv); if (F.lane == 0) red[1 + F.wave] = sq;
            }
            __syncthreads();
            if (tid < 128) {
                const float r = 1.f / sqrtf((red[1] + red[2]) * (1.f / 128.f) + EPS);
                const float og = (float)F.Z[row * ZP + ZC_MO + h * 128 + e];
                F.MIX[row * D + h * 128 + e] = (h16)(hv * r * F.mlstm_norm[h * 128 + e] * sigmoidf_(og));
            }
        }
        __syncthreads();
    }
}

constexpr int LQ = 72;
constexpr int LW = 136;
typedef _Float16 h16x4 __attribute__((ext_vector_type(4)));

__device__ __forceinline__ void conv_silu8(const Frame& F, size_t row, int t, int cb, float (&o)[8]) {
#pragma unroll
    for (int i = 0; i < 8; ++i) o[i] = F.conv_b[cb + i];
#pragma unroll
    for (int j = 0; j < 4; ++j) {
        if (t - 3 + j >= 0) {
            const h16x8 z = *(const h16x8*)(F.Z + (row - 3 + j) * ZP + cb);
#pragma unroll
            for (int i = 0; i < 8; ++i) o[i] += F.conv_w[j * 512 + cb + i] * (float)z[i];
        }
    }
#pragma unroll
    for (int i = 0; i < 8; ++i) o[i] = o[i] * sigmoidf_(o[i]);
}
__device__ __forceinline__ float wave_scan_add(float x, int lane) {
#pragma unroll
    for (int o = 1; o < 64; o <<= 1) { const float v = __shfl_up(x, o); if (lane >= o) x += v; }
    return x;
}
__device__ __forceinline__ float wave_scan_max(float x, int lane) {
#pragma unroll
    for (int o = 1; o < 64; o <<= 1) { const float v = __shfl_up(x, o); if (lane >= o) x = fmaxf(x, v); }
    return x;
}

__device__ __forceinline__ void mlstm_A(const Frame& F, LAS unsigned char* lds) {
    LAS h16* KT = (LAS h16*)lds;
    LAS h16* VT = KT + 64 * LQ;
    LAS float* wg = (LAS float*)(VT + 128 * LQ);
    const int tid = F.tid, lane = F.lane, w = F.wave, fr = lane & 15, fq = lane >> 4;
    for (int u = blockIdx.x; u < NB * 4 * 64; u += gridDim.x) {
        const int c = u & 63, h = (u >> 6) & 3, b = u >> 8; const size_t row0 = (size_t)b * S + c * 64;
        if (w == 0) {
            const float ig = F.GATES[(row0 + lane) * 16 + h] + F.i_bias[h], fp = F.GATES[(row0 + lane) * 16 + 4 + h] + F.f_bias[h];
            const float logf = fminf(fp, 0.f) - log1pf(__expf(-fabsf(fp)));
            const float bl = wave_scan_add(logf, lane), g = __shfl(bl, 63);
            const float a = g - bl + ig, ml = wave_max(a);
            wg[lane] = __expf(a - ml);
            if (lane == 0) { F.G[u] = g; F.MLOC[u] = ml; }
        }
        __syncthreads();
        { const int l = tid >> 3, c8 = (tid & 7) * 8; float o[8]; conv_silu8(F, row0 + l, c * 64 + l, ZC_MK + h * 64 + c8, o);
#pragma unroll
          for (int i = 0; i < 8; ++i) KT[(c8 + i) * LQ + l] = (h16)o[i]; }
#pragma unroll
        for (int j = 0; j < 2; ++j) { const int id = tid + 512 * j, l = id >> 4, e8 = (id & 15) * 8; const float wl = wg[l];
            const h16x8 v = *(const h16x8*)(F.Z + (row0 + l) * ZP + ZC_MV + h * 128 + e8);
#pragma unroll
            for (int i = 0; i < 8; ++i) VT[(e8 + i) * LQ + l] = (h16)((float)v[i] * wl); }
        __syncthreads();
        f32x4 acc[4];
#pragma unroll
        for (int db = 0; db < 4; ++db) acc[db] = (f32x4){0.f, 0.f, 0.f, 0.f};
#pragma unroll
        for (int ks = 0; ks < 2; ++ks) {
            const h16x8 a = *(const LAS h16x8*)(VT + (16 * w + fr) * LQ + 32 * ks + 8 * fq);
#pragma unroll
            for (int db = 0; db < 4; ++db) { const h16x8 bb = *(const LAS h16x8*)(KT + (16 * db + fr) * LQ + 32 * ks + 8 * fq);
                acc[db] = __builtin_amdgcn_mfma_f32_16x16x32_f16(a, bb, acc[db], 0, 0, 0); }
        }
        float* kvt = F.KVT + (size_t)u * 8192;
#pragma unroll
        for (int db = 0; db < 4; ++db)
#pragma unroll
            for (int i = 0; i < 4; ++i) kvt[(16 * w + 4 * fq + i) * 64 + 16 * db + fr] = acc[db][i];
        if (tid < 64) { float s = 0.f; for (int l = 0; l < 64; ++l) s += wg[l] * (float)KT[tid * LQ + l]; F.KS[(size_t)u * 64 + tid] = s; }
        __syncthreads();
    }
}

__device__ __forceinline__ void mlstm_B(const Frame& F) {
    typedef float f32x2 __attribute__((ext_vector_type(2)));
    const int tid = F.tid;
    for (int slot = blockIdx.x; slot < 256; slot += gridDim.x) {
        const int bh = slot >> 3, part = slot & 7; const int idx = part * 1024 + tid * 2;
        float* base = F.KVT + (size_t)bh * 64 * 8192 + idx;
        const bool do_n = (part == 0 && tid < 64);
        f32x2 st = (f32x2){0.f, 0.f}; float nst = 0.f, m = 0.f;
        for (int c0 = 0; c0 < 64; c0 += 8) {
            f32x2 kv[8]; float ksv[8];
#pragma unroll
            for (int j = 0; j < 8; ++j) { kv[j] = *(const f32x2*)(base + (size_t)(c0 + j) * 8192); ksv[j] = do_n ? F.KS[(size_t)(bh * 64 + c0 + j) * 64 + tid] : 0.f; }
#pragma unroll
            for (int j = 0; j < 8; ++j) {
                const int u = bh * 64 + c0 + j; const float g = F.G[u], ml = F.MLOC[u];
                *(f32x2*)(base + (size_t)(c0 + j) * 8192) = st;
                if (do_n) F.KS[(size_t)u * 64 + tid] = nst;
                if (part == 0 && tid == 0) F.MPREV[u] = m;
                const float mn = fmaxf(g + m, ml), dec = __expf(g + m - mn), sc = __expf(ml - mn);
                st = dec * st + sc * kv[j]; nst = dec * nst + sc * ksv[j]; m = mn;
            }
        }
    }
}

__device__ __forceinline__ void mlstm_C(const Frame& F, LAS unsigned char* lds) {
    LAS h16* Qs = (LAS h16*)lds;
    LAS h16* Ks = Qs + 64 * LQ;
    LAS h16* QS = Ks + 64 * LQ;
    LAS h16* BT = QS + 64 * LW;
    LAS float* fa = (LAS float*)(BT + 128 * LW);
    LAS float *ul = fa, *wl = fa + 64, *iw = fa + 128, *emt = fa + 192, *den = fa + 256, *nb = fa + 320, *rowsq = fa + 384;
    const int tid = F.tid, lane = F.lane, w = F.wave, fr = lane & 15, fq = lane >> 4;
    for (int u = blockIdx.x; u < NB * 4 * 64; u += gridDim.x) {
        const int c = u & 63, h = (u >> 6) & 3, b = u >> 8; const size_t row0 = (size_t)b * S + c * 64;
        if (w == 0) {
            const float ig = F.GATES[(row0 + lane) * 16 + h] + F.i_bias[h], fp = F.GATES[(row0 + lane) * 16 + 4 + h] + F.f_bias[h];
            const float logf = fminf(fp, 0.f) - log1pf(__expf(-fabsf(fp)));
            const float bl = wave_scan_add(logf, lane), ww = ig - bl, pm = wave_scan_max(ww, lane);
            const float il = bl + F.MPREV[u], mt = fmaxf(il, bl + pm);
            ul[lane] = bl - mt; wl[lane] = ww; iw[lane] = __expf(il - mt); emt[lane] = __expf(-mt);
        }
        if (tid < 64) nb[tid] = F.KS[(size_t)u * 64 + tid];
        { const int l = tid >> 3, c8 = (tid & 7) * 8; float o[8];
          conv_silu8(F, row0 + l, c * 64 + l, ZC_MQ + h * 64 + c8, o);
          h16x8 hv;
#pragma unroll
          for (int i = 0; i < 8; ++i) hv[i] = (h16)(o[i] * 0.125f);
          *(LAS h16x8*)(Qs + l * LQ + c8) = hv;
          conv_silu8(F, row0 + l, c * 64 + l, ZC_MK + h * 64 + c8, o);
#pragma unroll
          for (int i = 0; i < 8; ++i) hv[i] = (h16)o[i];
          *(LAS h16x8*)(Ks + l * LQ + c8) = hv; }
#pragma unroll
        for (int j = 0; j < 2; ++j) { const int id = tid + 512 * j;
            { const int l = id >> 4, e8 = (id & 15) * 8; const h16x8 v = *(const h16x8*)(F.Z + (row0 + l) * ZP + ZC_MV + h * 128 + e8);
#pragma unroll
              for (int i = 0; i < 8; ++i) BT[(e8 + i) * LW + 64 + l] = v[i]; }
            { const int e = id >> 3, d8 = (id & 7) * 8; const float* cp = F.KVT + (size_t)u * 8192 + e * 64 + d8; const f32x4 c0 = *(const f32x4*)cp, c1 = *(const f32x4*)(cp + 4);
              h16x8 hv; hv[0] = (h16)c0[0]; hv[1] = (h16)c0[1]; hv[2] = (h16)c0[2]; hv[3] = (h16)c0[3]; hv[4] = (h16)c1[0]; hv[5] = (h16)c1[1]; hv[6] = (h16)c1[2]; hv[7] = (h16)c1[3];
              *(LAS h16x8*)(BT + e * LW + d8) = hv; } }
        __syncthreads();
        { const int l = tid >> 3, c8 = (tid & 7) * 8; const h16x8 q = *(const LAS h16x8*)(Qs + l * LQ + c8); const float s = iw[l]; h16x8 hv;
#pragma unroll
          for (int i = 0; i < 8; ++i) hv[i] = (h16)((float)q[i] * s);
          *(LAS h16x8*)(QS + l * LW + c8) = hv; }
#pragma unroll
        for (int tt = 0; tt < 2; ++tt) {
            const int lb = w & 3, sb = 2 * (w >> 2) + tt;
            f32x4 acc = (f32x4){0.f, 0.f, 0.f, 0.f};
            if (sb <= lb) {
#pragma unroll
                for (int ks = 0; ks < 2; ++ks) { const h16x8 a = *(const LAS h16x8*)(Qs + (16 * lb + fr) * LQ + 32 * ks + 8 * fq), bb = *(const LAS h16x8*)(Ks + (16 * sb + fr) * LQ + 32 * ks + 8 * fq);
                    acc = __builtin_amdgcn_mfma_f32_16x16x32_f16(a, bb, acc, 0, 0, 0); }
            }
            const int s = 16 * sb + fr; const float ws = wl[s];
#pragma unroll
            for (int i = 0; i < 4; ++i) { const int l = 16 * lb + 4 * fq + i; const float v = (s <= l) ? acc[i] * __expf(ul[l] + ws) : 0.f; QS[l * LW + 64 + s] = (h16)v; }
        }
        __syncthreads();
        { const int l = tid >> 3, part = tid & 7; float s = 0.f;
#pragma unroll
          for (int j = 0; j < 2; ++j) { const h16x8 q = *(const LAS h16x8*)(QS + l * LW + 16 * part + 8 * j);
#pragma unroll
              for (int i = 0; i < 8; ++i) { const int k = 16 * part + 8 * j + i; s += (float)q[i] * (k < 64 ? nb[k] : 1.f); } }
          s += __shfl_xor(s, 1); s += __shfl_xor(s, 2); s += __shfl_xor(s, 4);
          if (part == 0) den[l] = s; }
        f32x4 acc[4];
#pragma unroll
        for (int lb = 0; lb < 4; ++lb) acc[lb] = (f32x4){0.f, 0.f, 0.f, 0.f};
#pragma unroll
        for (int ks = 0; ks < 4; ++ks) { const h16x8 bb = *(const LAS h16x8*)(BT + (16 * w + fr) * LW + 32 * ks + 8 * fq);
#pragma unroll
            for (int lb = 0; lb < 4; ++lb) { const h16x8 a = *(const LAS h16x8*)(QS + (16 * lb + fr) * LW + 32 * ks + 8 * fq);
                acc[lb] = __builtin_amdgcn_mfma_f32_16x16x32_f16(a, bb, acc[lb], 0, 0, 0); } }
        __syncthreads();
#pragma unroll
        for (int lb = 0; lb < 4; ++lb)
#pragma unroll
            for (int i = 0; i < 4; ++i) { const int l = 16 * lb + 4 * fq + i; const float hv = acc[lb][i] / fmaxf(fabsf(den[l]), emt[l]); acc[lb][i] = hv;
                float sq = hv * hv; sq += __shfl_xor(sq, 1); sq += __shfl_xor(sq, 2); sq += __shfl_xor(sq, 4); sq += __shfl_xor(sq, 8);
                if (fr == 0) rowsq[w * 64 + l] = sq; }
        __syncthreads();
        const int e = 16 * w + fr; const float gn = F.mlstm_norm[h * 128 + e];
#pragma unroll
        for (int lb = 0; lb < 4; ++lb)
#pragma unroll
            for (int i = 0; i < 4; ++i) { const int l = 16 * lb + 4 * fq + i; float tot = 0.f;
#pragma unroll
                for (int ww = 0; ww < 8; ++ww) tot += rowsq[ww * 64 + l];
                const float r = 1.f / sqrtf(tot * (1.f / 128.f) + EPS);
                const float og = (float)F.Z[(row0 + l) * ZP + ZC_MO + h * 128 + e];
                F.MIX[(row0 + l) * D + h * 128 + e] = (h16)(acc[lb][i] * r * gn * sigmoidf_(og)); }
        __syncthreads();
    }
}

__device__ __forceinline__ void kn_phase(const Frame& F) {
    const int gw = blockIdx.x * 8 + F.wave, NGW = gridDim.x * 8;
    const float g = F.idx_k_norm[F.lane];
    for (int m = gw; m < T; m += NGW) {
        const float v = (float)F.Z[(size_t)m * ZP + ZC_IK + F.lane];
        const float r = 1.f / sqrtf(wave_sum(v * v) * (1.f / 64.f) + EPS);
        F.KN[(size_t)m * 64 + F.lane] = (h16)(v * r * g);
    }
}

__device__ __forceinline__ unsigned ord_key(float f) { const unsigned u = __float_as_uint(f); return (u & 0x80000000u) ? ~u : (u | 0x80000000u); }

__device__ __forceinline__ void index_naive(const Frame& F, LAS unsigned char* lds) {
    LAS float* qf = (LAS float*)lds;
    LAS float* wq = qf + 512;
    LAS unsigned* cnt = (LAS unsigned*)(wq + 8);
    LAS unsigned* keys = cnt + 40;
    const int tid = F.tid;
    for (int row = blockIdx.x; row < T; row += gridDim.x) {
        const int t = row & (S - 1), b = row >> 12;
        __syncthreads();
        qf[tid] = (float)F.Z[(size_t)row * ZP + ZC_IQ + tid];
        if (tid < 8) wq[tid] = F.GATES[(size_t)row * 16 + 8 + tid] * 0.35355339059327373f;
        if (tid < 40) cnt[tid] = 0u;
        __syncthreads();
        unsigned kk[8];
#pragma unroll
        for (int j = 0; j < 8; ++j) {
            const int s = tid + 512 * j; kk[j] = 0u;
            if (s <= t) {
                const h16* kr = F.KN + ((size_t)b * S + s) * 64;
                float kf[64];
#pragma unroll
                for (int c = 0; c < 8; ++c) { const h16x8 v = *(const h16x8*)(kr + 8 * c);
#pragma unroll
                    for (int i = 0; i < 8; ++i) kf[8 * c + i] = (float)v[i]; }
                float score = 0.f;
#pragma unroll
                for (int hh = 0; hh < 8; ++hh) { float dot = 0.f;
#pragma unroll
                    for (int d = 0; d < 64; ++d) dot += qf[hh * 64 + d] * kf[d];
                    score += fmaxf(dot * 0.125f, 0.f) * wq[hh]; }
                kk[j] = ord_key(score); keys[s] = kk[j];
            }
        }
        unsigned vstar = 0u;
        if (t >= TOPK) {
            unsigned prefix = 0u;
            for (int bit = 31; bit >= 0; --bit) {
                const unsigned cand = prefix | (1u << bit); int c = 0;
#pragma unroll
                for (int j = 0; j < 8; ++j) c += (kk[j] >= cand) ? 1 : 0;
                c = wave_isum(c); if (F.lane == 0) atomicAdd((unsigned*)&cnt[bit], (unsigned)c);
                __syncthreads();
                if (cnt[bit] >= (unsigned)TOPK) prefix = cand;
            }
            vstar = prefix;
            int cg = 0, ce = 0;
#pragma unroll
            for (int j = 0; j < 8; ++j) { cg += (kk[j] > vstar) ? 1 : 0; ce += (kk[j] == vstar) ? 1 : 0; }
            cg = wave_isum(cg); ce = wave_isum(ce);
            if (F.lane == 0) { atomicAdd((unsigned*)&cnt[32], (unsigned)cg); atomicAdd((unsigned*)&cnt[33], (unsigned)ce); }
            __syncthreads();
            const int need = TOPK - (int)cnt[32];
            if ((int)cnt[33] > need) {
                if (tid == 0) { int nd = need; for (int s = 0; s <= t; ++s) if (keys[s] == vstar) { if (nd > 0) --nd; else keys[s] = 0u; } }
            }
        }
        __syncthreads();
        if (tid < 128) {
            unsigned word = 0u;
            for (int i = 0; i < 32; ++i) { const int s = 32 * tid + i; if (s <= t && keys[s] >= vstar) word |= (1u << i); }
            F.BM[(size_t)row * 128 + tid] = word;
        }
    }
}

typedef float f32x16 __attribute__((ext_vector_type(16)));
__device__ __forceinline__ size_t bm_index(int b, int t, int kt) { return ((((size_t)(b * 128 + (t >> 5)) * 64 + kt) * 32) + (t & 31)) * 2; }

__device__ __forceinline__ void index_mfma(const Frame& F, LAS unsigned char* lds) {
    LAS unsigned* keys = (LAS unsigned*)lds;
    const int lane = F.lane, w = F.wave, c32 = lane & 31, hi = lane >> 5;
    const int qa = 2 * ((c32 >> 2) & 1) + ((((c32 & 3) + 4 * (c32 >> 3))) >> 3), ha = ((c32 & 3) + 4 * (c32 >> 3)) & 7;
    for (int unit = blockIdx.x; unit < NB * 512; unit += gridDim.x) {
        const int b = unit & 7, qg = unit >> 3, t0 = 8 * qg; const size_t rowbase = (size_t)b * S;
        const int ntile = (t0 + 7) / 32 + 1, L = 32 * ntile;
        h16x8 a[2][4]; float wv[2][16];
#pragma unroll
        for (int blk = 0; blk < 2; ++blk) {
#pragma unroll
            for (int ks = 0; ks < 4; ++ks) a[blk][ks] = *(const h16x8*)(F.Z + (rowbase + t0 + 4 * blk + qa) * ZP + ZC_IQ + ha * 64 + 16 * ks + 8 * hi);
#pragma unroll
            for (int qq = 0; qq < 2; ++qq) { const float* gp = F.GATES + (rowbase + t0 + 4 * blk + 2 * hi + qq) * 16 + 8; const f32x4 g0 = *(const f32x4*)gp, g1 = *(const f32x4*)(gp + 4);
#pragma unroll
                for (int i = 0; i < 4; ++i) { wv[blk][qq * 8 + i] = g0[i] * (0.125f * 0.35355339059327373f); wv[blk][qq * 8 + 4 + i] = g1[i] * (0.125f * 0.35355339059327373f); } }
        }
        for (int tile = w; tile < ntile; tile += 8) {
            const h16* kp = F.KN + (rowbase + 32 * tile + c32) * 64 + 8 * hi;
            h16x8 bf[4];
#pragma unroll
            for (int ks = 0; ks < 4; ++ks) bf[ks] = *(const h16x8*)(kp + 16 * ks);
            const int s = 32 * tile + c32;
#pragma unroll
            for (int blk = 0; blk < 2; ++blk) {
                f32x16 acc;
#pragma unroll
                for (int i = 0; i < 16; ++i) acc[i] = 0.f;
#pragma unroll
                for (int ks = 0; ks < 4; ++ks) acc = __builtin_amdgcn_mfma_f32_32x32x16_f16(a[blk][ks], bf[ks], acc, 0, 0, 0);
#pragma unroll
                for (int qq = 0; qq < 2; ++qq) { float sc = 0.f;
#pragma unroll
                    for (int hh = 0; hh < 8; ++hh) sc += fmaxf(acc[qq * 8 + hh], 0.f) * wv[blk][qq * 8 + hh];
                    const int ql = 4 * blk + 2 * hi + qq;
                    keys[ql * 4096 + s] = (s <= t0 + ql) ? ord_key(sc) : 0u; }
            }
        }
        __syncthreads();
        {
            const int t = t0 + w, nj = (L + 63) >> 6; const LAS unsigned* kr = keys + w * 4096;
            unsigned kk[64];
#pragma unroll
            for (int g = 0; g < 8; ++g) {
                if (8 * g < nj) {
#pragma unroll
                    for (int i = 0; i < 8; ++i) { const int s = 64 * (8 * g + i) + lane; kk[8 * g + i] = (s < L) ? kr[s] : 0u; }
                } else {
#pragma unroll
                    for (int i = 0; i < 8; ++i) kk[8 * g + i] = 0u;
                }
            }
            unsigned vstar = 0u; int allowed = 0;
            if (t >= TOPK) {
                unsigned prefix = 0u;
                for (int bit = 31; bit >= 0; --bit) {
                    const unsigned cand = prefix | (1u << bit); int cnt = 0;
#pragma unroll
                    for (int g = 0; g < 8; ++g) if (8 * g < nj) {
#pragma unroll
                        for (int i = 0; i < 8; ++i) cnt += __popcll(__ballot(kk[8 * g + i] >= cand)); }
                    if (cnt >= TOPK) prefix = cand;
                }
                vstar = prefix; int cgt = 0;
#pragma unroll
                for (int g = 0; g < 8; ++g) if (8 * g < nj) {
#pragma unroll
                    for (int i = 0; i < 8; ++i) cgt += __popcll(__ballot(kk[8 * g + i] > vstar)); }
                allowed = TOPK - cgt;
            }
            unsigned mlo = 0u, mhi = 0u;
#pragma unroll
            for (int j = 0; j < 64; ++j) {
                unsigned long long m = 0ull;
                if (j < nj) {
                    const unsigned long long gt = __ballot(kk[j] > vstar); unsigned long long eq = __ballot(kk[j] == vstar);
                    if (allowed <= 0) eq = 0ull;
                    else { while (__popcll(eq) > allowed) eq &= ~(1ull << (63 - __clzll(eq))); allowed -= __popcll(eq); }
                    m = gt | eq;
                }
                if (lane == j) { mlo = (unsigned)m; mhi = (unsigned)(m >> 32); }
            }
            typedef unsigned u32x2 __attribute__((ext_vector_type(2)));
            *(u32x2*)(F.BM + bm_index(b, t, lane)) = (u32x2){mlo, mhi};
        }
        __syncthreads();
    }
}

__device__ __forceinline__ void attn_naive(const Frame& F, LAS unsigned char* lds) {
    LAS float* qf = (LAS float*)lds;
    LAS float* p = qf + 512;
    LAS int* sel = (LAS int*)(p + 2048);
    LAS int* pcs = sel + 288;
    LAS float* btab = (LAS float*)(pcs + 128);
    LAS int* nselp = (LAS int*)(btab + 1024);
    const int tid = F.tid, hh = F.wave, lane = F.lane;
    for (int i = tid; i < 1024; i += NTHR) {
        const int dist = i >> 3, h = i & 7; int bk;
        if (dist < 16) bk = dist; else { bk = 16 + (int)(log((double)dist / 16.0) / log(8.0) * 16.0); if (bk > 31) bk = 31; }
        btab[i] = F.rel_bias[bk * 8 + h];
    }
    for (int row = blockIdx.x; row < T; row += gridDim.x) {
        const int t = row & (S - 1), b = row >> 12;
        __syncthreads();
        unsigned word = 0u;
        if (tid < 128) { word = F.BM[bm_index(b, t, tid >> 1) + (tid & 1)]; pcs[tid] = __popc(word); }
        qf[tid] = (float)F.Z[(size_t)row * ZP + ZC_AQ + tid];
        __syncthreads();
        if (tid < 128) {
            int off = 0; for (int i = 0; i < tid; ++i) off += pcs[i];
            if (tid == 127) *nselp = off + pcs[127];
            while (word) { const int bpos = __ffs(word) - 1; word &= word - 1; if (off < 288) sel[off] = 32 * tid + bpos; ++off; }
        }
        __syncthreads();
        const int nsel = min(*nselp, 256);
        float lg[4]; float mx = -INFINITY;
#pragma unroll
        for (int jj = 0; jj < 4; ++jj) {
            const int j = lane + 64 * jj; lg[jj] = -INFINITY;
            if (j < nsel) {
                const int s = sel[j]; const h16* kr = F.Z + ((size_t)b * S + s) * ZP + ZC_AK + hh * 64;
                float dot = 0.f;
#pragma unroll
                for (int c = 0; c < 8; ++c) { const h16x8 v = *(const h16x8*)(kr + 8 * c);
#pragma unroll
                    for (int i = 0; i < 8; ++i) dot += qf[hh * 64 + 8 * c + i] * (float)v[i]; }
                const int dist = t - s;
                lg[jj] = dot * 0.125f + btab[(dist < 127 ? dist : 127) * 8 + hh];
                mx = fmaxf(mx, lg[jj]);
            }
        }
        mx = wave_max(mx);
        float sum = 0.f;
#pragma unroll
        for (int jj = 0; jj < 4; ++jj) { const int j = lane + 64 * jj; const float ev = (j < nsel) ? __expf(lg[jj] - mx) : 0.f; sum += ev; p[hh * 256 + j] = ev; }
        sum = wave_sum(sum);
        __syncthreads();
        float acc = 0.f;
        for (int j = 0; j < nsel; ++j) acc += p[hh * 256 + j] * (float)F.Z[((size_t)b * S + sel[j]) * ZP + ZC_AV + hh * 64 + lane];
        F.MIX[(size_t)row * D + 512 + hh * 64 + lane] = (h16)(acc / sum);
    }
}

typedef short v4i16_t __attribute__((ext_vector_type(4)));
__device__ __forceinline__ h16x4 vtr16(const LAS unsigned char* p) { return __builtin_bit_cast(h16x4, __builtin_amdgcn_ds_read_tr16_b64_v4i16((LAS v4i16_t*)p)); }
constexpr float LOG2E = 1.4426950408889634f;
constexpr int AT_K = 0, AT_V = 16384, AT_BT = 32768, AT_WS = 36864;
__device__ __forceinline__ void attn_dense(const Frame& F, LAS unsigned char* lds) {
    const int tid = F.tid, lane = F.lane, w = F.wave, q = lane & 31, hi = lane >> 5;
    LAS float* btab = (LAS float*)(lds + AT_BT);
    LAS float* wsf = (LAS float*)(lds + AT_WS) + w * 64;
    for (int i = tid; i < 1024; i += NTHR) {
        const int dist = i >> 3, h = i & 7; int bk;
        if (dist < 16) bk = dist; else { bk = 16 + (int)(log((double)dist / 16.0) / log(8.0) * 16.0); if (bk > 31) bk = 31; }
        btab[i] = F.rel_bias[bk * 8 + h] * LOG2E;
    }
    __syncthreads();
    const float c2 = 0.125f * LOG2E, THR = 8.f;
    const int vb0 = ((lane >> 4) & 1) * 32 + (lane & 3) * 8 + (4 * hi + ((lane & 15) >> 2)) * 64;
    for (int vu = blockIdx.x; vu < 256; vu += gridDim.x)
    for (int rr = 0; rr < 4; ++rr) {
        const int bh = vu >> 2, jj = vu & 3, qb = rr == 0 ? jj : rr == 1 ? 7 - jj : rr == 2 ? 8 + jj : 15 - jj, b = bh >> 3, h = bh & 7;
        const size_t rowbase = (size_t)b * S; const int q0 = qb * 256 + 32 * w, t = q0 + q, NT = 4 * (qb + 1);
        h16x8 qf[4];
#pragma unroll
        for (int ks = 0; ks < 4; ++ks) qf[ks] = *(const h16x8*)(F.Z + (rowbase + t) * ZP + ZC_AQ + h * 64 + 16 * ks + 8 * hi);
        const h16* kg = F.Z + (rowbase + lane) * ZP + ZC_AK + h * 64 + 8 * w;
        const h16* vg = F.Z + (rowbase + 16 * (w & 3) + (lane >> 2)) * ZP + ZC_AV + h * 64 + (w >> 2) * 32 + (lane & 3) * 8;
        const int sdst = w * 1024 + lane * 16;
        const unsigned* bmp = F.BM + bm_index(b, t, 0);
        typedef unsigned u32x2 __attribute__((ext_vector_type(2)));
        { const u32x4 kr = *(const u32x4*)kg, vr = *(const u32x4*)vg; *(LAS u32x4*)(lds + AT_K + sdst) = kr; *(LAS u32x4*)(lds + AT_V + sdst) = vr; }
        u32x2 mw = *(const u32x2*)bmp;
        __syncthreads();
        float m_run = -1e30f, l_part = 0.f; f32x16 o[2];
#pragma unroll
        for (int i = 0; i < 16; ++i) { o[0][i] = 0.f; o[1][i] = 0.f; }
        for (int kt = 0; kt < NT; ++kt) {
            const int cur = kt & 1; const bool more = (kt + 1 < NT);
            u32x4 kr, vr; u32x2 mwn = (u32x2){0u, 0u};
            if (more) { kr = *(const u32x4*)(kg + (size_t)(kt + 1) * 64 * ZP); vr = *(const u32x4*)(vg + (size_t)(kt + 1) * 64 * ZP); mwn = *(const u32x2*)(bmp + (size_t)(kt + 1) * 64); }
            if (64 * kt <= q0 + 31) {
                f32x16 p0, p1;
#pragma unroll
                for (int i = 0; i < 16; ++i) { p0[i] = 0.f; p1[i] = 0.f; }
                const LAS unsigned char* kb = lds + AT_K + cur * 8192 + hi * 1024 + q * 16;
#pragma unroll
                for (int d0 = 0; d0 < 4; ++d0) { const h16x8 b0 = *(const LAS h16x8*)(kb + d0 * 2048), b1 = *(const LAS h16x8*)(kb + d0 * 2048 + 512);
                    p0 = __builtin_amdgcn_mfma_f32_32x32x16_f16(b0, qf[d0], p0, 0, 0, 0); p1 = __builtin_amdgcn_mfma_f32_32x32x16_f16(b1, qf[d0], p1, 0, 0, 0); }
                if (q0 - (64 * kt + 63) >= 127) { const float bb = btab[127 * 8 + h];
#pragma unroll
                    for (int r = 0; r < 16; ++r) { p0[r] = p0[r] * c2 + bb; p1[r] = p1[r] * c2 + bb; }
                } else {
#pragma unroll
                    for (int r = 0; r < 16; ++r) { const int kv = 64 * kt + (r & 3) + 8 * (r >> 2) + 4 * hi; int d0_ = t - kv, d1_ = d0_ - 32;
                        d0_ = d0_ < 0 ? 0 : (d0_ > 127 ? 127 : d0_); d1_ = d1_ < 0 ? 0 : (d1_ > 127 ? 127 : d1_);
                        p0[r] = p0[r] * c2 + btab[d0_ * 8 + h]; p1[r] = p1[r] * c2 + btab[d1_ * 8 + h]; }
                }
                float mx = fmaxf(p0[0], p1[0]);
#pragma unroll
                for (int r = 1; r < 16; ++r) mx = fmaxf(mx, fmaxf(p0[r], p1[r]));
                mx = fmaxf(mx, __shfl_xor(mx, 32));
                if (__ballot(mx > m_run + THR) != 0ull) {
                    const float mn = fmaxf(m_run, mx), alpha = __builtin_amdgcn_exp2f(m_run - mn); m_run = mn; l_part *= alpha;
                    __builtin_amdgcn_wave_barrier();
                    if (hi == 0) wsf[q] = alpha;
                    __builtin_amdgcn_wave_barrier();
#pragma unroll
                    for (int g = 0; g < 4; ++g) { const f32x4 av = *(const LAS f32x4*)(wsf + 8 * g + 4 * hi);
#pragma unroll
                        for (int i = 0; i < 4; ++i) { o[0][4 * g + i] *= av[i]; o[1][4 * g + i] *= av[i]; } }
                    __builtin_amdgcn_wave_barrier();
                }
                const unsigned w0s = mw.x >> (4 * hi), w1s = mw.y >> (4 * hi);
#pragma unroll
                for (int r = 0; r < 16; ++r) { const int pos = (r & 3) + 8 * (r >> 2);
                    const float e0 = __builtin_amdgcn_exp2f(p0[r] - m_run), e1 = __builtin_amdgcn_exp2f(p1[r] - m_run);
                    const unsigned k0 = (unsigned)(-(int)((w0s >> pos) & 1u)), k1 = (unsigned)(-(int)((w1s >> pos) & 1u));
                    p0[r] = __uint_as_float(__float_as_uint(e0) & k0); p1[r] = __uint_as_float(__float_as_uint(e1) & k1);
                    l_part += p0[r] + p1[r]; }
                h16x8 pa[4];
#pragma unroll
                for (int j = 0; j < 8; ++j) { pa[0][j] = (h16)p0[j]; pa[1][j] = (h16)p0[8 + j]; pa[2][j] = (h16)p1[j]; pa[3][j] = (h16)p1[8 + j]; }
                const LAS unsigned char* vb = lds + AT_V + cur * 8192 + vb0;
#pragma unroll
                for (int d0 = 0; d0 < 2; ++d0)
#pragma unroll
                    for (int ks = 0; ks < 4; ++ks) { const h16x4 lo = vtr16(vb + d0 * 4096 + ks * 1024), hh = vtr16(vb + d0 * 4096 + ks * 1024 + 512);
                        h16x8 bv; bv[0] = lo[0]; bv[1] = lo[1]; bv[2] = lo[2]; bv[3] = lo[3]; bv[4] = hh[0]; bv[5] = hh[1]; bv[6] = hh[2]; bv[7] = hh[3];
                        o[d0] = __builtin_amdgcn_mfma_f32_32x32x16_f16(pa[ks], bv, o[d0], 0, 0, 0); }
            }
            if (more) { *(LAS u32x4*)(lds + AT_K + (cur ^ 1) * 8192 + sdst) = kr; *(LAS u32x4*)(lds + AT_V + (cur ^ 1) * 8192 + sdst) = vr; }
            mw = mwn;
            __syncthreads();
        }
        const float lt = l_part + __shfl_xor(l_part, 32), inv = 1.f / lt;
        __builtin_amdgcn_wave_barrier();
        if (hi == 0) wsf[q] = inv;
        __builtin_amdgcn_wave_barrier();
#pragma unroll
        for (int g = 0; g < 4; ++g) { const f32x4 av = *(const LAS f32x4*)(wsf + 8 * g + 4 * hi);
#pragma unroll
            for (int i = 0; i < 4; ++i) { const int qq = 8 * g + 4 * hi + i; h16* op = F.MIX + (rowbase + q0 + qq) * D + 512 + h * 64 + q;
                op[0] = (h16)(o[0][4 * g + i] * av[i]); op[32] = (h16)(o[1][4 * g + i] * av[i]); } }
        __builtin_amdgcn_wave_barrier();
    }
}

__device__ __forceinline__ void h2_phase(const Frame& F) {
    const int gw = blockIdx.x * 8 + F.wave, NGW = gridDim.x * 8;
    for (int m = gw; m < T; m += NGW) rms_row_to_h16(F.out + (size_t)m * D, F.norm_ffn, F.XN + (size_t)m * D, F.lane);
}
__device__ __forceinline__ void act_phase(const Frame& F, int row_lo, int row_hi) {
    const size_t total = (size_t)(row_hi - row_lo) * DFF;
    for (size_t i = (size_t)blockIdx.x * NTHR + F.tid; i < total; i += (size_t)gridDim.x * NTHR) {
        const int r = (int)(i / DFF), c = (int)(i % DFF); const int row = row_lo + r, t = row & (S - 1);
        const int pc = 256 * (c >> 7) + (c & 127);
        float ug = F.ffn_conv_b[c], uv = F.ffn_conv_b[DFF + c];
#pragma unroll
        for (int j = 0; j < 3; ++j) { const int tt = t - 2 + j; if (tt >= 0) {
            const h16* yr = F.Y + (size_t)(r - 2 + j) * NUP + pc;
            ug += F.ffn_conv_w[j * NUP + c] * (float)yr[0]; uv += F.ffn_conv_w[j * NUP + DFF + c] * (float)yr[128]; } }
        F.ACT[(size_t)row * DFF + c] = (h16)(ug * sigmoidf_(ug) * uv);
    }
}
__device__ __forceinline__ void final_norm_phase(const Frame& F) {
    const int gw = blockIdx.x * 8 + F.wave, NGW = gridDim.x * 8;
    for (int m = gw; m < T; m += NGW) {
        float* xr = F.out + (size_t)m * D; f32x4 v[4]; float s = 0.f;
#pragma unroll
        for (int j = 0; j < 4; ++j) { v[j] = *(const f32x4*)(xr + 4 * F.lane + 256 * j); s += (v[j].x * v[j].x + v[j].y * v[j].y) + (v[j].z * v[j].z + v[j].w * v[j].w); }
        const float r = 1.f / sqrtf(wave_sum(s) * (1.f / D) + EPS);
#pragma unroll
        for (int j = 0; j < 4; ++j) { const f32x4 g = *(const f32x4*)(F.norm_final + 4 * F.lane + 256 * j); *(f32x4*)(xr + 4 * F.lane + 256 * j) = (f32x4){v[j].x * r * g.x, v[j].y * r * g.y, v[j].z * r * g.z, v[j].w * r * g.w}; }
    }
}


#ifndef MK_N_LAUNCHES
#define MK_N_LAUNCHES 1
#endif
constexpr int N_PHASES = 14;
constexpr int RING_BYTES = 131072, MISC_OFF = RING_BYTES + 320, LDS_BYTES = 147456;
constexpr int CW_BAR = 4096;
constexpr size_t CTL_ZERO_BYTES = 64 * 1024;
__global__ void __launch_bounds__(NTHR, 2) mk_fwd(Args a) {
    extern __shared__ __attribute__((aligned(16))) unsigned char lds_raw[];
    LAS unsigned char* lds = (LAS unsigned char*)lds_raw;
    Frame F;
    F.x = a.in[0]; F.norm_mix = a.in[1]; F.w_in = a.in[2]; F.conv_w = a.in[3]; F.conv_b = a.in[4]; F.i_bias = a.in[5]; F.f_bias = a.in[6]; F.mlstm_norm = a.in[7];
    F.idx_k_norm = a.in[8]; F.rel_bias = a.in[9]; F.w_out = a.in[10]; F.norm_ffn = a.in[11]; F.w_up = a.in[12]; F.ffn_conv_w = a.in[13]; F.ffn_conv_b = a.in[14];
    F.w_down = a.in[15]; F.norm_final = a.in[16]; F.out = a.out;
    unsigned char* ws = a.ws;
    F.WIN = (h16*)(ws + WS_WIN); F.WOUT = (h16*)(ws + WS_WOUT); F.WUP = (h16*)(ws + WS_WUP); F.WDN = (h16*)(ws + WS_WDN);
    F.GATES = (float*)(ws + WS_GATES); F.XN = (h16*)(ws + WS_XN); F.Z = (h16*)(ws + WS_Z); F.MIX = (h16*)(ws + WS_MIX); F.KN = (h16*)(ws + WS_KN);
    F.BM = (unsigned*)(ws + WS_BM); F.KVT = (float*)(ws + WS_KVT); F.KS = (float*)(ws + WS_KS); F.G = (float*)(ws + WS_GML); F.MLOC = F.G + 2048; F.MPREV = F.G + 4096; F.Y = (h16*)(ws + WS_Y); F.ACT = (h16*)(ws + WS_ACT);
    F.tid = threadIdx.x; F.lane = F.tid & 63; F.wave = __builtin_amdgcn_readfirstlane(F.tid >> 6);
    volatile LAS unsigned* MISC = (volatile LAS unsigned*)(lds + MISC_OFF);
    for (int u = F.tid; u < (LDS_BYTES - RING_BYTES) / 4; u += NTHR) ((LAS unsigned*)(lds + RING_BYTES))[u] = 0u;
    __syncthreads();
    XcdBarrier bar; bar.bar = (unsigned*)(ws + WS_CTL) + CW_BAR; bar.x = 0; bar.st = nullptr;
    if (MK_N_LAUNCHES == 1) bar = xcd_barrier_post((unsigned*)(ws + WS_CTL) + CW_BAR, MISC + 8);
    const int lo = a.ph_lo, hi = a.ph_hi, G = gridDim.x;
#define IN(k) (lo <= (k) && (k) < hi)
#define SEAM(k) do { if (IN(k) && IN((k) + 1)) xcd_barrier(bar); } while (0)
    if (IN(0)) p0_prologue(F, lds);
    SEAM(0);
    if (IN(1)) { pg8::Gemm g{(const pg8::bf16_t*)F.XN, (const pg8::bf16_t*)F.WIN, T, ZP, D}; pg8::StaticOrder So; So.init(T, ZP, G, (int)blockIdx.x);
        pg8::EpiH16 E{F.Z, ZP, 0, F.GATES, ZC_G}; pg8::gemm_phase<pg8::EpiH16, pg8::StaticOrder, true, true>(lds, g, So, E); }
    SEAM(1);
    if (IN(2)) { kn_phase(F); mlstm_A(F, lds); }
    SEAM(2);
    if (IN(3)) mlstm_B(F);
    SEAM(3);
    if (IN(4)) { mlstm_C(F, lds); index_mfma(F, lds); }
    SEAM(4);
    if (IN(5)) attn_dense(F, lds);
    SEAM(5);
    if (IN(6)) { pg8::Gemm g{(const pg8::bf16_t*)F.MIX, (const pg8::bf16_t*)F.WOUT, T, D, D}; pg8::StaticOrder So; So.init(T, D, G, (int)blockIdx.x);
        pg8::EpiRes32 E{F.x, F.out, D}; pg8::gemm_phase<pg8::EpiRes32, pg8::StaticOrder, true, true>(lds, g, So, E); }
    SEAM(6);
    if (IN(7)) h2_phase(F);
    SEAM(7);
    if (IN(8)) { pg8::Gemm g{(const pg8::bf16_t*)F.XN, (const pg8::bf16_t*)F.WUP, T / 2, NUP, D}; pg8::StaticOrder So; So.init(T / 2, NUP, G, (int)blockIdx.x);
        pg8::EpiH16 E{F.Y, NUP, 0, nullptr, 0}; pg8::gemm_phase<pg8::EpiH16, pg8::StaticOrder, true, true>(lds, g, So, E); }
    SEAM(8);
    if (IN(9)) act_phase(F, 0, T / 2);
    SEAM(9);
    if (IN(10)) { pg8::Gemm g{(const pg8::bf16_t*)(F.XN + (size_t)(T / 2) * D), (const pg8::bf16_t*)F.WUP, T / 2, NUP, D}; pg8::StaticOrder So; So.init(T / 2, NUP, G, (int)blockIdx.x);
        pg8::EpiH16 E{F.Y, NUP, 0, nullptr, 0}; pg8::gemm_phase<pg8::EpiH16, pg8::StaticOrder, true, true>(lds, g, So, E); }
    SEAM(10);
    if (IN(11)) act_phase(F, T / 2, T);
    SEAM(11);
    if (IN(12)) { pg8::Gemm g{(const pg8::bf16_t*)F.ACT, (const pg8::bf16_t*)F.WDN, T, D, DFF}; pg8::StaticOrder So; So.init(T, D, G, (int)blockIdx.x);
        pg8::EpiRes32 E{F.out, F.out, D}; pg8::gemm_phase<pg8::EpiRes32, pg8::StaticOrder, true, true>(lds, g, So, E); }
    SEAM(12);
    if (IN(13)) final_norm_phase(F);
#undef IN
#undef SEAM
}

extern "C" void kernel_launch(void* const* d_in, const int* in_sizes, int n_in, void* d_out, int out_size, void* d_ws, size_t ws_size, hipStream_t stream) {
    static int grid = 0;
    if (grid == 0) {
        if (n_in != 17 || in_sizes[0] != T * D || out_size != T * D || ws_size < WS_END) { fprintf(stderr, "kernel_launch: unexpected shapes (n_in %d, in0 %d, out %d, ws %zu)\n", n_in, n_in > 0 ? in_sizes[0] : -1, out_size, ws_size); grid = -1; return; }
        int dev = 0, cus = 0, per_cu = 0;
        if (hipGetDevice(&dev) != hipSuccess || hipDeviceGetAttribute(&cus, hipDeviceAttributeMultiprocessorCount, dev) != hipSuccess) { fprintf(stderr, "kernel_launch: device query failed\n"); grid = -1; return; }
        if (hipFuncSetAttribute((const void*)mk_fwd, hipFuncAttributeMaxDynamicSharedMemorySize, LDS_BYTES) != hipSuccess) { fprintf(stderr, "kernel_launch: hipFuncSetAttribute failed\n"); grid = -1; return; }
        if (hipOccupancyMaxActiveBlocksPerMultiprocessor(&per_cu, (const void*)mk_fwd, NTHR, LDS_BYTES) != hipSuccess || per_cu < 1) fprintf(stderr, "kernel_launch: note: occupancy query reports %d workgroups per CU\n", per_cu);
        (void)hipGetLastError();
        grid = cus;
    }
    if (grid < 0) return;
    if (hipMemsetAsync((char*)d_ws + WS_CTL, 0, CTL_ZERO_BYTES, stream) != hipSuccess) { fprintf(stderr, "kernel_launch: memset failed\n"); return; }
    Args a{};
    for (int i = 0; i < 17; ++i) a.in[i] = (const float*)d_in[i];
    a.out = (float*)d_out; a.ws = (unsigned char*)d_ws;
    if (MK_N_LAUNCHES == 1) { a.ph_lo = 0; a.ph_hi = N_PHASES; hipLaunchKernelGGL(mk_fwd, dim3(grid), dim3(NTHR), LDS_BYTES, stream, a); }
    else for (int ph = 0; ph < N_PHASES; ++ph) { a.ph_lo = ph; a.ph_hi = ph + 1; hipLaunchKernelGGL(mk_fwd, dim3(grid), dim3(NTHR), LDS_BYTES, stream, a); }
}
```

```cpp
#include <hip/hip_runtime.h>
#include <cstdio>
#include <cstdint>

#define LAS __attribute__((address_space(3)))
typedef _Float16 h16;
typedef _Float16 h16x8 __attribute__((ext_vector_type(8)));
typedef float f32x4 __attribute__((ext_vector_type(4)));
typedef unsigned u32x4 __attribute__((ext_vector_type(4)));

constexpr int NB = 8, S = 4096, T = NB * S, D = 1024;
constexpr int ZP = 3840;
constexpr int DFF = 2816, NUP = 2 * DFF;
constexpr int ZC_MQ = 0, ZC_MK = 256, ZC_MV = 512, ZC_MO = 1024, ZC_AQ = 1536, ZC_AK = 2048, ZC_AV = 2560, ZC_IQ = 3072, ZC_IK = 3584, ZC_G = 3648;
constexpr int TOPK = 256;
constexpr float EPS = 1e-6f;
constexpr int NTHR = 512;

constexpr size_t MiB = 1u << 20;
constexpr size_t WS_CTL = 0;
constexpr size_t WS_WIN = 2 * MiB;
constexpr size_t WS_WOUT = 10 * MiB;
constexpr size_t WS_WUP = 12 * MiB;
constexpr size_t WS_WDN = 23 * MiB;
constexpr size_t WS_GATES = 29 * MiB;
constexpr size_t WS_XN = 32 * MiB;
constexpr size_t WS_Z = 96 * MiB;
constexpr size_t WS_MIX = 336 * MiB;
constexpr size_t WS_KN = 400 * MiB;
constexpr size_t WS_BM = 404 * MiB;
constexpr size_t WS_Y = 96 * MiB;
constexpr size_t WS_ACT = 272 * MiB;
constexpr size_t WS_KVT = 420 * MiB;
constexpr size_t WS_KS = 484 * MiB;
constexpr size_t WS_GML = 485 * MiB;
constexpr size_t WS_END = 486 * MiB;

struct Args { const float* in[17]; float* out; unsigned char* ws; int ph_lo, ph_hi; };

struct Frame {
    const float *x, *norm_mix, *w_in, *conv_w, *conv_b, *i_bias, *f_bias, *mlstm_norm, *idx_k_norm, *rel_bias, *w_out, *norm_ffn, *w_up, *ffn_conv_w, *ffn_conv_b, *w_down, *norm_final;
    float* out;
    h16 *WIN, *WOUT, *WUP, *WDN, *XN, *Z, *MIX, *KN, *Y, *ACT;
    float* GATES; unsigned* BM;
    float *KVT, *KS, *G, *MLOC, *MPREV;
    int tid, lane, wave;
};

__device__ __forceinline__ float wave_sum(float v) {
#pragma unroll
    for (int o = 1; o < 64; o <<= 1) v += __shfl_xor(v, o);
    return v;
}
__device__ __forceinline__ float wave_max(float v) {
#pragma unroll
    for (int o = 1; o < 64; o <<= 1) v = fmaxf(v, __shfl_xor(v, o));
    return v;
}
__device__ __forceinline__ int wave_isum(int v) {
#pragma unroll
    for (int o = 1; o < 64; o <<= 1) v += __shfl_xor(v, o);
    return v;
}
__device__ __forceinline__ float sigmoidf_(float x) { return 1.f / (1.f + __expf(-x)); }

__device__ __forceinline__ int src_col_in(int n) { return n < 1536 ? n : n < 3648 ? n + 8 : n < 3656 ? n - 3648 + 1536 : n < 3664 ? n : -1; }
__device__ __forceinline__ int src_col_up(int n) { const int pn = n >> 8, r = n & 255; return (r >> 7) * DFF + pn * 128 + (r & 127); }

template <int MODE>
__device__ __forceinline__ void transpose_item(const float* W, int K, int N, h16* WT, int NOUT, LAS float* scr, int item, int lane) {
    const int nblk = NOUT / 32, kb = item / nblk, nb = item % nblk, k0 = 64 * kb, n0 = 32 * nb;
    const int n = n0 + (lane & 31);
    const int sc = MODE == 1 ? src_col_in(n) : MODE == 2 ? src_col_up(n) : n;
#pragma unroll 8
    for (int i = 0; i < 32; ++i) { const int kk = 2 * i + (lane >> 5); scr[kk * 33 + (lane & 31)] = sc >= 0 ? W[(size_t)(k0 + kk) * N + sc] : 0.f; }
    __builtin_amdgcn_s_waitcnt(0xc07f); __builtin_amdgcn_wave_barrier();
    const int c = lane & 7;
#pragma unroll
    for (int j = 0; j < 4; ++j) {
        const int nn = (lane >> 3) + 8 * j; const LAS float* s = scr + (8 * c) * 33 + nn;
        h16x8 o;
#pragma unroll
        for (int i = 0; i < 8; ++i) o[i] = (h16)s[i * 33];
        *(h16x8*)(WT + (size_t)(n0 + nn) * K + k0 + 8 * c) = o;
    }
    __builtin_amdgcn_s_waitcnt(0xc07f); __builtin_amdgcn_wave_barrier();
}

__device__ __forceinline__ void rms_row_to_h16(const float* xrow, const float* g, h16* orow, int lane) {
    f32x4 v[4]; float s = 0.f;
#pragma unroll
    for (int j = 0; j < 4; ++j) { v[j] = *(const f32x4*)(xrow + 4 * lane + 256 * j); s += (v[j].x * v[j].x + v[j].y * v[j].y) + (v[j].z * v[j].z + v[j].w * v[j].w); }
    const float r = 1.f / sqrtf(wave_sum(s) * (1.f / D) + EPS);
#pragma unroll
    for (int j = 0; j < 4; ++j) {
        const f32x4 gg = *(const f32x4*)(g + 4 * lane + 256 * j);
        typedef _Float16 h16x4 __attribute__((ext_vector_type(4)));
        h16x4 o; o[0] = (h16)(v[j].x * r * gg.x); o[1] = (h16)(v[j].y * r * gg.y); o[2] = (h16)(v[j].z * r * gg.z); o[3] = (h16)(v[j].w * r * gg.w);
        *(h16x4*)(orow + 4 * lane + 256 * j) = o;
    }
}

__device__ __forceinline__ void p0_prologue(const Frame& F, LAS unsigned char* lds) {
    LAS float* scr = (LAS float*)lds + F.wave * (64 * 33);
    const int gw = blockIdx.x * 8 + F.wave, NGW = gridDim.x * 8;
    constexpr int I_IN = 16 * (ZP / 32), I_OUT = 16 * (D / 32), I_UP = 16 * (NUP / 32), I_DN = (DFF / 64) * (D / 32);
    for (int it = gw; it < I_IN + I_OUT + I_UP + I_DN; it += NGW) {
        int r = it;
        if (r < I_IN) { transpose_item<1>(F.w_in, D, 3664, F.WIN, ZP, scr, r, F.lane); continue; } r -= I_IN;
        if (r < I_OUT) { transpose_item<0>(F.w_out, D, D, F.WOUT, D, scr, r, F.lane); continue; } r -= I_OUT;
        if (r < I_UP) { transpose_item<2>(F.w_up, D, NUP, F.WUP, NUP, scr, r, F.lane); continue; } r -= I_UP;
        transpose_item<0>(F.w_down, DFF, D, F.WDN, D, scr, r, F.lane);
    }
    for (int m = gw; m < T; m += NGW) rms_row_to_h16(F.x + (size_t)m * D, F.norm_mix, F.XN + (size_t)m * D, F.lane);
}

namespace pg8 {
#define PG8_LAS __attribute__((address_space(3)))
typedef unsigned short bf16_t;
typedef short bf16x8 __attribute__((ext_vector_type(8)));
typedef float f32x4 __attribute__((ext_vector_type(4)));
typedef unsigned u32x4 __attribute__((ext_vector_type(4)));
constexpr int BM = 256, BK = 64, HALF = 128, HTB = HALF * BK * 2  , STAGE_BYTES = 8 * HTB, NXCD = 8, WGM = 8;

__host__ __device__ __forceinline__ int lds_byte(int r, int c) { const int st = (r >> 4) * 2 + (c >> 5), rr = r & 15, cc = c & 31, ob = rr * 64 + cc * 2; return st * 1024 + (ob ^ (((ob >> 9) & 1) << 5)); }
__host__ __device__ __forceinline__ void stage_rc(int b, int& R, int& C) { const int st = b / 1024, sb = b % 1024, swz = sb ^ (((sb >> 9) & 1) << 5); R = (st >> 1) * 16 + swz / 64; C = (st & 1) * 32 + (swz % 64) / 2; }
__host__ __device__ __forceinline__ int perm32(int rho) { const int n = rho >> 4, i = rho & 15; return 8 * (i >> 2) + 4 * n + (i & 3); }

struct Unit { int pm, pn; };
struct Gemm { const bf16_t* A; const bf16_t* Bt; int M, N, K; };

struct StaticOrder {
    int nM, nN, nwg, G, c;
    __host__ __device__ void init(int M, int N, int G_, int c_) { nM = M / BM; nN = N / BM; nwg = nM * nN; G = G_; c = c_; }
    __host__ __device__ bool next(int i, Unit& u) const {
        const long L = (long)i * G + c; if (L >= nwg) return false;
        int wgid = (int)L; { const int q = nwg / NXCD, r = nwg % NXCD, xcd = wgid % NXCD, off = wgid / NXCD; wgid = (xcd < r ? xcd * (q + 1) : r * (q + 1) + (xcd - r) * q) + off; }
        const int nig = WGM * nN, gid = wgid / nig, fm = gid * WGM, gsz = (nM - fm) < WGM ? (nM - fm) : WGM;
        u.pm = fm + ((wgid % nig) % gsz); u.pn = (wgid % nig) / gsz; return true;
    }
    __device__ __forceinline__ void a_ready(const Unit&) const {}
    __device__ __forceinline__ void done(const Unit&) const {}
};

typedef _Float16 f16x8 __attribute__((ext_vector_type(8)));
struct EpiH16 {
    static constexpr bool PERM = true, AFTER_DRAIN = false;
    _Float16* O; int ldc; int row_off; float* G; int gc0;
    __device__ __forceinline__ void operator()(const f32x4 (&acc)[2][2][4][2], const Unit& u, int wr, int wc, int fr, int fq) const {
        const int row0 = row_off + u.pm * BM + wr * 64 + fr, col0 = u.pn * BM + wc * 32 + 8 * fq;
#pragma unroll
        for (int ai = 0; ai < 2; ++ai)
#pragma unroll
            for (int m = 0; m < 4; ++m) { const size_t r = (size_t)(row0 + ai * HALF + m * 16);
#pragma unroll
                for (int bj = 0; bj < 2; ++bj) { const int c = col0 + bj * HALF; const f32x4 v0 = acc[ai][bj][m][0], v1 = acc[ai][bj][m][1];
                    f16x8 o; o[0] = (_Float16)v0[0]; o[1] = (_Float16)v0[1]; o[2] = (_Float16)v0[2]; o[3] = (_Float16)v0[3]; o[4] = (_Float16)v1[0]; o[5] = (_Float16)v1[1]; o[6] = (_Float16)v1[2]; o[7] = (_Float16)v1[3];
                    *(f16x8*)(O + r * ldc + c) = o;
                    if (G && c >= gc0 && c < gc0 + 16) { *(f32x4*)(G + r * 16 + (c - gc0)) = v0; *(f32x4*)(G + r * 16 + (c - gc0) + 4) = v1; } } }
    }
};
struct EpiRes32 {
    static constexpr bool PERM = false, AFTER_DRAIN = false;
    const float* base; float* out; int ldc;
    __device__ __forceinline__ void operator()(const f32x4 (&acc)[2][2][4][2], const Unit& u, int wr, int wc, int fr, int fq) const {
        const int row0 = u.pm * BM + wr * 64 + fr, col0 = u.pn * BM + wc * 32 + 4 * fq;
#pragma unroll
        for (int ai = 0; ai < 2; ++ai)
#pragma unroll
            for (int m = 0; m < 4; ++m) { const size_t off = (size_t)(row0 + ai * HALF + m * 16) * ldc + col0;
#pragma unroll
                for (int bj = 0; bj < 2; ++bj)
#pragma unroll
                    for (int n = 0; n < 2; ++n) { const f32x4 b = *(const f32x4*)(base + off + bj * HALF + n * 16); *(f32x4*)(out + off + bj * HALF + n * 16) = b + acc[ai][bj][m][n]; } }
    }
};
template <class Epi, class Sched, bool ALIGN_EPI = false, bool SP2 = false>
__device__ __forceinline__ void gemm_phase(PG8_LAS unsigned char* lds, const Gemm g, const Sched& S, const Epi& E) {
    const int tid = threadIdx.x, wid = __builtin_amdgcn_readfirstlane(tid >> 6), lane = tid & 63, wr = wid >> 2, wc = wid & 3, fr = lane & 15, fq = lane >> 4;
    const int K = g.K, nt = K / BK;
    unsigned voffA[2], voffB[2];
#pragma unroll
    for (int i = 0; i < 2; ++i) { int R, C; stage_rc(tid * 16 + i * 8192, R, C); const int Rb = Epi::PERM ? ((R & ~31) + perm32(R & 31)) : R;
        voffA[i] = (unsigned)(R * K + C) * 2u; voffB[i] = (unsigned)(Rb * K + C) * 2u; }
    const size_t kstep = (size_t)(BK * 2);
    const size_t hstep = (size_t)HALF * K * 2;
    const size_t tstep = 2 * hstep;
    const unsigned ldsw = (unsigned)wid * 1024u;
    const int aoff = lds_byte(wr * 64 + fr, fq * 8), boff = lds_byte(wc * 32 + fr, fq * 8);
#define PG8_SA(b, h) (((b) * 2 + (h)) * HTB)
#define PG8_SB(b, h) ((4 + (b) * 2 + (h)) * HTB)
#define PG8_STAGE(bufoff, gbase, voff) do { _Pragma("unroll") for (int _i = 0; _i < 2; ++_i) \
        __builtin_amdgcn_global_load_lds((const unsigned*)((const char*)(gbase) + (voff)[_i]), (PG8_LAS unsigned*)(lds + (bufoff) + ldsw + _i * 8192), 16, 0, 0); } while (0)
#define PG8_LDA(dst, b, h) do { _Pragma("unroll") for (int m = 0; m < 4; ++m) _Pragma("unroll") for (int k = 0; k < 2; ++k) dst[m][k] = *(const PG8_LAS bf16x8*)(lds + PG8_SA(b, h) + aoff + m * 2048 + k * 1024); } while (0)
#define PG8_LDB(dst, b, h) do { _Pragma("unroll") for (int n = 0; n < 2; ++n) _Pragma("unroll") for (int k = 0; k < 2; ++k) dst[n][k] = *(const PG8_LAS bf16x8*)(lds + PG8_SB(b, h) + boff + n * 2048 + k * 1024); } while (0)
#define PG8_MMA(ai, bj, At, Bt) do { __builtin_amdgcn_s_setprio(1); _Pragma("unroll") for (int m = 0; m < 4; ++m) _Pragma("unroll") for (int n = 0; n < 2; ++n) _Pragma("unroll") for (int k = 0; k < 2; ++k) \
        acc[ai][bj][m][n] = __builtin_amdgcn_mfma_f32_16x16x32_f16(__builtin_bit_cast(f16x8, Bt[n][k]), __builtin_bit_cast(f16x8, At[m][k]), acc[ai][bj][m][n], 0, 0, 0); __builtin_amdgcn_s_setprio(0); } while (0)
#define PG8_WAIT_V(n) asm volatile("s_waitcnt vmcnt(" #n ")" ::: "memory")
#define PG8_WAIT_L(n) asm volatile("s_waitcnt lgkmcnt(" #n ")" ::: "memory")
#define PG8_BAR __builtin_amdgcn_s_barrier()
#define PG8_SCHED __builtin_amdgcn_sched_barrier(0)
    Unit cur, nxt; int ui = 0;
    if (!S.next(0, cur)) return;
    f32x4 acc[2][2][4][2];
#pragma unroll
    for (int a = 0; a < 2; ++a)
#pragma unroll
        for (int b = 0; b < 2; ++b)
#pragma unroll
            for (int m = 0; m < 4; ++m)
#pragma unroll
                for (int n = 0; n < 2; ++n) acc[a][b][m][n] = (f32x4){0.f, 0.f, 0.f, 0.f};
    bf16x8 At[4][2], B0[2][2], B1[2][2];
    const char* cA = (const char*)g.A + (size_t)cur.pm * tstep; const char* cB = (const char*)g.Bt + (size_t)cur.pn * tstep;
    S.a_ready(cur);
    if constexpr (SP2) {
        PG8_STAGE(PG8_SB(0, 0), cB, voffB); PG8_STAGE(PG8_SB(0, 1), cB + hstep, voffB); PG8_STAGE(PG8_SA(0, 0), cA, voffA); PG8_STAGE(PG8_SA(0, 1), cA + hstep, voffA);
        if (wr == 1) PG8_BAR;
        PG8_WAIT_V(2); PG8_BAR;
        PG8_STAGE(PG8_SB(1, 0), cB + kstep, voffB); PG8_STAGE(PG8_SA(1, 0), cA + kstep, voffA); PG8_STAGE(PG8_SB(1, 1), cB + hstep + kstep, voffB);
        PG8_WAIT_V(6); PG8_BAR;
    } else {
        PG8_STAGE(PG8_SB(0, 0), cB, voffB); PG8_STAGE(PG8_SA(0, 0), cA, voffA); PG8_STAGE(PG8_SB(0, 1), cB + hstep, voffB); PG8_STAGE(PG8_SA(0, 1), cA + hstep, voffA);
        if (wr == 1) PG8_BAR;
        PG8_WAIT_V(4); PG8_BAR;
        PG8_STAGE(PG8_SB(1, 0), cB + kstep, voffB); PG8_STAGE(PG8_SA(1, 0), cA + kstep, voffA); PG8_STAGE(PG8_SB(1, 1), cB + hstep + kstep, voffB);
        PG8_WAIT_V(6); PG8_BAR;
    }
    for (;;) {
        const bool has_next = S.next(ui + 1, nxt);
        const char* nA = has_next ? (const char*)g.A + (size_t)nxt.pm * tstep : cA; const char* nB = has_next ? (const char*)g.Bt + (size_t)nxt.pn * tstep : cB;
        for (int t = 0; t < nt; t += 2) {
            const bool last = (t == nt - 2);
            const char* a1 = cA + (size_t)(t + 1) * kstep;
            const char* a2 = last ? nA : cA + (size_t)(t + 2) * kstep; const char* b2 = last ? nB : cB + (size_t)(t + 2) * kstep;
            const char* a3 = a2 + kstep; const char* b3 = b2 + kstep;
            if (last && has_next) S.a_ready(nxt);
            if constexpr (SP2) {
            PG8_LDB(B0, 0, 0); PG8_LDB(B1, 0, 1); PG8_SCHED; PG8_LDA(At, 0, 0); PG8_STAGE(PG8_SA(1, 1), a1 + hstep, voffA);
            PG8_WAIT_V(8); PG8_WAIT_L(0); PG8_BAR; PG8_MMA(0, 0, At, B0); PG8_MMA(0, 1, At, B1); PG8_BAR; PG8_SCHED;
            PG8_LDA(At, 0, 1); PG8_STAGE(PG8_SB(0, 0), b2, voffB); PG8_STAGE(PG8_SB(0, 1), b2 + hstep, voffB); PG8_STAGE(PG8_SA(0, 0), a2, voffA);
            PG8_WAIT_V(8); PG8_WAIT_L(0); PG8_BAR; PG8_MMA(1, 0, At, B0); PG8_MMA(1, 1, At, B1); PG8_BAR; PG8_SCHED;
            PG8_LDB(B0, 1, 0); PG8_LDB(B1, 1, 1); PG8_SCHED; PG8_LDA(At, 1, 0); PG8_STAGE(PG8_SA(0, 1), a2 + hstep, voffA);
            PG8_WAIT_V(8); PG8_WAIT_L(0); PG8_BAR; PG8_MMA(0, 0, At, B0); PG8_MMA(0, 1, At, B1); PG8_BAR; PG8_SCHED;
            PG8_LDA(At, 1, 1); PG8_STAGE(PG8_SB(1, 0), b3, voffB); PG8_STAGE(PG8_SB(1, 1), b3 + hstep, voffB); PG8_STAGE(PG8_SA(1, 0), a3, voffA);
            PG8_WAIT_V(8); PG8_WAIT_L(0); PG8_BAR; PG8_MMA(1, 0, At, B0); PG8_MMA(1, 1, At, B1); PG8_BAR; PG8_SCHED;
            } else {
            PG8_LDB(B0, 0, 0); PG8_SCHED; PG8_LDA(At, 0, 0); PG8_STAGE(PG8_SA(1, 1), a1 + hstep, voffA);
            PG8_WAIT_L(8); PG8_BAR; PG8_WAIT_L(0); PG8_MMA(0, 0, At, B0); PG8_BAR; PG8_SCHED;
            PG8_LDB(B1, 0, 1); PG8_STAGE(PG8_SB(0, 0), b2, voffB);
            PG8_BAR; PG8_WAIT_L(0); PG8_MMA(0, 1, At, B1); PG8_BAR;
            PG8_LDA(At, 0, 1); PG8_STAGE(PG8_SA(0, 0), a2, voffA);
            PG8_BAR; PG8_WAIT_L(0); PG8_MMA(1, 0, At, B0); PG8_BAR; PG8_SCHED;
            PG8_STAGE(PG8_SB(0, 1), b2 + hstep, voffB);
            PG8_WAIT_V(6); PG8_BAR; PG8_MMA(1, 1, At, B1); PG8_BAR;
            PG8_LDB(B0, 1, 0); PG8_SCHED; PG8_LDA(At, 1, 0); PG8_STAGE(PG8_SA(0, 1), a2 + hstep, voffA);
            PG8_WAIT_L(8); PG8_BAR; PG8_WAIT_L(0); PG8_MMA(0, 0, At, B0); PG8_BAR; PG8_SCHED;
            PG8_LDB(B1, 1, 1); PG8_STAGE(PG8_SB(1, 0), b3, voffB);
            PG8_BAR; PG8_WAIT_L(0); PG8_MMA(0, 1, At, B1); PG8_BAR;
            PG8_LDA(At, 1, 1); PG8_STAGE(PG8_SA(1, 0), a3, voffA);
            PG8_BAR; PG8_WAIT_L(0); PG8_MMA(1, 0, At, B0); PG8_BAR; PG8_SCHED;
            PG8_STAGE(PG8_SB(1, 1), b3 + hstep, voffB);
            PG8_WAIT_V(6); PG8_BAR; PG8_MMA(1, 1, At, B1); PG8_BAR;
            }
        }
        if constexpr (ALIGN_EPI) { if (wr == 0) PG8_BAR; }
        if constexpr (!Epi::AFTER_DRAIN) { E(acc, cur, wr, wc, fr, fq); S.done(cur); }
        if (!has_next) break;
#pragma unroll
        for (int a = 0; a < 2; ++a)
#pragma unroll
            for (int b = 0; b < 2; ++b)
#pragma unroll
                for (int m = 0; m < 4; ++m)
#pragma unroll
                    for (int n = 0; n < 2; ++n) acc[a][b][m][n] = (f32x4){0.f, 0.f, 0.f, 0.f};
        cur = nxt; cA = nA; cB = nB; ++ui;
        if constexpr (ALIGN_EPI) { if (wr == 1) PG8_BAR; }
    }
    PG8_WAIT_V(0);
    if constexpr (!ALIGN_EPI) { if (wr == 0) PG8_BAR; }
    PG8_BAR;
    if constexpr (Epi::AFTER_DRAIN) { E.fused(acc, cur, wr, wc, fr, fq, lds, wid, lane); S.done(cur); }
#undef PG8_SA
#undef PG8_SB
#undef PG8_STAGE
#undef PG8_LDA
#undef PG8_LDB
#undef PG8_MMA
#undef PG8_WAIT_V
#undef PG8_WAIT_L
#undef PG8_BAR
#undef PG8_SCHED
}
}


#define XB_TMO      128
#define XB_XCNT(j)  (256  + 64 * (j))
#define XB_XSUB(j)  (1280 + 64 * (j))
#define XB_XGEN(j)  (2304 + 64 * (j))
#define XB_TOP      3328
#define XB_TOPGEN   3392
#define XCD_BAR_WORDS 3456
#define XB_SPIN_CAP (1u << 18)

__device__ __forceinline__ unsigned xb_ld(unsigned* p)              { return __hip_atomic_load(p, __ATOMIC_RELAXED, __HIP_MEMORY_SCOPE_AGENT); }
__device__ __forceinline__ unsigned xb_add(unsigned* p, unsigned v) { return __hip_atomic_fetch_add(p, v, __ATOMIC_RELAXED, __HIP_MEMORY_SCOPE_AGENT); }
__device__ __forceinline__ unsigned xb_xcc_id() { return (unsigned)__builtin_amdgcn_s_getreg((3 << 11) | 20) & 0xFu; }
#define XB_SPIN(cond, bar) do { unsigned _sp = 0; while (cond) { __builtin_amdgcn_s_sleep(1); \
    if ((++_sp & 255u) == 0u) { if (xb_ld(&(bar)[XB_TMO])) break; if (_sp > XB_SPIN_CAP) { atomicAdd(&(bar)[XB_TMO], 1u); break; } } } } while (0)

struct XcdBarrier {
    unsigned* bar; unsigned x;
    volatile LAS unsigned* st;
};

__device__ __forceinline__ XcdBarrier xcd_barrier_post(unsigned* bar, volatile LAS unsigned* st) {
    XcdBarrier b; b.bar = bar; b.x = xb_xcc_id(); b.st = st;
    if (threadIdx.x == 0) (void)xb_add(&bar[XB_XCNT(b.x)], 1u);
    return b;
}
__device__ __forceinline__ void xcd_barrier_complete(unsigned* bar, unsigned x, unsigned& nloc, unsigned& nx) {
    const unsigned G = gridDim.x * gridDim.y * gridDim.z;
    unsigned sum, cnt, mine, sp = 0u;
    for (;;) {
        sum = 0u; cnt = 0u; mine = 0u;
#pragma unroll
        for (unsigned j = 0; j < 16; ++j) { const unsigned c = xb_ld(&bar[XB_XCNT(j)]); sum += c; cnt += (c > 0u) ? 1u : 0u; mine = (j == x) ? c : mine; }
        if (sum == G) break;
        __builtin_amdgcn_s_sleep(1);
        if ((++sp & 255u) == 0u) { if (xb_ld(&bar[XB_TMO])) break; if (sp > XB_SPIN_CAP) { atomicAdd(&bar[XB_TMO], 1u); break; } }
    }
    nloc = mine > 0u ? mine : 1u; nx = cnt > 0u ? cnt : 1u;
}

__device__ __forceinline__ void xcd_barrier(const XcdBarrier& b) {
    asm volatile("s_waitcnt vmcnt(0)" ::: "memory");
    __syncthreads();
    if (threadIdx.x == 0) {
        unsigned* bar = b.bar;
        __builtin_amdgcn_s_waitcnt(0);
        unsigned nloc = b.st[0], nx = b.st[1];
        if (nloc == 0u) { xcd_barrier_complete(bar, b.x, nloc, nx); b.st[0] = nloc; b.st[1] = nx; }
        const unsigned old = xb_add(&bar[XB_XSUB(b.x)], 1u);
        const unsigned gen = old / nloc;
        if (old + 1u == (gen + 1u) * nloc) {
            __builtin_amdgcn_fence(__ATOMIC_RELEASE, "agent");
            asm volatile("s_waitcnt vmcnt(0)" ::: "memory");
            const unsigned og = xb_add(&bar[XB_TOP], 1u);
            const unsigned tg = og / nx;
            if (og + 1u == (tg + 1u) * nx) xb_add(&bar[XB_TOPGEN], 1u);
            else XB_SPIN(xb_ld(&bar[XB_TOPGEN]) == tg, bar);
            __builtin_amdgcn_fence(__ATOMIC_ACQUIRE, "agent");
            xb_add(&bar[XB_XGEN(b.x)], 1u);
            asm volatile("s_waitcnt vmcnt(0)" ::: "memory");
        } else {
            XB_SPIN(xb_ld(&bar[XB_XGEN(b.x)]) == gen, bar);
            __builtin_amdgcn_fence(__ATOMIC_ACQUIRE, "agent");
            asm volatile("s_waitcnt vmcnt(0)" ::: "memory");
        }
    }
    __syncthreads();
}

__device__ __forceinline__ void mlstm_naive(const Frame& F, LAS unsigned char* lds) {
    LAS float* qs = (LAS float*)lds; LAS float* ks = qs + 64; LAS float* part = ks + 64; LAS float* red = part + 512;
    const int tid = F.tid, e = tid & 127, qd = tid >> 7;
    for (int unit = blockIdx.x; unit < NB * 4; unit += gridDim.x) {
        const int b = unit >> 2, h = unit & 3;
        float C[16]; float n_d = 0.f, m = 0.f;
#pragma unroll
        for (int i = 0; i < 16; ++i) C[i] = 0.f;
        const float ib = F.i_bias[h], fb = F.f_bias[h];
        for (int t = 0; t < S; ++t) {
            const size_t row = (size_t)b * S + t;
            if (tid < 128) {
                const int cc = (tid < 64) ? (h * 64 + tid) : (256 + h * 64 + (tid - 64));
                float a = F.conv_b[cc];
#pragma unroll
                for (int j = 0; j < 4; ++j) { const int tt = t - 3 + j; if (tt >= 0) a += F.conv_w[j * 512 + cc] * (float)F.Z[(row - 3 + j) * ZP + cc]; }
                float v = a * sigmoidf_(a);
                if (tid < 64) qs[tid] = v * 0.125f; else ks[tid - 64] = v;
            }
            const float ig = F.GATES[row * 16 + h] + ib, fp = F.GATES[row * 16 + 4 + h] + fb;
            const float logf = fminf(fp, 0.f) - log1pf(__expf(-fabsf(fp)));
            const float m_new = fmaxf(logf + m, ig), fs = __expf(logf + m - m_new), is = __expf(ig - m_new); m = m_new;
            __syncthreads();
            const float ve = (float)F.Z[row * ZP + ZC_MV + h * 128 + e];
            float pn = 0.f;
#pragma unroll
            for (int i = 0; i < 16; ++i) { const int d = qd * 16 + i; C[i] = fs * C[i] + is * ks[d] * ve; pn += qs[d] * C[i]; }
            part[qd * 128 + e] = pn;
            if (tid < 64) { n_d = fs * n_d + is * ks[tid]; const float dn = wave_sum(qs[tid] * n_d); if (tid == 0) red[0] = dn; }
            __syncthreads();
            float hv = 0.f;
            if (tid < 128) {
                const float num = (part[e] + part[128 + e]) + (part[256 + e] + part[384 + e]), den = red[0];
                hv = num / fmaxf(fabsf(den), __expf(-m));
                const float sq = wave_sum(hv * hv); if (F.lane == 0) red[1 + F.wave] = sq;
            }
            __syncthreads();
            if (tid < 128) {
                const float r = 1.f / sqrtf((red[1] + red[2]) * (1.f / 128.f) + EPS);
                const float og = (float)F.Z[row * ZP + ZC_MO + h * 128 + e];
                F.MIX[row * D + h * 128 + e] = (h16)(hv * r * F.mlstm_norm[h * 128 + e] * sigmoidf_(og));
            }
        }
        __syncthreads();
    }
}

constexpr int LQ = 72;
constexpr int LW = 136;
typedef _Float16 h16x4 __attribute__((ext_vector_type(4)));

__device__ __forceinline__ void conv_silu8(const Frame& F, size_t row, int t, int cb, float (&o)[8]) {
#pragma unroll
    for (int i = 0; i < 8; ++i) o[i] = F.conv_b[cb + i];
#pragma unroll
    for (int j = 0; j < 4; ++j) {
        if (t - 3 + j >= 0) {
            const h16x8 z = *(const h16x8*)(F.Z + (row - 3 + j) * ZP + cb);
#pragma unroll
            for (int i = 0; i < 8; ++i) o[i] += F.conv_w[j * 512 + cb + i] * (float)z[i];
        }
    }
#pragma unroll
    for (int i = 0; i < 8; ++i) o[i] = o[i] * sigmoidf_(o[i]);
}
__device__ __forceinline__ float wave_scan_add(float x, int lane) {
#pragma unroll
    for (int o = 1; o < 64; o <<= 1) { const float v = __shfl_up(x, o); if (lane >= o) x += v; }
    return x;
}
__device__ __forceinline__ float wave_scan_max(float x, int lane) {
#pragma unroll
    for (int o = 1; o < 64; o <<= 1) { const float v = __shfl_up(x, o); if (lane >= o) x = fmaxf(x, v); }
    return x;
}

__device__ __forceinline__ void mlstm_A(const Frame& F, LAS unsigned char* lds) {
    LAS h16* KT = (LAS h16*)lds;
    LAS h16* VT = KT + 64 * LQ;
    LAS float* wg = (LAS float*)(VT + 128 * LQ);
    const int tid = F.tid, lane = F.lane, w = F.wave, fr = lane & 15, fq = lane >> 4;
    for (int u = blockIdx.x; u < NB * 4 * 64; u += gridDim.x) {
        const int c = u & 63, h = (u >> 6) & 3, b = u >> 8; const size_t row0 = (size_t)b * S + c * 64;
        if (w == 0) {
            const float ig = F.GATES[(row0 + lane) * 16 + h] + F.i_bias[h], fp = F.GATES[(row0 + lane) * 16 + 4 + h] + F.f_bias[h];
            const float logf = fminf(fp, 0.f) - log1pf(__expf(-fabsf(fp)));
            const float bl = wave_scan_add(logf, lane), g = __shfl(bl, 63);
            const float a = g - bl + ig, ml = wave_max(a);
            wg[lane] = __expf(a - ml);
            if (lane == 0) { F.G[u] = g; F.MLOC[u] = ml; }
        }
        __syncthreads();
        { const int l = tid >> 3, c8 = (tid & 7) * 8; float o[8]; conv_silu8(F, row0 + l, c * 64 + l, ZC_MK + h * 64 + c8, o);
#pragma unroll
          for (int i = 0; i < 8; ++i) KT[(c8 + i) * LQ + l] = (h16)o[i]; }
#pragma unroll
        for (int j = 0; j < 2; ++j) { const int id = tid + 512 * j, l = id >> 4, e8 = (id & 15) * 8; const float wl = wg[l];
            const h16x8 v = *(const h16x8*)(F.Z + (row0 + l) * ZP + ZC_MV + h * 128 + e8);
#pragma unroll
            for (int i = 0; i < 8; ++i) VT[(e8 + i) * LQ + l] = (h16)((float)v[i] * wl); }
        __syncthreads();
        f32x4 acc[4];
#pragma unroll
        for (int db = 0; db < 4; ++db) acc[db] = (f32x4){0.f, 0.f, 0.f, 0.f};
#pragma unroll
        for (int ks = 0; ks < 2; ++ks) {
            const h16x8 a = *(const LAS h16x8*)(VT + (16 * w + fr) * LQ + 32 * ks + 8 * fq);
#pragma unroll
            for (int db = 0; db < 4; ++db) { const h16x8 bb = *(const LAS h16x8*)(KT + (16 * db + fr) * LQ + 32 * ks + 8 * fq);
                acc[db] = __builtin_amdgcn_mfma_f32_16x16x32_f16(a, bb, acc[db], 0, 0, 0); }
        }
        float* kvt = F.KVT + (size_t)u * 8192;
#pragma unroll
        for (int db = 0; db < 4; ++db)
#pragma unroll
            for (int i = 0; i < 4; ++i) kvt[(16 * w + 4 * fq + i) * 64 + 16 * db + fr] = acc[db][i];
        if (tid < 64) { float s = 0.f; for (int l = 0; l < 64; ++l) s += wg[l] * (float)KT[tid * LQ + l]; F.KS[(size_t)u * 64 + tid] = s; }
        __syncthreads();
    }
}

__device__ __forceinline__ void mlstm_B(const Frame& F) {
    typedef float f32x2 __attribute__((ext_vector_type(2)));
    const int tid = F.tid;
    for (int slot = blockIdx.x; slot < 256; slot += gridDim.x) {
        const int bh = slot >> 3, part = slot & 7; const int idx = part * 1024 + tid * 2;
        float* base = F.KVT + (size_t)bh * 64 * 8192 + idx;
        const bool do_n = (part == 0 && tid < 64);
        f32x2 st = (f32x2){0.f, 0.f}; float nst = 0.f, m = 0.f;
        for (int c0 = 0; c0 < 64; c0 += 8) {
            f32x2 kv[8]; float ksv[8];
#pragma unroll
            for (int j = 0; j < 8; ++j) { kv[j] = *(const f32x2*)(base + (size_t)(c0 + j) * 8192); ksv[j] = do_n ? F.KS[(size_t)(bh * 64 + c0 + j) * 64 + tid] : 0.f; }
#pragma unroll
            for (int j = 0; j < 8; ++j) {
                const int u = bh * 64 + c0 + j; const float g = F.G[u], ml = F.MLOC[u];
                *(f32x2*)(base + (size_t)(c0 + j) * 8192) = st;
                if (do_n) F.KS[(size_t)u * 64 + tid] = nst;
                if (part == 0 && tid == 0) F.MPREV[u] = m;
                const float mn = fmaxf(g + m, ml), dec = __expf(g + m - mn), sc = __expf(ml - mn);
                st = dec * st + sc * kv[j]; nst = dec * nst + sc * ksv[j]; m = mn;
            }
        }
    }
}

__device__ __forceinline__ void mlstm_C(const Frame& F, LAS unsigned char* lds) {
    LAS h16* Qs = (LAS h16*)lds;
    LAS h16* Ks = Qs + 64 * LQ;
    LAS h16* QS = Ks + 64 * LQ;
    LAS h16* BT = QS + 64 * LW;
    LAS float* fa = (LAS float*)(BT + 128 * LW);
    LAS float *ul = fa, *wl = fa + 64, *iw = fa + 128, *emt = fa + 192, *den = fa + 256, *nb = fa + 320, *rowsq = fa + 384;
    const int tid = F.tid, lane = F.lane, w = F.wave, fr = lane & 15, fq = lane >> 4;
    for (int u = blockIdx.x; u < NB * 4 * 64; u += gridDim.x) {
        const int c = u & 63, h = (u >> 6) & 3, b = u >> 8; const size_t row0 = (size_t)b * S + c * 64;
        if (w == 0) {
            const float ig = F.GATES[(row0 + lane) * 16 + h] + F.i_bias[h], fp = F.GATES[(row0 + lane) * 16 + 4 + h] + F.f_bias[h];
            const float logf = fminf(fp, 0.f) - log1pf(__expf(-fabsf(fp)));
            const float bl = wave_scan_add(logf, lane), ww = ig - bl, pm = wave_scan_max(ww, lane);
            const float il = bl + F.MPREV[u], mt = fmaxf(il, bl + pm);
            ul[lane] = bl - mt; wl[lane] = ww; iw[lane] = __expf(il - mt); emt[lane] = __expf(-mt);
        }
        if (tid < 64) nb[tid] = F.KS[(size_t)u * 64 + tid];
        { const int l = tid >> 3, c8 = (tid & 7) * 8; float o[8];
          conv_silu8(F, row0 + l, c * 64 + l, ZC_MQ + h * 64 + c8, o);
          h16x8 hv;
#pragma unroll
          for (int i = 0; i < 8; ++i) hv[i] = (h16)(o[i] * 0.125f);
          *(LAS h16x8*)(Qs + l * LQ + c8) = hv;
          conv_silu8(F, row0 + l, c * 64 + l, ZC_MK + h * 64 + c8, o);
#pragma unroll
          for (int i = 0; i < 8; ++i) hv[i] = (h16)o[i];
          *(LAS h16x8*)(Ks + l * LQ + c8) = hv; }
#pragma unroll
        for (int j = 0; j < 2; ++j) { const int id = tid + 512 * j;
            { const int l = id >> 4, e8 = (id & 15) * 8; const h16x8 v = *(const h16x8*)(F.Z + (row0 + l) * ZP + ZC_MV + h * 128 + e8);
#pragma unroll
              for (int i = 0; i < 8; ++i) BT[(e8 + i) * LW + 64 + l] = v[i]; }
            { const int e = id >> 3, d8 = (id & 7) * 8; const float* cp = F.KVT + (size_t)u * 8192 + e * 64 + d8; const f32x4 c0 = *(const f32x4*)cp, c1 = *(const f32x4*)(cp + 4);
              h16x8 hv; hv[0] = (h16)c0[0]; hv[1] = (h16)c0[1]; hv[2] = (h16)c0[2]; hv[3] = (h16)c0[3]; hv[4] = (h16)c1[0]; hv[5] = (h16)c1[1]; hv[6] = (h16)c1[2]; hv[7] = (h16)c1[3];
              *(LAS h16x8*)(BT + e * LW + d8) = hv; } }
        __syncthreads();
        { const int l = tid >> 3, c8 = (tid & 7) * 8; const h16x8 q = *(const LAS h16x8*)(Qs + l * LQ + c8); const float s = iw[l]; h16x8 hv;
#pragma unroll
          for (int i = 0; i < 8; ++i) hv[i] = (h16)((float)q[i] * s);
          *(LAS h16x8*)(QS + l * LW + c8) = hv; }
#pragma unroll
        for (int tt = 0; tt < 2; ++tt) {
            const int lb = w & 3, sb = 2 * (w >> 2) + tt;
            f32x4 acc = (f32x4){0.f, 0.f, 0.f, 0.f};
            if (sb <= lb) {
#pragma unroll
                for (int ks = 0; ks < 2; ++ks) { const h16x8 a = *(const LAS h16x8*)(Qs + (16 * lb + fr) * LQ + 32 * ks + 8 * fq), bb = *(const LAS h16x8*)(Ks + (16 * sb + fr) * LQ + 32 * ks + 8 * fq);
                    acc = __builtin_amdgcn_mfma_f32_16x16x32_f16(a, bb, acc, 0, 0, 0); }
            }
            const int s = 16 * sb + fr; const float ws = wl[s];
#pragma unroll
            for (int i = 0; i < 4; ++i) { const int l = 16 * lb + 4 * fq + i; const float v = (s <= l) ? acc[i] * __expf(ul[l] + ws) : 0.f; QS[l * LW + 64 + s] = (h16)v; }
        }
        __syncthreads();
        { const int l = tid >> 3, part = tid & 7; float s = 0.f;
#pragma unroll
          for (int j = 0; j < 2; ++j) { const h16x8 q = *(const LAS h16x8*)(QS + l * LW + 16 * part + 8 * j);
#pragma unroll
              for (int i = 0; i < 8; ++i) { const int k = 16 * part + 8 * j + i; s += (float)q[i] * (k < 64 ? nb[k] : 1.f); } }
          s += __shfl_xor(s, 1); s += __shfl_xor(s, 2); s += __shfl_xor(s, 4);
          if (part == 0) den[l] = s; }
        f32x4 acc[4];
#pragma unroll
        for (int lb = 0; lb < 4; ++lb) acc[lb] = (f32x4){0.f, 0.f, 0.f, 0.f};
#pragma unroll
        for (int ks = 0; ks < 4; ++ks) { const h16x8 bb = *(const LAS h16x8*)(BT + (16 * w + fr) * LW + 32 * ks + 8 * fq);
#pragma unroll
            for (int lb = 0; lb < 4; ++lb) { const h16x8 a = *(const LAS h16x8*)(QS + (16 * lb + fr) * LW + 32 * ks + 8 * fq);
                acc[lb] = __builtin_amdgcn_mfma_f32_16x16x32_f16(a, bb, acc[lb], 0, 0, 0); } }
        __syncthreads();
#pragma unroll
        for (int lb = 0; lb < 4; ++lb)
#pragma unroll
            for (int i = 0; i < 4; ++i) { const int l = 16 * lb + 4 * fq + i; const float hv = acc[lb][i] / fmaxf(fabsf(den[l]), emt[l]); acc[lb][i] = hv;
                float sq = hv * hv; sq += __shfl_xor(sq, 1); sq += __shfl_xor(sq, 2); sq += __shfl_xor(sq, 4); sq += __shfl_xor(sq, 8);
                if (fr == 0) rowsq[w * 64 + l] = sq; }
        __syncthreads();
        const int e = 16 * w + fr; const float gn = F.mlstm_norm[h * 128 + e];
#pragma unroll
        for (int lb = 0; lb < 4; ++lb)
#pragma unroll
            for (int i = 0; i < 4; ++i) { const int l = 16 * lb + 4 * fq + i; float tot = 0.f;
#pragma unroll
                for (int ww = 0; ww < 8; ++ww) tot += rowsq[ww * 64 + l];
                const float r = 1.f / sqrtf(tot * (1.f / 128.f) + EPS);
                const float og = (float)F.Z[(row0 + l) * ZP + ZC_MO + h * 128 + e];
                F.MIX[(row0 + l) * D + h * 128 + e] = (h16)(acc[lb][i] * r * gn * sigmoidf_(og)); }
        __syncthreads();
    }
}

__device__ __forceinline__ void kn_phase(const Frame& F) {
    const int gw = blockIdx.x * 8 + F.wave, NGW = gridDim.x * 8;
    const float g = F.idx_k_norm[F.lane];
    for (int m = gw; m < T; m += NGW) {
        const float v = (float)F.Z[(size_t)m * ZP + ZC_IK + F.lane];
        const float r = 1.f / sqrtf(wave_sum(v * v) * (1.f / 64.f) + EPS);
        F.KN[(size_t)m * 64 + F.lane] = (h16)(v * r * g);
    }
}

__device__ __forceinline__ unsigned ord_key(float f) { const unsigned u = __float_as_uint(f); return (u & 0x80000000u) ? ~u : (u | 0x80000000u); }

__device__ __forceinline__ void index_naive(const Frame& F, LAS unsigned char* lds) {
    LAS float* qf = (LAS float*)lds;
    LAS float* wq = qf + 512;
    LAS unsigned* cnt = (LAS unsigned*)(wq + 8);
    LAS unsigned* keys = cnt + 40;
    const int tid = F.tid;
    for (int row = blockIdx.x; row < T; row += gridDim.x) {
        const int t = row & (S - 1), b = row >> 12;
        __syncthreads();
        qf[tid] = (float)F.Z[(size_t)row * ZP + ZC_IQ + tid];
        if (tid < 8) wq[tid] = F.GATES[(size_t)row * 16 + 8 + tid] * 0.35355339059327373f;
        if (tid < 40) cnt[tid] = 0u;
        __syncthreads();
        unsigned kk[8];
#pragma unroll
        for (int j = 0; j < 8; ++j) {
            const int s = tid + 512 * j; kk[j] = 0u;
            if (s <= t) {
                const h16* kr = F.KN + ((size_t)b * S + s) * 64;
                float kf[64];
#pragma unroll
                for (int c = 0; c < 8; ++c) { const h16x8 v = *(const h16x8*)(kr + 8 * c);
#pragma unroll
                    for (int i = 0; i < 8; ++i) kf[8 * c + i] = (float)v[i]; }
                float score = 0.f;
#pragma unroll
                for (int hh = 0; hh < 8; ++hh) { float dot = 0.f;
#pragma unroll
                    for (int d = 0; d < 64; ++d) dot += qf[hh * 64 + d] * kf[d];
                    score += fmaxf(dot * 0.125f, 0.f) * wq[hh]; }
                kk[j] = ord_key(score); keys[s] = kk[j];
            }
        }
        unsigned vstar = 0u;
        if (t >= TOPK) {
            unsigned prefix = 0u;
            for (int bit = 31; bit >= 0; --bit) {
                const unsigned cand = prefix | (1u << bit); int c = 0;
#pragma unroll
                for (int j = 0; j < 8; ++j) c += (kk[j] >= cand) ? 1 : 0;
                c = wave_isum(c); if (F.lane == 0) atomicAdd((unsigned*)&cnt[bit], (unsigned)c);
                __syncthreads();
                if (cnt[bit] >= (unsigned)TOPK) prefix = cand;
            }
            vstar = prefix;
            int cg = 0, ce = 0;
#pragma unroll
            for (int j = 0; j < 8; ++j) { cg += (kk[j] > vstar) ? 1 : 0; ce += (kk[j] == vstar) ? 1 : 0; }
            cg = wave_isum(cg); ce = wave_isum(ce);
            if (F.lane == 0) { atomicAdd((unsigned*)&cnt[32], (unsigned)cg); atomicAdd((unsigned*)&cnt[33], (unsigned)ce); }
            __syncthreads();
            const int need = TOPK - (int)cnt[32];
            if ((int)cnt[33] > need) {
                if (tid == 0) { int nd = need; for (int s = 0; s <= t; ++s) if (keys[s] == vstar) { if (nd > 0) --nd; else keys[s] = 0u; } }
            }
        }
        __syncthreads();
        if (tid < 128) {
            unsigned word = 0u;
            for (int i = 0; i < 32; ++i) { const int s = 32 * tid + i; if (s <= t && keys[s] >= vstar) word |= (1u << i); }
            F.BM[(size_t)row * 128 + tid] = word;
        }
    }
}

typedef float f32x16 __attribute__((ext_vector_type(16)));
__device__ __forceinline__ size_t bm_index(int b, int t, int kt) { return ((((size_t)(b * 128 + (t >> 5)) * 64 + kt) * 32) + (t & 31)) * 2; }

__device__ __forceinline__ int wave_scan_dpp(int v, int& tot) {
    v += __builtin_amdgcn_update_dpp(0, v, 0x111, 0xF, 0xF, false);
    v += __builtin_amdgcn_update_dpp(0, v, 0x112, 0xF, 0xF, false);
    v += __builtin_amdgcn_update_dpp(0, v, 0x114, 0xF, 0xF, false);
    v += __builtin_amdgcn_update_dpp(0, v, 0x118, 0xF, 0xF, false);
    v += __builtin_amdgcn_update_dpp(0, v, 0x142, 0xA, 0xF, false);
    v += __builtin_amdgcn_update_dpp(0, v, 0x143, 0xC, 0xF, false);
    tot = __builtin_amdgcn_readlane(v, 63);
    return v;
}
template <int NR> __device__ __forceinline__ unsigned kth_largest_pl(const unsigned (&r)[NR], int K, int lowbit) {
    unsigned prefix = 0u;
    for (int bit = 31; bit >= lowbit; --bit) {
        const unsigned cand = prefix | (1u << bit); int c = 0;
#pragma unroll
        for (int j = 0; j < NR; ++j) c += (r[j] >= cand) ? 1 : 0;
        int tot; (void)wave_scan_dpp(c, tot);
        if (tot >= K) prefix = cand;
    }
    return prefix;
}
__device__ __forceinline__ int count_ge_row(const LAS unsigned* kr, int nj, int lane, unsigned thr) {
    int c = 0;
#pragma unroll 8
    for (int j = 0; j < nj; ++j) c += (kr[64 * j + lane] >= thr) ? 1 : 0;
    return c;
}
constexpr int IDX_CAND_OFF = 131072 + 1024, IDX_CAND = 768;
template <int MODE> __device__ __forceinline__ void index_mfma(const Frame& F, LAS unsigned char* lds) {
    LAS unsigned* keys = (LAS unsigned*)lds;
    const int lane = F.lane, w = F.wave, c32 = lane & 31, hi = lane >> 5;
    const int qa = 2 * ((c32 >> 2) & 1) + ((((c32 & 3) + 4 * (c32 >> 3))) >> 3), ha = ((c32 & 3) + 4 * (c32 >> 3)) & 7;
    for (int unit = blockIdx.x; unit < NB * 512; unit += gridDim.x) {
        const int b = unit & 7, qg = unit >> 3, t0 = 8 * qg; const size_t rowbase = (size_t)b * S;
        const int ntile = (t0 + 7) / 32 + 1, L = 32 * ntile;
        h16x8 a[2][4]; float wv[2][16];
#pragma unroll
        for (int blk = 0; blk < 2; ++blk) {
#pragma unroll
            for (int ks = 0; ks < 4; ++ks) a[blk][ks] = *(const h16x8*)(F.Z + (rowbase + t0 + 4 * blk + qa) * ZP + ZC_IQ + ha * 64 + 16 * ks + 8 * hi);
#pragma unroll
            for (int qq = 0; qq < 2; ++qq) { const float* gp = F.GATES + (rowbase + t0 + 4 * blk + 2 * hi + qq) * 16 + 8; const f32x4 g0 = *(const f32x4*)gp, g1 = *(const f32x4*)(gp + 4);
#pragma unroll
                for (int i = 0; i < 4; ++i) { wv[blk][qq * 8 + i] = g0[i] * (0.125f * 0.35355339059327373f); wv[blk][qq * 8 + 4 + i] = g1[i] * (0.125f * 0.35355339059327373f); } }
        }
#ifndef PROBE_X
#define PROBE_X 0
#endif
        for (int rx1 = 0; rx1 < (PROBE_X == 1 ? 2 : 1); ++rx1)
        if (MODE != 2) {
            const h16* kp0 = F.KN + (rowbase + c32) * 64 + 8 * hi;
            for (int tb = w; tb < ntile; tb += 32) {
                h16x8 bf[4][4];
#pragma unroll
                for (int k4 = 0; k4 < 4; ++k4) {
                    if (tb + 8 * k4 < ntile) {
#pragma unroll
                        for (int ks = 0; ks < 4; ++ks) bf[k4][ks] = *(const h16x8*)(kp0 + (size_t)(tb + 8 * k4) * 2048 + 16 * ks);
                    } else {
#pragma unroll
                        for (int ks = 0; ks < 4; ++ks) bf[k4][ks] = a[0][ks];
                    }
                }
#pragma unroll
                for (int k4 = 0; k4 < 4; ++k4) {
                    const int tile = tb + 8 * k4;
                    if (tile < ntile) {
                        const int s = 32 * tile + c32;
#pragma unroll
                        for (int blk = 0; blk < 2; ++blk) {
                            f32x16 acc;
#pragma unroll
                            for (int i = 0; i < 16; ++i) acc[i] = 0.f;
#pragma unroll
                            for (int ks = 0; ks < 4; ++ks) acc = __builtin_amdgcn_mfma_f32_32x32x16_f16(a[blk][ks], bf[k4][ks], acc, 0, 0, 0);
#pragma unroll
                            for (int qq = 0; qq < 2; ++qq) { float sc = 0.f;
#pragma unroll
                                for (int hh = 0; hh < 8; ++hh) sc += __builtin_amdgcn_fmed3f(acc[qq * 8 + hh], 0.f, __builtin_inff()) * wv[blk][qq * 8 + hh];
                                const int ql = 4 * blk + 2 * hi + qq;
                                keys[ql * 4096 + s] = (s <= t0 + ql) ? ord_key(sc) : 0u; }
                        }
                    }
                }
            }
        }
        __syncthreads();
        if (MODE != 1) {
            const int t = t0 + w, nj = (L + 63) >> 6; LAS unsigned* kr = keys + w * 4096; LAS unsigned* cd = (LAS unsigned*)(lds + IDX_CAND_OFF) + w * IDX_CAND;
            if ((L & 32) && lane >= 32) kr[64 * (nj - 1) + lane] = 0u;
            __builtin_amdgcn_wave_barrier();
            unsigned vstar = 0u, thr = 1u; bool trim = false; int allowed = 0;
            if (t >= TOPK) {
                int cgt = 0, ceq = 0;
                if (nj <= 8) {
                    unsigned r8[8];
#pragma unroll
                    for (int i = 0; i < 8; ++i) r8[i] = (i < nj) ? kr[64 * i + lane] : 0u;
                    vstar = kth_largest_pl<8>(r8, TOPK, 0);
#pragma unroll
                    for (int i = 0; i < 8; ++i) { cgt += (r8[i] > vstar) ? 1 : 0; ceq += (r8[i] == vstar) ? 1 : 0; }
                } else {
                    unsigned sm[4];
#pragma unroll
                    for (int i = 0; i < 4; ++i) sm[i] = kr[64 * ((i * nj) >> 2) + lane];
                    const float E = 1024.f / (float)nj; const int m = (int)(E + 3.5f * sqrtf(E)) + 2;
                    unsigned tau = kth_largest_pl<4>(sm, m, 16);
                    int c = count_ge_row(kr, nj, lane, tau), tot; int incl = wave_scan_dpp(c, tot);
                    if (tot < TOPK) { tau = 0u; c = nj; tot = 64 * nj; incl = nj * (lane + 1); }
                    if (tot > IDX_CAND) {
                        const unsigned tau0 = tau; unsigned pre = 0u;
                        for (int bit = 31; bit >= 0; --bit) {
                            const unsigned cand = pre | (1u << bit);
                            if (cand <= tau0) { pre = cand; continue; }
                            const int c2 = count_ge_row(kr, nj, lane, cand); int tot2; const int incl2 = wave_scan_dpp(c2, tot2);
                            if (tot2 >= TOPK) { pre = cand; c = c2; tot = tot2; incl = incl2; if (tot <= IDX_CAND) break; }
                        }
                        tau = pre;
                    }
                    if (tot <= IDX_CAND) {
                        int pos = incl - c;
#pragma unroll 8
                        for (int j = 0; j < nj; ++j) { const unsigned k = kr[64 * j + lane]; if (k >= tau) { cd[pos] = k; ++pos; } }
                        __builtin_amdgcn_wave_barrier();
                        unsigned cc[12];
#pragma unroll
                        for (int i = 0; i < 12; ++i) { const int s = 64 * i + lane; cc[i] = (s < tot) ? cd[s] : 0u; }
                        vstar = kth_largest_pl<12>(cc, TOPK, 0);
#pragma unroll
                        for (int i = 0; i < 12; ++i) { cgt += (cc[i] > vstar) ? 1 : 0; ceq += (cc[i] == vstar) ? 1 : 0; }
                    } else {
                        vstar = tau;
                        for (int j = 0; j < nj; ++j) { const unsigned k = kr[64 * j + lane]; cgt += (k > vstar) ? 1 : 0; ceq += (k == vstar) ? 1 : 0; }
                    }
                }
                int cgt_t, ceq_t; (void)wave_scan_dpp(cgt, cgt_t); (void)wave_scan_dpp(ceq, ceq_t);
                allowed = TOPK - cgt_t; trim = ceq_t > allowed; thr = vstar;
            }
            typedef unsigned u32x2 __attribute__((ext_vector_type(2)));
            if (!trim) {
                int j = 0;
                for (; j + 4 <= nj; j += 4) {
                    const unsigned k0 = kr[64 * j + lane], k1 = kr[64 * j + 64 + lane], k2 = kr[64 * j + 128 + lane], k3 = kr[64 * j + 192 + lane];
                    const unsigned long long m0 = __ballot(k0 >= thr), m1 = __ballot(k1 >= thr), m2 = __ballot(k2 >= thr), m3 = __ballot(k3 >= thr);
                    if (lane < 4) { const unsigned long long mm = lane == 0 ? m0 : lane == 1 ? m1 : lane == 2 ? m2 : m3;
                        *(u32x2*)(F.BM + bm_index(b, t, j + lane)) = (u32x2){(unsigned)mm, (unsigned)(mm >> 32)}; }
                }
                for (; j < nj; ++j) {
                    const unsigned k = kr[64 * j + lane]; const unsigned long long m = __ballot(k >= thr);
                    if (lane == 0) *(u32x2*)(F.BM + bm_index(b, t, j)) = (u32x2){(unsigned)m, (unsigned)(m >> 32)};
                }
            } else {
                for (int j = 0; j < nj; ++j) {
                    const unsigned k = kr[64 * j + lane];
                    const unsigned long long gt = __ballot(k > vstar); unsigned long long eq = __ballot(k == vstar);
                    if (allowed <= 0) eq = 0ull;
                    else { while (__popcll(eq) > allowed) eq &= ~(1ull << (63 - __clzll(eq))); allowed -= __popcll(eq); }
                    const unsigned long long m = gt | eq;
                    if (lane == 0) *(u32x2*)(F.BM + bm_index(b, t, j)) = (u32x2){(unsigned)m, (unsigned)(m >> 32)};
                }
            }
            if (nj + lane < 64) *(u32x2*)(F.BM + bm_index(b, t, nj + lane)) = (u32x2){0u, 0u};
        }
        __syncthreads();
    }
}

__device__ __forceinline__ void attn_naive(const Frame& F, LAS unsigned char* lds) {
    LAS float* qf = (LAS float*)lds;
    LAS float* p = qf + 512;
    LAS int* sel = (LAS int*)(p + 2048);
    LAS int* pcs = sel + 288;
    LAS float* btab = (LAS float*)(pcs + 128);
    LAS int* nselp = (LAS int*)(btab + 1024);
    const int tid = F.tid, hh = F.wave, lane = F.lane;
    for (int i = tid; i < 1024; i += NTHR) {
        const int dist = i >> 3, h = i & 7; int bk;
        if (dist < 16) bk = dist; else { bk = 16 + (int)(log((double)dist / 16.0) / log(8.0) * 16.0); if (bk > 31) bk = 31; }
        btab[i] = F.rel_bias[bk * 8 + h];
    }
    for (int row = blockIdx.x; row < T; row += gridDim.x) {
        const int t = row & (S - 1), b = row >> 12;
        __syncthreads();
        unsigned word = 0u;
        if (tid < 128) { word = F.BM[bm_index(b, t, tid >> 1) + (tid & 1)]; pcs[tid] = __popc(word); }
        qf[tid] = (float)F.Z[(size_t)row * ZP + ZC_AQ + tid];
        __syncthreads();
        if (tid < 128) {
            int off = 0; for (int i = 0; i < tid; ++i) off += pcs[i];
            if (tid == 127) *nselp = off + pcs[127];
            while (word) { const int bpos = __ffs(word) - 1; word &= word - 1; if (off < 288) sel[off] = 32 * tid + bpos; ++off; }
        }
        __syncthreads();
        const int nsel = min(*nselp, 256);
        float lg[4]; float mx = -INFINITY;
#pragma unroll
        for (int jj = 0; jj < 4; ++jj) {
            const int j = lane + 64 * jj; lg[jj] = -INFINITY;
            if (j < nsel) {
                const int s = sel[j]; const h16* kr = F.Z + ((size_t)b * S + s) * ZP + ZC_AK + hh * 64;
                float dot = 0.f;
#pragma unroll
                for (int c = 0; c < 8; ++c) { const h16x8 v = *(const h16x8*)(kr + 8 * c);
#pragma unroll
                    for (int i = 0; i < 8; ++i) dot += qf[hh * 64 + 8 * c + i] * (float)v[i]; }
                const int dist = t - s;
                lg[jj] = dot * 0.125f + btab[(dist < 127 ? dist : 127) * 8 + hh];
                mx = fmaxf(mx, lg[jj]);
            }
        }
        mx = wave_max(mx);
        float sum = 0.f;
#pragma unroll
        for (int jj = 0; jj < 4; ++jj) { const int j = lane + 64 * jj; const float ev = (j < nsel) ? __expf(lg[jj] - mx) : 0.f; sum += ev; p[hh * 256 + j] = ev; }
        sum = wave_sum(sum);
        __syncthreads();
        float acc = 0.f;
        for (int j = 0; j < nsel; ++j) acc += p[hh * 256 + j] * (float)F.Z[((size_t)b * S + sel[j]) * ZP + ZC_AV + hh * 64 + lane];
        F.MIX[(size_t)row * D + 512 + hh * 64 + lane] = (h16)(acc / sum);
    }
}

typedef short v4i16_t __attribute__((ext_vector_type(4)));
__device__ __forceinline__ h16x4 vtr16(const LAS unsigned char* p) { return __builtin_bit_cast(h16x4, __builtin_amdgcn_ds_read_tr16_b64_v4i16((LAS v4i16_t*)p)); }
constexpr float LOG2E = 1.4426950408889634f;
constexpr int AT_K = 0, AT_V = 16384, AT_BT = 32768, AT_WS = 36864;
__device__ __forceinline__ void attn_dense(const Frame& F, LAS unsigned char* lds) {
    const int tid = F.tid, lane = F.lane, w = F.wave, q = lane & 31, hi = lane >> 5;
    LAS float* btab = (LAS float*)(lds + AT_BT);
    LAS float* wsf = (LAS float*)(lds + AT_WS) + w * 64;
    for (int i = tid; i < 1024; i += NTHR) {
        const int dist = i >> 3, h = i & 7; int bk;
        if (dist < 16) bk = dist; else { bk = 16 + (int)(log((double)dist / 16.0) / log(8.0) * 16.0); if (bk > 31) bk = 31; }
        btab[i] = F.rel_bias[bk * 8 + h] * LOG2E;
    }
    __syncthreads();
    const float c2 = 0.125f * LOG2E, THR = 8.f;
    const int vb0 = ((lane >> 4) & 1) * 32 + (lane & 3) * 8 + (4 * hi + ((lane & 15) >> 2)) * 64;
    for (int vu = blockIdx.x; vu < 256; vu += gridDim.x)
    for (int rr = 0; rr < 4; ++rr) {
        const int bh = vu >> 2, jj = vu & 3, qb = rr == 0 ? jj : rr == 1 ? 7 - jj : rr == 2 ? 8 + jj : 15 - jj, b = bh >> 3, h = bh & 7;
        const size_t rowbase = (size_t)b * S; const int q0 = qb * 256 + 32 * w, t = q0 + q, NT = 4 * (qb + 1);
        h16x8 qf[4];
#pragma unroll
        for (int ks = 0; ks < 4; ++ks) qf[ks] = *(const h16x8*)(F.Z + (rowbase + t) * ZP + ZC_AQ + h * 64 + 16 * ks + 8 * hi);
        const h16* kg = F.Z + (rowbase + lane) * ZP + ZC_AK + h * 64 + 8 * w;
        const h16* vg = F.Z + (rowbase + 16 * (w & 3) + (lane >> 2)) * ZP + ZC_AV + h * 64 + (w >> 2) * 32 + (lane & 3) * 8;
        const int sdst = w * 1024 + lane * 16;
        const unsigned* bmp = F.BM + bm_index(b, t, 0);
        typedef unsigned u32x2 __attribute__((ext_vector_type(2)));
        { const u32x4 kr = *(const u32x4*)kg, vr = *(const u32x4*)vg; *(LAS u32x4*)(lds + AT_K + sdst) = kr; *(LAS u32x4*)(lds + AT_V + sdst) = vr; }
        u32x2 mw = *(const u32x2*)bmp;
        __syncthreads();
        float m_run = -1e30f, l_part = 0.f; f32x16 o[2];
#pragma unroll
        for (int i = 0; i < 16; ++i) { o[0][i] = 0.f; o[1][i] = 0.f; }
        for (int kt = 0; kt < NT; ++kt) {
            const int cur = kt & 1; const bool more = (kt + 1 < NT);
            u32x4 kr, vr; u32x2 mwn = (u32x2){0u, 0u};
            if (more) { kr = *(const u32x4*)(kg + (size_t)(kt + 1) * 64 * ZP); vr = *(const u32x4*)(vg + (size_t)(kt + 1) * 64 * ZP); mwn = *(const u32x2*)(bmp + (size_t)(kt + 1) * 64); }
            if (64 * kt <= q0 + 31) {
                f32x16 p0, p1;
#pragma unroll
                for (int i = 0; i < 16; ++i) { p0[i] = 0.f; p1[i] = 0.f; }
                const LAS unsigned char* kb = lds + AT_K + cur * 8192 + hi * 1024 + q * 16;
#pragma unroll
                for (int d0 = 0; d0 < 4; ++d0) { const h16x8 b0 = *(const LAS h16x8*)(kb + d0 * 2048), b1 = *(const LAS h16x8*)(kb + d0 * 2048 + 512);
                    p0 = __builtin_amdgcn_mfma_f32_32x32x16_f16(b0, qf[d0], p0, 0, 0, 0); p1 = __builtin_amdgcn_mfma_f32_32x32x16_f16(b1, qf[d0], p1, 0, 0, 0); }
                if (q0 - (64 * kt + 63) >= 127) { const float bb = btab[127 * 8 + h];
#pragma unroll
                    for (int r = 0; r < 16; ++r) { p0[r] = p0[r] * c2 + bb; p1[r] = p1[r] * c2 + bb; }
                } else {
#pragma unroll
                    for (int r = 0; r < 16; ++r) { const int kv = 64 * kt + (r & 3) + 8 * (r >> 2) + 4 * hi; int d0_ = t - kv, d1_ = d0_ - 32;
                        d0_ = d0_ < 0 ? 0 : (d0_ > 127 ? 127 : d0_); d1_ = d1_ < 0 ? 0 : (d1_ > 127 ? 127 : d1_);
                        p0[r] = p0[r] * c2 + btab[d0_ * 8 + h]; p1[r] = p1[r] * c2 + btab[d1_ * 8 + h]; }
                }
                float mx = fmaxf(p0[0], p1[0]);
#pragma unroll
                for (int r = 1; r < 16; ++r) mx = fmaxf(mx, fmaxf(p0[r], p1[r]));
                mx = fmaxf(mx, __shfl_xor(mx, 32));
                if (__ballot(mx > m_run + THR) != 0ull) {
                    const float mn = fmaxf(m_run, mx), alpha = __builtin_amdgcn_exp2f(m_run - mn); m_run = mn; l_part *= alpha;
                    __builtin_amdgcn_wave_barrier();
                    if (hi == 0) wsf[q] = alpha;
                    __builtin_amdgcn_wave_barrier();
#pragma unroll
                    for (int g = 0; g < 4; ++g) { const f32x4 av = *(const LAS f32x4*)(wsf + 8 * g + 4 * hi);
#pragma unroll
                        for (int i = 0; i < 4; ++i) { o[0][4 * g + i] *= av[i]; o[1][4 * g + i] *= av[i]; } }
                    __builtin_amdgcn_wave_barrier();
                }
                const unsigned w0s = mw.x >> (4 * hi), w1s = mw.y >> (4 * hi);
#pragma unroll
                for (int r = 0; r < 16; ++r) { const int pos = (r & 3) + 8 * (r >> 2);
                    const float e0 = __builtin_amdgcn_exp2f(p0[r] - m_run), e1 = __builtin_amdgcn_exp2f(p1[r] - m_run);
                    const unsigned k0 = (unsigned)(-(int)((w0s >> pos) & 1u)), k1 = (unsigned)(-(int)((w1s >> pos) & 1u));
                    p0[r] = __uint_as_float(__float_as_uint(e0) & k0); p1[r] = __uint_as_float(__float_as_uint(e1) & k1);
                    l_part += p0[r] + p1[r]; }
                h16x8 pa[4];
#pragma unroll
                for (int j = 0; j < 8; ++j) { pa[0][j] = (h16)p0[j]; pa[1][j] = (h16)p0[8 + j]; pa[2][j] = (h16)p1[j]; pa[3][j] = (h16)p1[8 + j]; }
                const LAS unsigned char* vb = lds + AT_V + cur * 8192 + vb0;
#pragma unroll
                for (int d0 = 0; d0 < 2; ++d0)
#pragma unroll
                    for (int ks = 0; ks < 4; ++ks) { const h16x4 lo = vtr16(vb + d0 * 4096 + ks * 1024), hh = vtr16(vb + d0 * 4096 + ks * 1024 + 512);
                        h16x8 bv; bv[0] = lo[0]; bv[1] = lo[1]; bv[2] = lo[2]; bv[3] = lo[3]; bv[4] = hh[0]; bv[5] = hh[1]; bv[6] = hh[2]; bv[7] = hh[3];
                        o[d0] = __builtin_amdgcn_mfma_f32_32x32x16_f16(pa[ks], bv, o[d0], 0, 0, 0); }
            }
            if (more) { *(LAS u32x4*)(lds + AT_K + (cur ^ 1) * 8192 + sdst) = kr; *(LAS u32x4*)(lds + AT_V + (cur ^ 1) * 8192 + sdst) = vr; }
            mw = mwn;
            __syncthreads();
        }
        const float lt = l_part + __shfl_xor(l_part, 32), inv = 1.f / lt;
        __builtin_amdgcn_wave_barrier();
        if (hi == 0) wsf[q] = inv;
        __builtin_amdgcn_wave_barrier();
#pragma unroll
        for (int g = 0; g < 4; ++g) { const f32x4 av = *(const LAS f32x4*)(wsf + 8 * g + 4 * hi);
#pragma unroll
            for (int i = 0; i < 4; ++i) { const int qq = 8 * g + 4 * hi + i; h16* op = F.MIX + (rowbase + q0 + qq) * D + 512 + h * 64 + q;
                op[0] = (h16)(o[0][4 * g + i] * av[i]); op[32] = (h16)(o[1][4 * g + i] * av[i]); } }
        __builtin_amdgcn_wave_barrier();
    }
}

__device__ __forceinline__ void h2_phase(const Frame& F) {
    const int gw = blockIdx.x * 8 + F.wave, NGW = gridDim.x * 8;
    for (int m = gw; m < T; m += NGW) rms_row_to_h16(F.out + (size_t)m * D, F.norm_ffn, F.XN + (size_t)m * D, F.lane);
}
__device__ __forceinline__ void act_phase(const Frame& F, int row_lo, int row_hi) {
    constexpr int NCG = DFF / 8;
    const int nitems = ((row_hi - row_lo) / 32) * NCG;
    for (int id = blockIdx.x * NTHR + F.tid; id < nitems; id += gridDim.x * NTHR) {
        const int cg = id % NCG, run = id / NCG, c = cg * 8, pc = 256 * (c >> 7) + (c & 127);
        float wgt[3][8], wvl[3][8], bg[8], bv[8];
#pragma unroll
        for (int j = 0; j < 3; ++j) {
#pragma unroll
            for (int q4 = 0; q4 < 2; ++q4) { const f32x4 a = *(const f32x4*)(F.ffn_conv_w + j * NUP + c + 4 * q4), bq = *(const f32x4*)(F.ffn_conv_w + j * NUP + DFF + c + 4 * q4);
#pragma unroll
                for (int i = 0; i < 4; ++i) { wgt[j][4 * q4 + i] = a[i]; wvl[j][4 * q4 + i] = bq[i]; } }
        }
#pragma unroll
        for (int q4 = 0; q4 < 2; ++q4) { const f32x4 a = *(const f32x4*)(F.ffn_conv_b + c + 4 * q4), bq = *(const f32x4*)(F.ffn_conv_b + DFF + c + 4 * q4);
#pragma unroll
            for (int i = 0; i < 4; ++i) { bg[4 * q4 + i] = a[i]; bv[4 * q4 + i] = bq[i]; } }
        const int r0 = run * 32, t0 = (row_lo + r0) & (S - 1);
        const h16* yb = F.Y + (size_t)r0 * NUP + pc;
        h16x8 g2, g1, v2, v1;
#pragma unroll
        for (int i = 0; i < 8; ++i) { g2[i] = (h16)0.f; g1[i] = (h16)0.f; v2[i] = (h16)0.f; v1[i] = (h16)0.f; }
        if (t0 != 0) { g2 = *(const h16x8*)(yb - 2 * (ptrdiff_t)NUP); v2 = *(const h16x8*)(yb - 2 * (ptrdiff_t)NUP + 128); g1 = *(const h16x8*)(yb - (ptrdiff_t)NUP); v1 = *(const h16x8*)(yb - (ptrdiff_t)NUP + 128); }
        h16* ob = F.ACT + (size_t)(row_lo + r0) * DFF + c;
#pragma unroll 4
        for (int rr = 0; rr < 32; ++rr) {
            const h16x8 g0 = *(const h16x8*)(yb + (size_t)rr * NUP), v0 = *(const h16x8*)(yb + (size_t)rr * NUP + 128);
            h16x8 o;
#pragma unroll
            for (int i = 0; i < 8; ++i) {
                const float ug = bg[i] + wgt[0][i] * (float)g2[i] + wgt[1][i] * (float)g1[i] + wgt[2][i] * (float)g0[i];
                const float uv = bv[i] + wvl[0][i] * (float)v2[i] + wvl[1][i] * (float)v1[i] + wvl[2][i] * (float)v0[i];
                o[i] = (h16)(ug * sigmoidf_(ug) * uv);
            }
            *(h16x8*)(ob + (size_t)rr * DFF) = o;
            g2 = g1; g1 = g0; v2 = v1; v1 = v0;
        }
    }
}
__device__ __forceinline__ void final_norm_phase(const Frame& F) {
    const int gw = blockIdx.x * 8 + F.wave, NGW = gridDim.x * 8;
    for (int m = gw; m < T; m += NGW) {
        float* xr = F.out + (size_t)m * D; f32x4 v[4]; float s = 0.f;
#pragma unroll
        for (int j = 0; j < 4; ++j) { v[j] = *(const f32x4*)(xr + 4 * F.lane + 256 * j); s += (v[j].x * v[j].x + v[j].y * v[j].y) + (v[j].z * v[j].z + v[j].w * v[j].w); }
        const float r = 1.f / sqrtf(wave_sum(s) * (1.f / D) + EPS);
#pragma unroll
        for (int j = 0; j < 4; ++j) { const f32x4 g = *(const f32x4*)(F.norm_final + 4 * F.lane + 256 * j); *(f32x4*)(xr + 4 * F.lane + 256 * j) = (f32x4){v[j].x * r * g.x, v[j].y * r * g.y, v[j].z * r * g.z, v[j].w * r * g.w}; }
    }
}


#ifndef MK_N_LAUNCHES
#define MK_N_LAUNCHES 1
#endif
constexpr int N_PHASES = 14;
constexpr int RING_BYTES = 131072, MISC_OFF = RING_BYTES + 320, LDS_BYTES = 157696;
constexpr int CW_BAR = 4096;
constexpr size_t CTL_ZERO_BYTES = 64 * 1024;
__global__ void __launch_bounds__(NTHR, 2) mk_fwd(Args a) {
    extern __shared__ __attribute__((aligned(16))) unsigned char lds_raw[];
    LAS unsigned char* lds = (LAS unsigned char*)lds_raw;
    Frame F;
    F.x = a.in[0]; F.norm_mix = a.in[1]; F.w_in = a.in[2]; F.conv_w = a.in[3]; F.conv_b = a.in[4]; F.i_bias = a.in[5]; F.f_bias = a.in[6]; F.mlstm_norm = a.in[7];
    F.idx_k_norm = a.in[8]; F.rel_bias = a.in[9]; F.w_out = a.in[10]; F.norm_ffn = a.in[11]; F.w_up = a.in[12]; F.ffn_conv_w = a.in[13]; F.ffn_conv_b = a.in[14];
    F.w_down = a.in[15]; F.norm_final = a.in[16]; F.out = a.out;
    unsigned char* ws = a.ws;
    F.WIN = (h16*)(ws + WS_WIN); F.WOUT = (h16*)(ws + WS_WOUT); F.WUP = (h16*)(ws + WS_WUP); F.WDN = (h16*)(ws + WS_WDN);
    F.GATES = (float*)(ws + WS_GATES); F.XN = (h16*)(ws + WS_XN); F.Z = (h16*)(ws + WS_Z); F.MIX = (h16*)(ws + WS_MIX); F.KN = (h16*)(ws + WS_KN);
    F.BM = (unsigned*)(ws + WS_BM); F.KVT = (float*)(ws + WS_KVT); F.KS = (float*)(ws + WS_KS); F.G = (float*)(ws + WS_GML); F.MLOC = F.G + 2048; F.MPREV = F.G + 4096; F.Y = (h16*)(ws + WS_Y); F.ACT = (h16*)(ws + WS_ACT);
    F.tid = threadIdx.x; F.lane = F.tid & 63; F.wave = __builtin_amdgcn_readfirstlane(F.tid >> 6);
    volatile LAS unsigned* MISC = (volatile LAS unsigned*)(lds + MISC_OFF);
    for (int u = F.tid; u < (LDS_BYTES - RING_BYTES) / 4; u += NTHR) ((LAS unsigned*)(lds + RING_BYTES))[u] = 0u;
    __syncthreads();
    XcdBarrier bar; bar.bar = (unsigned*)(ws + WS_CTL) + CW_BAR; bar.x = 0; bar.st = nullptr;
    if (MK_N_LAUNCHES == 1) bar = xcd_barrier_post((unsigned*)(ws + WS_CTL) + CW_BAR, MISC + 8);
    const int lo = a.ph_lo, hi = a.ph_hi, G = gridDim.x;
#define IN(k) (lo <= (k) && (k) < hi)
#define SEAM(k) do { if (IN(k) && IN((k) + 1)) xcd_barrier(bar); } while (0)
#ifndef PROBE_DUP
#define PROBE_DUP 0
#endif
#define REP(k) for (int rep_ = 0; rep_ <= ((PROBE_DUP >> (k)) & 1); ++rep_)
    if (IN(0)) REP(0) p0_prologue(F, lds);
    SEAM(0);
    if (IN(1)) { pg8::Gemm g{(const pg8::bf16_t*)F.XN, (const pg8::bf16_t*)F.WIN, T, ZP, D}; pg8::StaticOrder So; So.init(T, ZP, G, (int)blockIdx.x);
        pg8::EpiH16 E{F.Z, ZP, 0, F.GATES, ZC_G}; pg8::gemm_phase<pg8::EpiH16, pg8::StaticOrder, true, true>(lds, g, So, E); }
    SEAM(1);
    if (IN(2)) { kn_phase(F); REP(2) mlstm_A(F, lds); }
    SEAM(2);
    if (IN(3)) mlstm_B(F);
    SEAM(3);
    if (IN(4)) { REP(4) mlstm_C(F, lds); index_mfma<0>(F, lds);
#ifdef PROBE_IDX
        index_mfma<PROBE_IDX>(F, lds);
#endif
 }
    SEAM(4);
    if (IN(5)) REP(5) attn_dense(F, lds);
    SEAM(5);
    if (IN(6)) { pg8::Gemm g{(const pg8::bf16_t*)F.MIX, (const pg8::bf16_t*)F.WOUT, T, D, D}; pg8::StaticOrder So; So.init(T, D, G, (int)blockIdx.x);
        pg8::EpiRes32 E{F.x, F.out, D}; pg8::gemm_phase<pg8::EpiRes32, pg8::StaticOrder, true, true>(lds, g, So, E); }
    SEAM(6);
    if (IN(7)) REP(7) h2_phase(F);
    SEAM(7);
    if (IN(8)) { pg8::Gemm g{(const pg8::bf16_t*)F.XN, (const pg8::bf16_t*)F.WUP, T / 2, NUP, D}; pg8::StaticOrder So; So.init(T / 2, NUP, G, (int)blockIdx.x);
        pg8::EpiH16 E{F.Y, NUP, 0, nullptr, 0}; pg8::gemm_phase<pg8::EpiH16, pg8::StaticOrder, true, true>(lds, g, So, E); }
    SEAM(8);
    if (IN(9)) REP(9) act_phase(F, 0, T / 2);
    SEAM(9);
    if (IN(10)) { pg8::Gemm g{(const pg8::bf16_t*)(F.XN + (size_t)(T / 2) * D), (const pg8::bf16_t*)F.WUP, T / 2, NUP, D}; pg8::StaticOrder So; So.init(T / 2, NUP, G, (int)blockIdx.x);
        pg8::EpiH16 E{F.Y, NUP, 0, nullptr, 0}; pg8::gemm_phase<pg8::EpiH16, pg8::StaticOrder, true, true>(lds, g, So, E); }
    SEAM(10);
    if (IN(11)) REP(11) act_phase(F, T / 2, T);
    SEAM(11);
    if (IN(12)) { pg8::Gemm g{(const pg8::bf16_t*)F.ACT, (const pg8::bf16_t*)F.WDN, T, D, DFF}; pg8::StaticOrder So; So.init(T, D, G, (int)blockIdx.x);
        pg8::EpiRes32 E{F.out, F.out, D}; pg8::gemm_phase<pg8::EpiRes32, pg8::StaticOrder, true, true>(lds, g, So, E); }
    SEAM(12);
    if (IN(13)) final_norm_phase(F);
#undef IN
#undef SEAM
}

extern "C" void kernel_launch(void* const* d_in, const int* in_sizes, int n_in, void* d_out, int out_size, void* d_ws, size_t ws_size, hipStream_t stream) {
    static int grid = 0;
    if (grid == 0) {
        if (n_in != 17 || in_sizes[0] != T * D || out_size != T * D || ws_size < WS_END) { fprintf(stderr, "kernel_launch: unexpected shapes (n_in %d, in0 %d, out %d, ws %zu)\n", n_in, n_in > 0 ? in_sizes[0] : -1, out_size, ws_size); grid = -1; return; }
        int dev = 0, cus = 0, per_cu = 0;
        if (hipGetDevice(&dev) != hipSuccess || hipDeviceGetAttribute(&cus, hipDeviceAttributeMultiprocessorCount, dev) != hipSuccess) { fprintf(stderr, "kernel_launch: device query failed\n"); grid = -1; return; }
        if (hipFuncSetAttribute((const void*)mk_fwd, hipFuncAttributeMaxDynamicSharedMemorySize, LDS_BYTES) != hipSuccess) { fprintf(stderr, "kernel_launch: hipFuncSetAttribute failed\n"); grid = -1; return; }
        if (hipOccupancyMaxActiveBlocksPerMultiprocessor(&per_cu, (const void*)mk_fwd, NTHR, LDS_BYTES) != hipSuccess || per_cu < 1) fprintf(stderr, "kernel_launch: note: occupancy query reports %d workgroups per CU\n", per_cu);
        (void)hipGetLastError();
        grid = cus;
    }
    if (grid < 0) return;
    if (hipMemsetAsync((char*)d_ws + WS_CTL, 0, CTL_ZERO_BYTES, stream) != hipSuccess) { fprintf(stderr, "kernel_launch: memset failed\n"); return; }
    Args a{};
    for (int i = 0; i < 17; ++i) a.in[i] = (const float*)d_in[i];
    a.out = (float*)d_out; a.ws = (unsigned char*)d_ws;
    if (MK_N_LAUNCHES == 1) { a.ph_lo = 0; a.ph_hi = N_PHASES; hipLaunchKernelGGL(mk_fwd, dim3(grid), dim3(NTHR), LDS_BYTES, stream, a); }
    else for (int ph = 0; ph < N_PHASES; ++ph) { a.ph_lo = ph; a.ph_hi = ph + 1; hipLaunchKernelGGL(mk_fwd, dim3(grid), dim3(NTHR), LDS_BYTES, stream, a); }
}
```

```cpp
#include <hip/hip_runtime.h>
#include <cstdio>
#include <cstdint>

#define LAS __attribute__((address_space(3)))
typedef _Float16 h16;
typedef _Float16 h16x8 __attribute__((ext_vector_type(8)));
typedef float f32x4 __attribute__((ext_vector_type(4)));
typedef unsigned u32x4 __attribute__((ext_vector_type(4)));

constexpr int NB = 8, S = 4096, T = NB * S, D = 1024;
constexpr int ZP = 3840;
constexpr int DFF = 2816, NUP = 2 * DFF;
constexpr int ZC_MQ = 0, ZC_MK = 256, ZC_MV = 512, ZC_MO = 1024, ZC_AQ = 1536, ZC_AK = 2048, ZC_AV = 2560, ZC_IQ = 3072, ZC_IK = 3584, ZC_G = 3648;
constexpr int TOPK = 256;
constexpr float EPS = 1e-6f;
constexpr int NTHR = 512;

constexpr size_t MiB = 1u << 20;
constexpr size_t WS_CTL = 0;
constexpr size_t WS_WIN = 2 * MiB;
constexpr size_t WS_WOUT = 10 * MiB;
constexpr size_t WS_WUP = 12 * MiB;
constexpr size_t WS_WDN = 23 * MiB;
constexpr size_t WS_GATES = 29 * MiB;
constexpr size_t WS_XN = 32 * MiB;
constexpr size_t WS_Z = 96 * MiB;
constexpr size_t WS_MIX = 336 * MiB;
constexpr size_t WS_KN = 400 * MiB;
constexpr size_t WS_BM = 404 * MiB;
constexpr size_t WS_Y = 96 * MiB;
constexpr size_t WS_ACT = 96 * MiB;
constexpr size_t WS_SS = 404 * MiB;
constexpr size_t WS_SS2 = 406 * MiB;
constexpr size_t WS_YH = 408 * MiB;
constexpr size_t WS_KVT = 420 * MiB;
constexpr size_t WS_KS = 484 * MiB;
constexpr size_t WS_GML = 485 * MiB;
constexpr size_t WS_END = 486 * MiB;

struct Args { const float* in[17]; float* out; unsigned char* ws; int ph_lo, ph_hi; };

struct Frame {
    const float *x, *norm_mix, *w_in, *conv_w, *conv_b, *i_bias, *f_bias, *mlstm_norm, *idx_k_norm, *rel_bias, *w_out, *norm_ffn, *w_up, *ffn_conv_w, *ffn_conv_b, *w_down, *norm_final;
    float* out;
    h16 *WIN, *WOUT, *WUP, *WDN, *XN, *Z, *MIX, *KN, *Y, *ACT;
    float* GATES; unsigned* BM;
    float *KVT, *KS, *G, *MLOC, *MPREV;
    float *SS, *SS2, *YH, *RSTD;
    int tid, lane, wave;
};

__device__ __forceinline__ float wave_sum(float v) {
#pragma unroll
    for (int o = 1; o < 64; o <<= 1) v += __shfl_xor(v, o);
    return v;
}
__device__ __forceinline__ float wave_max(float v) {
#pragma unroll
    for (int o = 1; o < 64; o <<= 1) v = fmaxf(v, __shfl_xor(v, o));
    return v;
}
__device__ __forceinline__ int wave_isum(int v) {
#pragma unroll
    for (int o = 1; o < 64; o <<= 1) v += __shfl_xor(v, o);
    return v;
}
__device__ __forceinline__ float sigmoidf_(float x) { return 1.f / (1.f + __expf(-x)); }

__device__ __forceinline__ int src_col_in(int n) { return n < 1536 ? n : n < 3648 ? n + 8 : n < 3656 ? n - 3648 + 1536 : n < 3664 ? n : -1; }
__device__ __forceinline__ int src_col_up(int n) { const int pn = n >> 8, r = n & 255; return (r >> 7) * DFF + pn * 128 + (r & 127); }

template <int MODE>
__device__ __forceinline__ void transpose_item(const float* W, int K, int N, h16* WT, int NOUT, LAS float* scr, int item, int lane, const float* kscale = nullptr) {
    const int nblk = NOUT / 32, kb = item / nblk, nb = item % nblk, k0 = 64 * kb, n0 = 32 * nb;
    const int n = n0 + (lane & 31);
    const int sc = MODE == 1 ? src_col_in(n) : MODE == 2 ? src_col_up(n) : n;
#pragma unroll 8
    for (int i = 0; i < 32; ++i) { const int kk = 2 * i + (lane >> 5); scr[kk * 33 + (lane & 31)] = sc >= 0 ? W[(size_t)(k0 + kk) * N + sc] * (kscale ? kscale[k0 + kk] : 1.f) : 0.f; }
    __builtin_amdgcn_s_waitcnt(0xc07f); __builtin_amdgcn_wave_barrier();
    const int c = lane & 7;
#pragma unroll
    for (int j = 0; j < 4; ++j) {
        const int nn = (lane >> 3) + 8 * j; const LAS float* s = scr + (8 * c) * 33 + nn;
        h16x8 o;
#pragma unroll
        for (int i = 0; i < 8; ++i) o[i] = (h16)s[i * 33];
        *(h16x8*)(WT + (size_t)(n0 + nn) * K + k0 + 8 * c) = o;
    }
    __builtin_amdgcn_s_waitcnt(0xc07f); __builtin_amdgcn_wave_barrier();
}

__device__ __forceinline__ void rms_row_to_h16(const float* xrow, const float* g, h16* orow, int lane) {
    f32x4 v[4]; float s = 0.f;
#pragma unroll
    for (int j = 0; j < 4; ++j) { v[j] = *(const f32x4*)(xrow + 4 * lane + 256 * j); s += (v[j].x * v[j].x + v[j].y * v[j].y) + (v[j].z * v[j].z + v[j].w * v[j].w); }
    const float r = 1.f / sqrtf(wave_sum(s) * (1.f / D) + EPS);
#pragma unroll
    for (int j = 0; j < 4; ++j) {
        const f32x4 gg = *(const f32x4*)(g + 4 * lane + 256 * j);
        typedef _Float16 h16x4 __attribute__((ext_vector_type(4)));
        h16x4 o; o[0] = (h16)(v[j].x * r * gg.x); o[1] = (h16)(v[j].y * r * gg.y); o[2] = (h16)(v[j].z * r * gg.z); o[3] = (h16)(v[j].w * r * gg.w);
        *(h16x4*)(orow + 4 * lane + 256 * j) = o;
    }
}

__device__ __forceinline__ void p0_prologue(const Frame& F, LAS unsigned char* lds) {
    LAS float* scr = (LAS float*)lds + F.wave * (64 * 33);
    const int gw = blockIdx.x * 8 + F.wave, NGW = gridDim.x * 8;
    constexpr int I_IN = 16 * (ZP / 32), I_OUT = 16 * (D / 32), I_UP = 16 * (NUP / 32), I_DN = (DFF / 64) * (D / 32);
    for (int it = gw; it < I_IN + I_OUT + I_UP + I_DN; it += NGW) {
        int r = it;
        if (r < I_IN) { transpose_item<1>(F.w_in, D, 3664, F.WIN, ZP, scr, r, F.lane); continue; } r -= I_IN;
        if (r < I_OUT) { transpose_item<0>(F.w_out, D, D, F.WOUT, D, scr, r, F.lane); continue; } r -= I_OUT;
        if (r < I_UP) { transpose_item<2>(F.w_up, D, NUP, F.WUP, NUP, scr, r, F.lane, F.norm_ffn); continue; } r -= I_UP;
        transpose_item<0>(F.w_down, DFF, D, F.WDN, D, scr, r, F.lane);
    }
    for (int m = gw; m < T; m += NGW) rms_row_to_h16(F.x + (size_t)m * D, F.norm_mix, F.XN + (size_t)m * D, F.lane);
}

namespace pg8 {
#define PG8_LAS __attribute__((address_space(3)))
typedef unsigned short bf16_t;
typedef short bf16x8 __attribute__((ext_vector_type(8)));
typedef float f32x4 __attribute__((ext_vector_type(4)));
typedef unsigned u32x4 __attribute__((ext_vector_type(4)));
constexpr int BM = 256, BK = 64, HALF = 128, HTB = HALF * BK * 2  , STAGE_BYTES = 8 * HTB, NXCD = 8, WGM = 8;

__host__ __device__ __forceinline__ int lds_byte(int r, int c) { const int st = (r >> 4) * 2 + (c >> 5), rr = r & 15, cc = c & 31, ob = rr * 64 + cc * 2; return st * 1024 + (ob ^ (((ob >> 9) & 1) << 5)); }
__host__ __device__ __forceinline__ void stage_rc(int b, int& R, int& C) { const int st = b / 1024, sb = b % 1024, swz = sb ^ (((sb >> 9) & 1) << 5); R = (st >> 1) * 16 + swz / 64; C = (st & 1) * 32 + (swz % 64) / 2; }
__host__ __device__ __forceinline__ int perm32(int rho) { const int n = rho >> 4, i = rho & 15; return 8 * (i >> 2) + 4 * n + (i & 3); }

struct Unit { int pm, pn; };
struct Gemm { const bf16_t* A; const bf16_t* Bt; int M, N, K; };

struct StaticOrder {
    int nM, nN, nwg, G, c;
    __host__ __device__ void init(int M, int N, int G_, int c_) { nM = M / BM; nN = N / BM; nwg = nM * nN; G = G_; c = c_; }
    __host__ __device__ bool next(int i, Unit& u) const {
        const long L = (long)i * G + c; if (L >= nwg) return false;
        int wgid = (int)L; { const int q = nwg / NXCD, r = nwg % NXCD, xcd = wgid % NXCD, off = wgid / NXCD; wgid = (xcd < r ? xcd * (q + 1) : r * (q + 1) + (xcd - r) * q) + off; }
        const int nig = WGM * nN, gid = wgid / nig, fm = gid * WGM, gsz = (nM - fm) < WGM ? (nM - fm) : WGM;
        u.pm = fm + ((wgid % nig) % gsz); u.pn = (wgid % nig) / gsz; return true;
    }
    __device__ __forceinline__ void a_ready(const Unit&) const {}
    __device__ __forceinline__ void done(const Unit&) const {}
};

typedef _Float16 f16x8 __attribute__((ext_vector_type(8)));
struct EpiH16 {
    static constexpr bool PERM = true, AFTER_DRAIN = false;
    _Float16* O; int ldc; int row_off; float* G; int gc0;
    __device__ __forceinline__ void operator()(const f32x4 (&acc)[2][2][4][2], const Unit& u, int wr, int wc, int fr, int fq) const {
        const int row0 = row_off + u.pm * BM + wr * 64 + fr, col0 = u.pn * BM + wc * 32 + 8 * fq;
#pragma unroll
        for (int ai = 0; ai < 2; ++ai)
#pragma unroll
            for (int m = 0; m < 4; ++m) { const size_t r = (size_t)(row0 + ai * HALF + m * 16);
#pragma unroll
                for (int bj = 0; bj < 2; ++bj) { const int c = col0 + bj * HALF; const f32x4 v0 = acc[ai][bj][m][0], v1 = acc[ai][bj][m][1];
                    f16x8 o; o[0] = (_Float16)v0[0]; o[1] = (_Float16)v0[1]; o[2] = (_Float16)v0[2]; o[3] = (_Float16)v0[3]; o[4] = (_Float16)v1[0]; o[5] = (_Float16)v1[1]; o[6] = (_Float16)v1[2]; o[7] = (_Float16)v1[3];
                    *(f16x8*)(O + r * ldc + c) = o;
                    if (G && c >= gc0 && c < gc0 + 16) { *(f32x4*)(G + r * 16 + (c - gc0)) = v0; *(f32x4*)(G + r * 16 + (c - gc0) + 4) = v1; } } }
    }
};
struct EpiRes32 {
    static constexpr bool PERM = false, AFTER_DRAIN = false;
    const float* base; float* out; int ldc;
    __device__ __forceinline__ void operator()(const f32x4 (&acc)[2][2][4][2], const Unit& u, int wr, int wc, int fr, int fq) const {
        const int row0 = u.pm * BM + wr * 64 + fr, col0 = u.pn * BM + wc * 32 + 4 * fq;
#pragma unroll
        for (int ai = 0; ai < 2; ++ai)
#pragma unroll
            for (int m = 0; m < 4; ++m) { const size_t off = (size_t)(row0 + ai * HALF + m * 16) * ldc + col0;
#pragma unroll
                for (int bj = 0; bj < 2; ++bj)
#pragma unroll
                    for (int n = 0; n < 2; ++n) { const f32x4 b = *(const f32x4*)(base + off + bj * HALF + n * 16); *(f32x4*)(out + off + bj * HALF + n * 16) = b + acc[ai][bj][m][n]; } }
    }
};

struct EpiOut {
    static constexpr bool PERM = false, AFTER_DRAIN = false;
    const float* base; float* out; _Float16* xn; float* ss;
    __device__ __forceinline__ void operator()(const f32x4 (&acc)[2][2][4][2], const Unit& u, int wr, int wc, int fr, int fq) const {
        typedef _Float16 f16x4 __attribute__((ext_vector_type(4)));
        const int row0 = u.pm * BM + wr * 64 + fr, col0 = u.pn * BM + wc * 32 + 4 * fq;
#pragma unroll
        for (int ai = 0; ai < 2; ++ai)
#pragma unroll
            for (int m = 0; m < 4; ++m) { const size_t row = (size_t)(row0 + ai * HALF + m * 16), off = row * 1024 + col0; float sq = 0.f;
#pragma unroll
                for (int bj = 0; bj < 2; ++bj)
#pragma unroll
                    for (int n = 0; n < 2; ++n) { const f32x4 b = *(const f32x4*)(base + off + bj * HALF + n * 16), v = b + acc[ai][bj][m][n];
                        *(f32x4*)(out + off + bj * HALF + n * 16) = v; sq += (v[0] * v[0] + v[1] * v[1]) + (v[2] * v[2] + v[3] * v[3]);
                        if (xn) { f16x4 h; h[0] = (_Float16)v[0]; h[1] = (_Float16)v[1]; h[2] = (_Float16)v[2]; h[3] = (_Float16)v[3]; *(f16x4*)(xn + off + bj * HALF + n * 16) = h; } }
                sq += __shfl_xor(sq, 16); sq += __shfl_xor(sq, 32);
                if (fq == 0) ss[row * 16 + 4 * u.pn + wc] = sq; }
    }
};
__device__ __forceinline__ float rstd16(const float* sp) {
    const f32x4 a = *(const f32x4*)sp, b = *(const f32x4*)(sp + 4), c = *(const f32x4*)(sp + 8), d = *(const f32x4*)(sp + 12);
    const float s = ((a[0] + a[1]) + (a[2] + a[3])) + ((b[0] + b[1]) + (b[2] + b[3])) + ((c[0] + c[1]) + (c[2] + c[3])) + ((d[0] + d[1]) + (d[2] + d[3]));
    return 1.0f / sqrtf(s * (1.0f / 1024.0f) + 1e-6f);
}
struct EpiHalo {
    static constexpr bool PERM = true, AFTER_DRAIN = false;
    float* yh; int ldc; const float* ss;
    __device__ __forceinline__ void operator()(const f32x4 (&acc)[2][2][4][2], const Unit& u, int wr, int wc, int fr, int fq) const {
        const int r0 = wr * 64 + fr, col0 = u.pn * BM + wc * 32 + 8 * fq;
#pragma unroll
        for (int ai = 0; ai < 2; ++ai)
#pragma unroll
            for (int m = 0; m < 4; ++m) { const int rp = r0 + ai * HALF + m * 16, tok = 256 * (rp >> 1) - 2 + (rp & 1); const float rs = tok >= 0 ? rstd16(ss + (size_t)tok * 16) : 0.f;
#pragma unroll
                for (int bj = 0; bj < 2; ++bj) { float* p = yh + (size_t)rp * ldc + col0 + bj * HALF; const f32x4 z = (f32x4){0.f, 0.f, 0.f, 0.f};
                    *(f32x4*)p = tok >= 0 ? acc[ai][bj][m][0] * rs : z; *(f32x4*)(p + 4) = tok >= 0 ? acc[ai][bj][m][1] * rs : z; }  asm volatile("" ::: "memory"); }
    }
};
struct EpiAct {
    static constexpr bool PERM = true, AFTER_DRAIN = false;
    _Float16* act; const float* rstd; const float* yh; const float* cw; const float* cb; PG8_LAS float* X;
    __device__ __forceinline__ void operator()(f32x4 (&acc)[2][2][4][2], const Unit& u, int wr, int wc, int fr, int fq) const {
        typedef _Float16 f16x4 __attribute__((ext_vector_type(4)));
        const size_t rowb = (size_t)u.pm * BM + wr * 64 + 4 * fr;
        const int gc0 = u.pn * 128 + wc * 32 + 8 * fq;
#pragma unroll
        for (int ai = 0; ai < 2; ++ai)
#pragma unroll
            for (int m = 0; m < 4; ++m) { const float rs = rstd[rowb + ai * HALF + m];
#pragma unroll
                for (int bj = 0; bj < 2; ++bj)
#pragma unroll
                    for (int n = 0; n < 2; ++n) acc[ai][bj][m][n] *= rs; }
        if (fr == 15) {
#pragma unroll
            for (int ai = 0; ai < 2; ++ai)
#pragma unroll
                for (int j = 0; j < 2; ++j) { PG8_LAS float* xp = X + ((((wr * 2 + ai) * 4 + wc) * 2 + j) * 64) + fq * 16;
#pragma unroll
                    for (int bj = 0; bj < 2; ++bj)
#pragma unroll
                        for (int n = 0; n < 2; ++n) *(PG8_LAS f32x4*)(xp + bj * 8 + n * 4) = acc[ai][bj][2 + j][n]; }
        }
        asm volatile("s_waitcnt lgkmcnt(0)" ::: "memory"); __builtin_amdgcn_s_barrier(); asm volatile("" ::: "memory");
        const bool seqstart = (u.pm & 15) == 0;
#pragma unroll
        for (int ai = 0; ai < 2; ++ai)
#pragma unroll
            for (int n = 0; n < 2; ++n) {
                f32x4 ug[4];
#pragma unroll
                for (int bj = 0; bj < 2; ++bj) {
                    f32x4 w3[3];
#pragma unroll
                    for (int j = 0; j < 3; ++j) w3[j] = *(const f32x4*)(cw + j * 5632 + bj * 2816 + gc0 + 4 * n);
                    const f32x4 bb = *(const f32x4*)(cb + bj * 2816 + gc0 + 4 * n);
                    f32x4 p[2];
                    p[0] = (f32x4){0.f, 0.f, 0.f, 0.f}; p[1] = (f32x4){0.f, 0.f, 0.f, 0.f};
                    if (fr == 0) {
                        if (wr == 1 || ai == 1) { const int swr = (wr == 1) ? 0 : 1, sai = (wr == 1) ? ai : 0;
#pragma unroll
                            for (int j = 0; j < 2; ++j) p[j] = *(const PG8_LAS f32x4*)(X + ((((swr * 2 + sai) * 4 + wc) * 2 + j) * 64) + fq * 16 + bj * 8 + n * 4);
                        } else if (!seqstart) {
#pragma unroll
                            for (int j = 0; j < 2; ++j) p[j] = *(const f32x4*)(yh + (size_t)(2 * u.pm + j) * 5632 + u.pn * BM + bj * HALF + wc * 32 + 8 * fq + 4 * n);
                        }
                    }
#pragma unroll
                    for (int j = 0; j < 2; ++j)
#pragma unroll
                        for (int i = 0; i < 4; ++i) p[j][i] = __int_as_float(__builtin_amdgcn_update_dpp(__float_as_int(p[j][i]), __float_as_int(acc[ai][bj][2 + j][n][i]), 0x111, 0xF, 0xF, false));
#pragma unroll
                    for (int m = 0; m < 4; ++m) {
                        const f32x4 y2 = m >= 2 ? acc[ai][bj][m - 2][n] : p[m], y1 = m >= 1 ? acc[ai][bj][m - 1][n] : p[1];
                        const f32x4 uu = bb + w3[0] * y2 + w3[1] * y1 + w3[2] * acc[ai][bj][m][n];
                        if (bj == 0) ug[m] = uu;
                        else { f16x4 o;
#pragma unroll
                            for (int i = 0; i < 4; ++i) o[i] = (_Float16)(ug[m][i] / (1.0f + __expf(-ug[m][i])) * uu[i]);
                            *(f16x4*)(act + (rowb + ai * HALF + m) * 2816 + gc0 + 4 * n) = o; }
                    }
                }
                asm volatile("" ::: "memory");
            }
    }
};
template <int AMAP> __host__ __device__ __forceinline__ int amap_row(int R) {
    if (AMAP == 1) return (R & 64) + 4 * (R & 15) + ((R >> 4) & 3);
    if (AMAP == 2) return 256 * (R >> 1) + (R & 1);
    return R;
}
template <class Epi, class Sched, bool ALIGN_EPI = false, bool SP2 = false, int AMAP = 0>
__device__ __forceinline__ void gemm_phase(PG8_LAS unsigned char* lds, const Gemm g, const Sched& S, const Epi& E) {
    const int tid = threadIdx.x, wid = __builtin_amdgcn_readfirstlane(tid >> 6), lane = tid & 63, wr = wid >> 2, wc = wid & 3, fr = lane & 15, fq = lane >> 4;
    const int K = g.K, nt = K / BK;
    unsigned voffA[2], voffB[2];
#pragma unroll
    for (int i = 0; i < 2; ++i) { int R, C; stage_rc(tid * 16 + i * 8192, R, C); const int Rb = Epi::PERM ? ((R & ~31) + perm32(R & 31)) : R;
        voffA[i] = (unsigned)(amap_row<AMAP>(R) * K + C) * 2u; voffB[i] = (unsigned)(Rb * K + C) * 2u; }
    const size_t kstep = (size_t)(BK * 2);
    const size_t hstep = (size_t)HALF * K * 2;
    const size_t hstepA = (AMAP == 2) ? (size_t)16384 * K * 2 : hstep;
    const size_t tstep = 2 * hstep;
    const unsigned ldsw = (unsigned)wid * 1024u;
    const int aoff = lds_byte(wr * 64 + fr, fq * 8), boff = lds_byte(wc * 32 + fr, fq * 8);
#define PG8_SA(b, h) (((b) * 2 + (h)) * HTB)
#define PG8_SB(b, h) ((4 + (b) * 2 + (h)) * HTB)
#define PG8_STAGE(bufoff, gbase, voff) do { _Pragma("unroll") for (int _i = 0; _i < 2; ++_i) \
        __builtin_amdgcn_global_load_lds((const unsigned*)((const char*)(gbase) + (voff)[_i]), (PG8_LAS unsigned*)(lds + (bufoff) + ldsw + _i * 8192), 16, 0, 0); } while (0)
#define PG8_LDA(dst, b, h) do { _Pragma("unroll") for (int m = 0; m < 4; ++m) _Pragma("unroll") for (int k = 0; k < 2; ++k) dst[m][k] = *(const PG8_LAS bf16x8*)(lds + PG8_SA(b, h) + aoff + m * 2048 + k * 1024); } while (0)
#define PG8_LDB(dst, b, h) do { _Pragma("unroll") for (int n = 0; n < 2; ++n) _Pragma("unroll") for (int k = 0; k < 2; ++k) dst[n][k] = *(const PG8_LAS bf16x8*)(lds + PG8_SB(b, h) + boff + n * 2048 + k * 1024); } while (0)
#define PG8_MMA(ai, bj, At, Bt) do { __builtin_amdgcn_s_setprio(1); _Pragma("unroll") for (int m = 0; m < 4; ++m) _Pragma("unroll") for (int n = 0; n < 2; ++n) _Pragma("unroll") for (int k = 0; k < 2; ++k) \
        acc[ai][bj][m][n] = __builtin_amdgcn_mfma_f32_16x16x32_f16(__builtin_bit_cast(f16x8, Bt[n][k]), __builtin_bit_cast(f16x8, At[m][k]), acc[ai][bj][m][n], 0, 0, 0); __builtin_amdgcn_s_setprio(0); } while (0)
#define PG8_WAIT_V(n) asm volatile("s_waitcnt vmcnt(" #n ")" ::: "memory")
#define PG8_WAIT_L(n) asm volatile("s_waitcnt lgkmcnt(" #n ")" ::: "memory")
#define PG8_BAR __builtin_amdgcn_s_barrier()
#define PG8_SCHED __builtin_amdgcn_sched_barrier(0)
    Unit cur, nxt; int ui = 0;
    if (!S.next(0, cur)) return;
    f32x4 acc[2][2][4][2];
#pragma unroll
    for (int a = 0; a < 2; ++a)
#pragma unroll
        for (int b = 0; b < 2; ++b)
#pragma unroll
            for (int m = 0; m < 4; ++m)
#pragma unroll
                for (int n = 0; n < 2; ++n) acc[a][b][m][n] = (f32x4){0.f, 0.f, 0.f, 0.f};
    bf16x8 At[4][2], B0[2][2], B1[2][2];
    const char* cA = (const char*)g.A + (size_t)cur.pm * tstep; const char* cB = (const char*)g.Bt + (size_t)cur.pn * tstep;
    S.a_ready(cur);
    if constexpr (SP2) {
        PG8_STAGE(PG8_SB(0, 0), cB, voffB); PG8_STAGE(PG8_SB(0, 1), cB + hstep, voffB); PG8_STAGE(PG8_SA(0, 0), cA, voffA); PG8_STAGE(PG8_SA(0, 1), cA + hstepA, voffA);
        if (wr == 1) PG8_BAR;
        PG8_WAIT_V(2); PG8_BAR;
        PG8_STAGE(PG8_SB(1, 0), cB + kstep, voffB); PG8_STAGE(PG8_SA(1, 0), cA + kstep, voffA); PG8_STAGE(PG8_SB(1, 1), cB + hstep + kstep, voffB);
        PG8_WAIT_V(6); PG8_BAR;
    } else {
        PG8_STAGE(PG8_SB(0, 0), cB, voffB); PG8_STAGE(PG8_SA(0, 0), cA, voffA); PG8_STAGE(PG8_SB(0, 1), cB + hstep, voffB); PG8_STAGE(PG8_SA(0, 1), cA + hstepA, voffA);
        if (wr == 1) PG8_BAR;
        PG8_WAIT_V(4); PG8_BAR;
        PG8_STAGE(PG8_SB(1, 0), cB + kstep, voffB); PG8_STAGE(PG8_SA(1, 0), cA + kstep, voffA); PG8_STAGE(PG8_SB(1, 1), cB + hstep + kstep, voffB);
        PG8_WAIT_V(6); PG8_BAR;
    }
    for (;;) {
        const bool has_next = S.next(ui + 1, nxt);
        const char* nA = has_next ? (const char*)g.A + (size_t)nxt.pm * tstep : cA; const char* nB = has_next ? (const char*)g.Bt + (size_t)nxt.pn * tstep : cB;
        for (int t = 0; t < nt; t += 2) {
            const bool last = (t == nt - 2);
            const char* a1 = cA + (size_t)(t + 1) * kstep;
            const char* a2 = last ? nA : cA + (size_t)(t + 2) * kstep; const char* b2 = last ? nB : cB + (size_t)(t + 2) * kstep;
            const char* a3 = a2 + kstep; const char* b3 = b2 + kstep;
            if (last && has_next) S.a_ready(nxt);
            if constexpr (SP2) {
            PG8_LDB(B0, 0, 0); PG8_LDB(B1, 0, 1); PG8_SCHED; PG8_LDA(At, 0, 0); PG8_STAGE(PG8_SA(1, 1), a1 + hstepA, voffA);
            PG8_WAIT_V(8); PG8_WAIT_L(0); PG8_BAR; PG8_MMA(0, 0, At, B0); PG8_MMA(0, 1, At, B1); PG8_BAR; PG8_SCHED;
            PG8_LDA(At, 0, 1); PG8_STAGE(PG8_SB(0, 0), b2, voffB); PG8_STAGE(PG8_SB(0, 1), b2 + hstep, voffB); PG8_STAGE(PG8_SA(0, 0), a2, voffA);
            PG8_WAIT_V(8); PG8_WAIT_L(0); PG8_BAR; PG8_MMA(1, 0, At, B0); PG8_MMA(1, 1, At, B1); PG8_BAR; PG8_SCHED;
            PG8_LDB(B0, 1, 0); PG8_LDB(B1, 1, 1); PG8_SCHED; PG8_LDA(At, 1, 0); PG8_STAGE(PG8_SA(0, 1), a2 + hstepA, voffA);
            PG8_WAIT_V(8); PG8_WAIT_L(0); PG8_BAR; PG8_MMA(0, 0, At, B0); PG8_MMA(0, 1, At, B1); PG8_BAR; PG8_SCHED;
            PG8_LDA(At, 1, 1); PG8_STAGE(PG8_SB(1, 0), b3, voffB); PG8_STAGE(PG8_SB(1, 1), b3 + hstep, voffB); PG8_STAGE(PG8_SA(1, 0), a3, voffA);
            PG8_WAIT_V(8); PG8_WAIT_L(0); PG8_BAR; PG8_MMA(1, 0, At, B0); PG8_MMA(1, 1, At, B1); PG8_BAR; PG8_SCHED;
            } else {
            PG8_LDB(B0, 0, 0); PG8_SCHED; PG8_LDA(At, 0, 0); PG8_STAGE(PG8_SA(1, 1), a1 + hstepA, voffA);
            PG8_WAIT_L(8); PG8_BAR; PG8_WAIT_L(0); PG8_MMA(0, 0, At, B0); PG8_BAR; PG8_SCHED;
            PG8_LDB(B1, 0, 1); PG8_STAGE(PG8_SB(0, 0), b2, voffB);
            PG8_BAR; PG8_WAIT_L(0); PG8_MMA(0, 1, At, B1); PG8_BAR;
            PG8_LDA(At, 0, 1); PG8_STAGE(PG8_SA(0, 0), a2, voffA);
            PG8_BAR; PG8_WAIT_L(0); PG8_MMA(1, 0, At, B0); PG8_BAR; PG8_SCHED;
            PG8_STAGE(PG8_SB(0, 1), b2 + hstep, voffB);
            PG8_WAIT_V(6); PG8_BAR; PG8_MMA(1, 1, At, B1); PG8_BAR;
            PG8_LDB(B0, 1, 0); PG8_SCHED; PG8_LDA(At, 1, 0); PG8_STAGE(PG8_SA(0, 1), a2 + hstepA, voffA);
            PG8_WAIT_L(8); PG8_BAR; PG8_WAIT_L(0); PG8_MMA(0, 0, At, B0); PG8_BAR; PG8_SCHED;
            PG8_LDB(B1, 1, 1); PG8_STAGE(PG8_SB(1, 0), b3, voffB);
            PG8_BAR; PG8_WAIT_L(0); PG8_MMA(0, 1, At, B1); PG8_BAR;
            PG8_LDA(At, 1, 1); PG8_STAGE(PG8_SA(1, 0), a3, voffA);
            PG8_BAR; PG8_WAIT_L(0); PG8_MMA(1, 0, At, B0); PG8_BAR; PG8_SCHED;
            PG8_STAGE(PG8_SB(1, 1), b3 + hstep, voffB);
            PG8_WAIT_V(6); PG8_BAR; PG8_MMA(1, 1, At, B1); PG8_BAR;
            }
        }
        if constexpr (ALIGN_EPI) { if (wr == 0) PG8_BAR; }
        if constexpr (!Epi::AFTER_DRAIN) { E(acc, cur, wr, wc, fr, fq); S.done(cur); }
        if (!has_next) break;
#pragma unroll
        for (int a = 0; a < 2; ++a)
#pragma unroll
            for (int b = 0; b < 2; ++b)
#pragma unroll
                for (int m = 0; m < 4; ++m)
#pragma unroll
                    for (int n = 0; n < 2; ++n) acc[a][b][m][n] = (f32x4){0.f, 0.f, 0.f, 0.f};
        cur = nxt; cA = nA; cB = nB; ++ui;
        if constexpr (ALIGN_EPI) { if (wr == 1) PG8_BAR; }
    }
    PG8_WAIT_V(0);
    if constexpr (!ALIGN_EPI) { if (wr == 0) PG8_BAR; }
    PG8_BAR;
    if constexpr (Epi::AFTER_DRAIN) { E.fused(acc, cur, wr, wc, fr, fq, lds, wid, lane); S.done(cur); }
#undef PG8_SA
#undef PG8_SB
#undef PG8_STAGE
#undef PG8_LDA
#undef PG8_LDB
#undef PG8_MMA
#undef PG8_WAIT_V
#undef PG8_WAIT_L
#undef PG8_BAR
#undef PG8_SCHED
}
}


#define XB_TMO      128
#define XB_XCNT(j)  (256  + 64 * (j))
#define XB_XSUB(j)  (1280 + 64 * (j))
#define XB_XGEN(j)  (2304 + 64 * (j))
#define XB_TOP      3328
#define XB_TOPGEN   3392
#define XCD_BAR_WORDS 3456
#define XB_SPIN_CAP (1u << 18)

__device__ __forceinline__ unsigned xb_ld(unsigned* p)              { return __hip_atomic_load(p, __ATOMIC_RELAXED, __HIP_MEMORY_SCOPE_AGENT); }
__device__ __forceinline__ unsigned xb_add(unsigned* p, unsigned v) { return __hip_atomic_fetch_add(p, v, __ATOMIC_RELAXED, __HIP_MEMORY_SCOPE_AGENT); }
__device__ __forceinline__ unsigned xb_xcc_id() { return (unsigned)__builtin_amdgcn_s_getreg((3 << 11) | 20) & 0xFu; }
#define XB_SPIN(cond, bar) do { unsigned _sp = 0; while (cond) { __builtin_amdgcn_s_sleep(1); \
    if ((++_sp & 255u) == 0u) { if (xb_ld(&(bar)[XB_TMO])) break; if (_sp > XB_SPIN_CAP) { atomicAdd(&(bar)[XB_TMO], 1u); break; } } } } while (0)

struct XcdBarrier {
    unsigned* bar; unsigned x;
    volatile LAS unsigned* st;
};

__device__ __forceinline__ XcdBarrier xcd_barrier_post(unsigned* bar, volatile LAS unsigned* st) {
    XcdBarrier b; b.bar = bar; b.x = xb_xcc_id(); b.st = st;
    if (threadIdx.x == 0) (void)xb_add(&bar[XB_XCNT(b.x)], 1u);
    return b;
}
__device__ __forceinline__ void xcd_barrier_complete(unsigned* bar, unsigned x, unsigned& nloc, unsigned& nx) {
    const unsigned G = gridDim.x * gridDim.y * gridDim.z;
    unsigned sum, cnt, mine, sp = 0u;
    for (;;) {
        sum = 0u; cnt = 0u; mine = 0u;
#pragma unroll
        for (unsigned j = 0; j < 16; ++j) { const unsigned c = xb_ld(&bar[XB_XCNT(j)]); sum += c; cnt += (c > 0u) ? 1u : 0u; mine = (j == x) ? c : mine; }
        if (sum == G) break;
        __builtin_amdgcn_s_sleep(1);
        if ((++sp & 255u) == 0u) { if (xb_ld(&bar[XB_TMO])) break; if (sp > XB_SPIN_CAP) { atomicAdd(&bar[XB_TMO], 1u); break; } }
    }
    nloc = mine > 0u ? mine : 1u; nx = cnt > 0u ? cnt : 1u;
}

__device__ __forceinline__ void xcd_barrier(const XcdBarrier& b) {
    asm volatile("s_waitcnt vmcnt(0)" ::: "memory");
    __syncthreads();
    if (threadIdx.x == 0) {
        unsigned* bar = b.bar;
        __builtin_amdgcn_s_waitcnt(0);
        unsigned nloc = b.st[0], nx = b.st[1];
        if (nloc == 0u) { xcd_barrier_complete(bar, b.x, nloc, nx); b.st[0] = nloc; b.st[1] = nx; }
        const unsigned old = xb_add(&bar[XB_XSUB(b.x)], 1u);
        const unsigned gen = old / nloc;
        if (old + 1u == (gen + 1u) * nloc) {
            __builtin_amdgcn_fence(__ATOMIC_RELEASE, "agent");
            asm volatile("s_waitcnt vmcnt(0)" ::: "memory");
            const unsigned og = xb_add(&bar[XB_TOP], 1u);
            const unsigned tg = og / nx;
            if (og + 1u == (tg + 1u) * nx) xb_add(&bar[XB_TOPGEN], 1u);
            else XB_SPIN(xb_ld(&bar[XB_TOPGEN]) == tg, bar);
            __builtin_amdgcn_fence(__ATOMIC_ACQUIRE, "agent");
            xb_add(&bar[XB_XGEN(b.x)], 1u);
            asm volatile("s_waitcnt vmcnt(0)" ::: "memory");
        } else {
            XB_SPIN(xb_ld(&bar[XB_XGEN(b.x)]) == gen, bar);
            __builtin_amdgcn_fence(__ATOMIC_ACQUIRE, "agent");
            asm volatile("s_waitcnt vmcnt(0)" ::: "memory");
        }
    }
    __syncthreads();
}

__device__ __forceinline__ void mlstm_naive(const Frame& F, LAS unsigned char* lds) {
    LAS float* qs = (LAS float*)lds; LAS float* ks = qs + 64; LAS float* part = ks + 64; LAS float* red = part + 512;
    const int tid = F.tid, e = tid & 127, qd = tid >> 7;
    for (int unit = blockIdx.x; unit < NB * 4; unit += gridDim.x) {
        const int b = unit >> 2, h = unit & 3;
        float C[16]; float n_d = 0.f, m = 0.f;
#pragma unroll
        for (int i = 0; i < 16; ++i) C[i] = 0.f;
        const float ib = F.i_bias[h], fb = F.f_bias[h];
        for (int t = 0; t < S; ++t) {
            const size_t row = (size_t)b * S + t;
            if (tid < 128) {
                const int cc = (tid < 64) ? (h * 64 + tid) : (256 + h * 64 + (tid - 64));
                float a = F.conv_b[cc];
#pragma unroll
                for (int j = 0; j < 4; ++j) { const int tt = t - 3 + j; if (tt >= 0) a += F.conv_w[j * 512 + cc] * (float)F.Z[(row - 3 + j) * ZP + cc]; }
                float v = a * sigmoidf_(a);
                if (tid < 64) qs[tid] = v * 0.125f; else ks[tid - 64] = v;
            }
            const float ig = F.GATES[row * 16 + h] + ib, fp = F.GATES[row * 16 + 4 + h] + fb;
            const float logf = fminf(fp, 0.f) - log1pf(__expf(-fabsf(fp)));
            const float m_new = fmaxf(logf + m, ig), fs = __expf(logf + m - m_new), is = __expf(ig - m_new); m = m_new;
            __syncthreads();
            const float ve = (float)F.Z[row * ZP + ZC_MV + h * 128 + e];
            float pn = 0.f;
#pragma unroll
            for (int i = 0; i < 16; ++i) { const int d = qd * 16 + i; C[i] = fs * C[i] + is * ks[d] * ve; pn += qs[d] * C[i]; }
            part[qd * 128 + e] = pn;
            if (tid < 64) { n_d = fs * n_d + is * ks[tid]; const float dn = wave_sum(qs[tid] * n_d); if (tid == 0) red[0] = dn; }
            __syncthreads();
            float hv = 0.f;
            if (tid < 128) {
                const float num = (part[e] + part[128 + e]) + (part[256 + e] + part[384 + e]), den = red[0];
                hv = num / fmaxf(fabsf(den), __expf(-m));
                const float sq = wave_sum(hv * hv); if (F.lane == 0) red[1 + F.wave] = sq;
            }
            __syncthreads();
            if (tid < 128) {
                const float r = 1.f / sqrtf((red[1] + red[2]) * (1.f / 128.f) + EPS);
                const float og = (float)F.Z[row * ZP + ZC_MO + h * 128 + e];
                F.MIX[row * D + h * 128 + e] = (h16)(hv * r * F.mlstm_norm[h * 128 + e] * sigmoidf_(og));
            }
        }
        __syncthreads();
    }
}

constexpr int LQ = 72;
constexpr int LW = 136;
typedef _Float16 h16x4 __attribute__((ext_vector_type(4)));

__device__ __forceinline__ void conv_silu8(const Frame& F, size_t row, int t, int cb, float (&o)[8]) {
#pragma unroll
    for (int i = 0; i < 8; ++i) o[i] = F.conv_b[cb + i];
#pragma unroll
    for (int j = 0; j < 4; ++j) {
        if (t - 3 + j >= 0) {
            const h16x8 z = *(const h16x8*)(F.Z + (row - 3 + j) * ZP + cb);
#pragma unroll
            for (int i = 0; i < 8; ++i) o[i] += F.conv_w[j * 512 + cb + i] * (float)z[i];
        }
    }
#pragma unroll
    for (int i = 0; i < 8; ++i) o[i] = o[i] * sigmoidf_(o[i]);
}
__device__ __forceinline__ float wave_scan_add(float x, int lane) {
#pragma unroll
    for (int o = 1; o < 64; o <<= 1) { const float v = __shfl_up(x, o); if (lane >= o) x += v; }
    return x;
}
__device__ __forceinline__ float wave_scan_max(float x, int lane) {
#pragma unroll
    for (int o = 1; o < 64; o <<= 1) { const float v = __shfl_up(x, o); if (lane >= o) x = fmaxf(x, v); }
    return x;
}

__device__ __forceinline__ void mlstm_A(const Frame& F, LAS unsigned char* lds) {
    LAS h16* KT = (LAS h16*)lds;
    LAS h16* VT = KT + 64 * LQ;
    LAS float* wg = (LAS float*)(VT + 128 * LQ);
    const int tid = F.tid, lane = F.lane, w = F.wave, fr = lane & 15, fq = lane >> 4;
    for (int u = blockIdx.x; u < NB * 4 * 64; u += gridDim.x) {
        const int c = u & 63, h = (u >> 6) & 3, b = u >> 8; const size_t row0 = (size_t)b * S + c * 64;
        if (w == 0) {
            const float ig = F.GATES[(row0 + lane) * 16 + h] + F.i_bias[h], fp = F.GATES[(row0 + lane) * 16 + 4 + h] + F.f_bias[h];
            const float logf = fminf(fp, 0.f) - log1pf(__expf(-fabsf(fp)));
            const float bl = wave_scan_add(logf, lane), g = __shfl(bl, 63);
            const float a = g - bl + ig, ml = wave_max(a);
            wg[lane] = __expf(a - ml);
            if (lane == 0) { F.G[u] = g; F.MLOC[u] = ml; }
        }
        __syncthreads();
        { const int l = tid >> 3, c8 = (tid & 7) * 8; float o[8]; conv_silu8(F, row0 + l, c * 64 + l, ZC_MK + h * 64 + c8, o);
#pragma unroll
          for (int i = 0; i < 8; ++i) KT[(c8 + i) * LQ + l] = (h16)o[i]; }
#pragma unroll
        for (int j = 0; j < 2; ++j) { const int id = tid + 512 * j, l = id >> 4, e8 = (id & 15) * 8; const float wl = wg[l];
            const h16x8 v = *(const h16x8*)(F.Z + (row0 + l) * ZP + ZC_MV + h * 128 + e8);
#pragma unroll
            for (int i = 0; i < 8; ++i) VT[(e8 + i) * LQ + l] = (h16)((float)v[i] * wl); }
        __syncthreads();
        f32x4 acc[4];
#pragma unroll
        for (int db = 0; db < 4; ++db) acc[db] = (f32x4){0.f, 0.f, 0.f, 0.f};
#pragma unroll
        for (int ks = 0; ks < 2; ++ks) {
            const h16x8 a = *(const LAS h16x8*)(VT + (16 * w + fr) * LQ + 32 * ks + 8 * fq);
#pragma unroll
            for (int db = 0; db < 4; ++db) { const h16x8 bb = *(const LAS h16x8*)(KT + (16 * db + fr) * LQ + 32 * ks + 8 * fq);
                acc[db] = __builtin_amdgcn_mfma_f32_16x16x32_f16(a, bb, acc[db], 0, 0, 0); }
        }
        float* kvt = F.KVT + (size_t)u * 8192;
#pragma unroll
        for (int db = 0; db < 4; ++db)
#pragma unroll
            for (int i = 0; i < 4; ++i) kvt[(16 * w + 4 * fq + i) * 64 + 16 * db + fr] = acc[db][i];
        if (tid < 64) { float s = 0.f; for (int l = 0; l < 64; ++l) s += wg[l] * (float)KT[tid * LQ + l]; F.KS[(size_t)u * 64 + tid] = s; }
        __syncthreads();
    }
}

__device__ __forceinline__ void mlstm_B(const Frame& F) {
    typedef float f32x2 __attribute__((ext_vector_type(2)));
    const int tid = F.tid;
    for (int slot = blockIdx.x; slot < 256; slot += gridDim.x) {
        const int bh = slot >> 3, part = slot & 7; const int idx = part * 1024 + tid * 2;
        float* base = F.KVT + (size_t)bh * 64 * 8192 + idx;
        const bool do_n = (part == 0 && tid < 64);
        f32x2 st = (f32x2){0.f, 0.f}; float nst = 0.f, m = 0.f;
        for (int c0 = 0; c0 < 64; c0 += 8) {
            f32x2 kv[8]; float ksv[8];
#pragma unroll
            for (int j = 0; j < 8; ++j) { kv[j] = *(const f32x2*)(base + (size_t)(c0 + j) * 8192); ksv[j] = do_n ? F.KS[(size_t)(bh * 64 + c0 + j) * 64 + tid] : 0.f; }
#pragma unroll
            for (int j = 0; j < 8; ++j) {
                const int u = bh * 64 + c0 + j; const float g = F.G[u], ml = F.MLOC[u];
                *(f32x2*)(base + (size_t)(c0 + j) * 8192) = st;
                if (do_n) F.KS[(size_t)u * 64 + tid] = nst;
                if (part == 0 && tid == 0) F.MPREV[u] = m;
                const float mn = fmaxf(g + m, ml), dec = __expf(g + m - mn), sc = __expf(ml - mn);
                st = dec * st + sc * kv[j]; nst = dec * nst + sc * ksv[j]; m = mn;
            }
        }
    }
}

__device__ __forceinline__ void mlstm_C(const Frame& F, LAS unsigned char* lds) {
    LAS h16* Qs = (LAS h16*)lds;
    LAS h16* Ks = Qs + 64 * LQ;
    LAS h16* QS = Ks + 64 * LQ;
    LAS h16* BT = QS + 64 * LW;
    LAS float* fa = (LAS float*)(BT + 128 * LW);
    LAS float *ul = fa, *wl = fa + 64, *iw = fa + 128, *emt = fa + 192, *den = fa + 256, *nb = fa + 320, *rowsq = fa + 384;
    const int tid = F.tid, lane = F.lane, w = F.wave, fr = lane & 15, fq = lane >> 4;
    for (int u = blockIdx.x; u < NB * 4 * 64; u += gridDim.x) {
        const int c = u & 63, h = (u >> 6) & 3, b = u >> 8; const size_t row0 = (size_t)b * S + c * 64;
        if (w == 0) {
            const float ig = F.GATES[(row0 + lane) * 16 + h] + F.i_bias[h], fp = F.GATES[(row0 + lane) * 16 + 4 + h] + F.f_bias[h];
            const float logf = fminf(fp, 0.f) - log1pf(__expf(-fabsf(fp)));
            const float bl = wave_scan_add(logf, lane), ww = ig - bl, pm = wave_scan_max(ww, lane);
            const float il = bl + F.MPREV[u], mt = fmaxf(il, bl + pm);
            ul[lane] = bl - mt; wl[lane] = ww; iw[lane] = __expf(il - mt); emt[lane] = __expf(-mt);
        }
        if (tid < 64) nb[tid] = F.KS[(size_t)u * 64 + tid];
        { const int l = tid >> 3, c8 = (tid & 7) * 8; float o[8];
          conv_silu8(F, row0 + l, c * 64 + l, ZC_MQ + h * 64 + c8, o);
          h16x8 hv;
#pragma unroll
          for (int i = 0; i < 8; ++i) hv[i] = (h16)(o[i] * 0.125f);
          *(LAS h16x8*)(Qs + l * LQ + c8) = hv;
          conv_silu8(F, row0 + l, c * 64 + l, ZC_MK + h * 64 + c8, o);
#pragma unroll
          for (int i = 0; i < 8; ++i) hv[i] = (h16)o[i];
          *(LAS h16x8*)(Ks + l * LQ + c8) = hv; }
#pragma unroll
        for (int j = 0; j < 2; ++j) { const int id = tid + 512 * j;
            { const int l = id >> 4, e8 = (id & 15) * 8; const h16x8 v = *(const h16x8*)(F.Z + (row0 + l) * ZP + ZC_MV + h * 128 + e8);
#pragma unroll
              for (int i = 0; i < 8; ++i) BT[(e8 + i) * LW + 64 + l] = v[i]; }
            { const int e = id >> 3, d8 = (id & 7) * 8; const float* cp = F.KVT + (size_t)u * 8192 + e * 64 + d8; const f32x4 c0 = *(const f32x4*)cp, c1 = *(const f32x4*)(cp + 4);
              h16x8 hv; hv[0] = (h16)c0[0]; hv[1] = (h16)c0[1]; hv[2] = (h16)c0[2]; hv[3] = (h16)c0[3]; hv[4] = (h16)c1[0]; hv[5] = (h16)c1[1]; hv[6] = (h16)c1[2]; hv[7] = (h16)c1[3];
              *(LAS h16x8*)(BT + e * LW + d8) = hv; } }
        __syncthreads();
        { const int l = tid >> 3, c8 = (tid & 7) * 8; const h16x8 q = *(const LAS h16x8*)(Qs + l * LQ + c8); const float s = iw[l]; h16x8 hv;
#pragma unroll
          for (int i = 0; i < 8; ++i) hv[i] = (h16)((float)q[i] * s);
          *(LAS h16x8*)(QS + l * LW + c8) = hv; }
#pragma unroll
        for (int tt = 0; tt < 2; ++tt) {
            const int lb = w & 3, sb = 2 * (w >> 2) + tt;
            f32x4 acc = (f32x4){0.f, 0.f, 0.f, 0.f};
            if (sb <= lb) {
#pragma unroll
                for (int ks = 0; ks < 2; ++ks) { const h16x8 a = *(const LAS h16x8*)(Qs + (16 * lb + fr) * LQ + 32 * ks + 8 * fq), bb = *(const LAS h16x8*)(Ks + (16 * sb + fr) * LQ + 32 * ks + 8 * fq);
                    acc = __builtin_amdgcn_mfma_f32_16x16x32_f16(a, bb, acc, 0, 0, 0); }
            }
            const int s = 16 * sb + fr; const float ws = wl[s];
#pragma unroll
            for (int i = 0; i < 4; ++i) { const int l = 16 * lb + 4 * fq + i; const float v = (s <= l) ? acc[i] * __expf(ul[l] + ws) : 0.f; QS[l * LW + 64 + s] = (h16)v; }
        }
        __syncthreads();
        { const int l = tid >> 3, part = tid & 7; float s = 0.f;
#pragma unroll
          for (int j = 0; j < 2; ++j) { const h16x8 q = *(const LAS h16x8*)(QS + l * LW + 16 * part + 8 * j);
#pragma unroll
              for (int i = 0; i < 8; ++i) { const int k = 16 * part + 8 * j + i; s += (float)q[i] * (k < 64 ? nb[k] : 1.f); } }
          s += __shfl_xor(s, 1); s += __shfl_xor(s, 2); s += __shfl_xor(s, 4);
          if (part == 0) den[l] = s; }
        f32x4 acc[4];
#pragma unroll
        for (int lb = 0; lb < 4; ++lb) acc[lb] = (f32x4){0.f, 0.f, 0.f, 0.f};
#pragma unroll
        for (int ks = 0; ks < 4; ++ks) { const h16x8 bb = *(const LAS h16x8*)(BT + (16 * w + fr) * LW + 32 * ks + 8 * fq);
#pragma unroll
            for (int lb = 0; lb < 4; ++lb) { const h16x8 a = *(const LAS h16x8*)(QS + (16 * lb + fr) * LW + 32 * ks + 8 * fq);
                acc[lb] = __builtin_amdgcn_mfma_f32_16x16x32_f16(a, bb, acc[lb], 0, 0, 0); } }
        __syncthreads();
#pragma unroll
        for (int lb = 0; lb < 4; ++lb)
#pragma unroll
            for (int i = 0; i < 4; ++i) { const int l = 16 * lb + 4 * fq + i; const float hv = acc[lb][i] / fmaxf(fabsf(den[l]), emt[l]); acc[lb][i] = hv;
                float sq = hv * hv; sq += __shfl_xor(sq, 1); sq += __shfl_xor(sq, 2); sq += __shfl_xor(sq, 4); sq += __shfl_xor(sq, 8);
                if (fr == 0) rowsq[w * 64 + l] = sq; }
        __syncthreads();
        const int e = 16 * w + fr; const float gn = F.mlstm_norm[h * 128 + e];
#pragma unroll
        for (int lb = 0; lb < 4; ++lb)
#pragma unroll
            for (int i = 0; i < 4; ++i) { const int l = 16 * lb + 4 * fq + i; float tot = 0.f;
#pragma unroll
                for (int ww = 0; ww < 8; ++ww) tot += rowsq[ww * 64 + l];
                const float r = 1.f / sqrtf(tot * (1.f / 128.f) + EPS);
                const float og = (float)F.Z[(row0 + l) * ZP + ZC_MO + h * 128 + e];
                F.MIX[(row0 + l) * D + h * 128 + e] = (h16)(acc[lb][i] * r * gn * sigmoidf_(og)); }
        __syncthreads();
    }
}

__device__ __forceinline__ void kn_phase(const Frame& F) {
    const int gw = blockIdx.x * 8 + F.wave, NGW = gridDim.x * 8;
    const float g = F.idx_k_norm[F.lane];
    for (int m = gw; m < T; m += NGW) {
        const float v = (float)F.Z[(size_t)m * ZP + ZC_IK + F.lane];
        const float r = 1.f / sqrtf(wave_sum(v * v) * (1.f / 64.f) + EPS);
        F.KN[(size_t)m * 64 + F.lane] = (h16)(v * r * g);
    }
}

__device__ __forceinline__ unsigned ord_key(float f) { const unsigned u = __float_as_uint(f); return (u & 0x80000000u) ? ~u : (u | 0x80000000u); }

__device__ __forceinline__ void index_naive(const Frame& F, LAS unsigned char* lds) {
    LAS float* qf = (LAS float*)lds;
    LAS float* wq = qf + 512;
    LAS unsigned* cnt = (LAS unsigned*)(wq + 8);
    LAS unsigned* keys = cnt + 40;
    const int tid = F.tid;
    for (int row = blockIdx.x; row < T; row += gridDim.x) {
        const int t = row & (S - 1), b = row >> 12;
        __syncthreads();
        qf[tid] = (float)F.Z[(size_t)row * ZP + ZC_IQ + tid];
        if (tid < 8) wq[tid] = F.GATES[(size_t)row * 16 + 8 + tid] * 0.35355339059327373f;
        if (tid < 40) cnt[tid] = 0u;
        __syncthreads();
        unsigned kk[8];
#pragma unroll
        for (int j = 0; j < 8; ++j) {
            const int s = tid + 512 * j; kk[j] = 0u;
            if (s <= t) {
                const h16* kr = F.KN + ((size_t)b * S + s) * 64;
                float kf[64];
#pragma unroll
                for (int c = 0; c < 8; ++c) { const h16x8 v = *(const h16x8*)(kr + 8 * c);
#pragma unroll
                    for (int i = 0; i < 8; ++i) kf[8 * c + i] = (float)v[i]; }
                float score = 0.f;
#pragma unroll
                for (int hh = 0; hh < 8; ++hh) { float dot = 0.f;
#pragma unroll
                    for (int d = 0; d < 64; ++d) dot += qf[hh * 64 + d] * kf[d];
                    score += fmaxf(dot * 0.125f, 0.f) * wq[hh]; }
                kk[j] = ord_key(score); keys[s] = kk[j];
            }
        }
        unsigned vstar = 0u;
        if (t >= TOPK) {
            unsigned prefix = 0u;
            for (int bit = 31; bit >= 0; --bit) {
                const unsigned cand = prefix | (1u << bit); int c = 0;
#pragma unroll
                for (int j = 0; j < 8; ++j) c += (kk[j] >= cand) ? 1 : 0;
                c = wave_isum(c); if (F.lane == 0) atomicAdd((unsigned*)&cnt[bit], (unsigned)c);
                __syncthreads();
                if (cnt[bit] >= (unsigned)TOPK) prefix = cand;
            }
            vstar = prefix;
            int cg = 0, ce = 0;
#pragma unroll
            for (int j = 0; j < 8; ++j) { cg += (kk[j] > vstar) ? 1 : 0; ce += (kk[j] == vstar) ? 1 : 0; }
            cg = wave_isum(cg); ce = wave_isum(ce);
            if (F.lane == 0) { atomicAdd((unsigned*)&cnt[32], (unsigned)cg); atomicAdd((unsigned*)&cnt[33], (unsigned)ce); }
            __syncthreads();
            const int need = TOPK - (int)cnt[32];
            if ((int)cnt[33] > need) {
                if (tid == 0) { int nd = need; for (int s = 0; s <= t; ++s) if (keys[s] == vstar) { if (nd > 0) --nd; else keys[s] = 0u; } }
            }
        }
        __syncthreads();
        if (tid < 128) {
            unsigned word = 0u;
            for (int i = 0; i < 32; ++i) { const int s = 32 * tid + i; if (s <= t && keys[s] >= vstar) word |= (1u << i); }
            F.BM[(size_t)row * 128 + tid] = word;
        }
    }
}

typedef float f32x16 __attribute__((ext_vector_type(16)));
__device__ __forceinline__ size_t bm_index(int b, int t, int kt) { return ((((size_t)(b * 128 + (t >> 5)) * 64 + kt) * 32) + (t & 31)) * 2; }

__device__ __forceinline__ int wave_scan_dpp(int v, int& tot) {
    v += __builtin_amdgcn_update_dpp(0, v, 0x111, 0xF, 0xF, false);
    v += __builtin_amdgcn_update_dpp(0, v, 0x112, 0xF, 0xF, false);
    v += __builtin_amdgcn_update_dpp(0, v, 0x114, 0xF, 0xF, false);
    v += __builtin_amdgcn_update_dpp(0, v, 0x118, 0xF, 0xF, false);
    v += __builtin_amdgcn_update_dpp(0, v, 0x142, 0xA, 0xF, false);
    v += __builtin_amdgcn_update_dpp(0, v, 0x143, 0xC, 0xF, false);
    tot = __builtin_amdgcn_readlane(v, 63);
    return v;
}
template <int NR> __device__ __forceinline__ unsigned kth_largest_pl(const unsigned (&r)[NR], int K, int lowbit) {
    unsigned prefix = 0u;
    for (int bit = 31; bit >= lowbit; --bit) {
        const unsigned cand = prefix | (1u << bit); int c = 0;
#pragma unroll
        for (int j = 0; j < NR; ++j) c += (r[j] >= cand) ? 1 : 0;
        int tot; (void)wave_scan_dpp(c, tot);
        if (tot >= K) prefix = cand;
    }
    return prefix;
}
__device__ __forceinline__ int count_ge_row(const LAS unsigned* kr, int nj, int lane, unsigned thr) {
    int c = 0;
#pragma unroll 8
    for (int j = 0; j < nj; ++j) c += (kr[64 * j + lane] >= thr) ? 1 : 0;
    return c;
}
constexpr int IDX_CAND_OFF = 131072 + 1024, IDX_CAND = 768;
template <int MODE> __device__ __forceinline__ void index_mfma(const Frame& F, LAS unsigned char* lds) {
    LAS unsigned* keys = (LAS unsigned*)lds;
    const int lane = F.lane, w = F.wave, c32 = lane & 31, hi = lane >> 5;
    const int qa = 2 * ((c32 >> 2) & 1) + ((((c32 & 3) + 4 * (c32 >> 3))) >> 3), ha = ((c32 & 3) + 4 * (c32 >> 3)) & 7;
    for (int unit = blockIdx.x; unit < NB * 512; unit += gridDim.x) {
        const int b = unit & 7, qg = unit >> 3, t0 = 8 * qg; const size_t rowbase = (size_t)b * S;
        const int ntile = (t0 + 7) / 32 + 1, L = 32 * ntile;
        h16x8 a[2][4]; float wv[2][16];
#pragma unroll
        for (int blk = 0; blk < 2; ++blk) {
#pragma unroll
            for (int ks = 0; ks < 4; ++ks) a[blk][ks] = *(const h16x8*)(F.Z + (rowbase + t0 + 4 * blk + qa) * ZP + ZC_IQ + ha * 64 + 16 * ks + 8 * hi);
#pragma unroll
            for (int qq = 0; qq < 2; ++qq) { const float* gp = F.GATES + (rowbase + t0 + 4 * blk + 2 * hi + qq) * 16 + 8; const f32x4 g0 = *(const f32x4*)gp, g1 = *(const f32x4*)(gp + 4);
#pragma unroll
                for (int i = 0; i < 4; ++i) { wv[blk][qq * 8 + i] = g0[i] * (0.125f * 0.35355339059327373f); wv[blk][qq * 8 + 4 + i] = g1[i] * (0.125f * 0.35355339059327373f); } }
        }
#ifndef PROBE_X
#define PROBE_X 0
#endif
        for (int rx1 = 0; rx1 < (PROBE_X == 1 ? 2 : 1); ++rx1)
        if (MODE != 2) {
            const h16* kp0 = F.KN + (rowbase + c32) * 64 + 8 * hi;
            for (int tb = w; tb < ntile; tb += 32) {
                h16x8 bf[4][4];
#pragma unroll
                for (int k4 = 0; k4 < 4; ++k4) {
                    if (tb + 8 * k4 < ntile) {
#pragma unroll
                        for (int ks = 0; ks < 4; ++ks) bf[k4][ks] = *(const h16x8*)(kp0 + (size_t)(tb + 8 * k4) * 2048 + 16 * ks);
                    } else {
#pragma unroll
                        for (int ks = 0; ks < 4; ++ks) bf[k4][ks] = a[0][ks];
                    }
                }
#pragma unroll
                for (int k4 = 0; k4 < 4; ++k4) {
                    const int tile = tb + 8 * k4;
                    if (tile < ntile) {
                        const int s = 32 * tile + c32;
#pragma unroll
                        for (int blk = 0; blk < 2; ++blk) {
                            f32x16 acc;
#pragma unroll
                            for (int i = 0; i < 16; ++i) acc[i] = 0.f;
#pragma unroll
                            for (int ks = 0; ks < 4; ++ks) acc = __builtin_amdgcn_mfma_f32_32x32x16_f16(a[blk][ks], bf[k4][ks], acc, 0, 0, 0);
#pragma unroll
                            for (int qq = 0; qq < 2; ++qq) { float sc = 0.f;
#pragma unroll
                                for (int hh = 0; hh < 8; ++hh) sc += __builtin_amdgcn_fmed3f(acc[qq * 8 + hh], 0.f, __builtin_inff()) * wv[blk][qq * 8 + hh];
                                const int ql = 4 * blk + 2 * hi + qq;
                                keys[ql * 4096 + s] = (s <= t0 + ql) ? ord_key(sc) : 0u; }
                        }
                    }
                }
            }
        }
        __syncthreads();
        if (MODE != 1) {
            const int t = t0 + w, nj = (L + 63) >> 6; LAS unsigned* kr = keys + w * 4096; LAS unsigned* cd = (LAS unsigned*)(lds + IDX_CAND_OFF) + w * IDX_CAND;
            if ((L & 32) && lane >= 32) kr[64 * (nj - 1) + lane] = 0u;
            __builtin_amdgcn_wave_barrier();
            unsigned vstar = 0u, thr = 1u; bool trim = false; int allowed = 0;
            if (t >= TOPK) {
                int cgt = 0, ceq = 0;
                if (nj <= 8) {
                    unsigned r8[8];
#pragma unroll
                    for (int i = 0; i < 8; ++i) r8[i] = (i < nj) ? kr[64 * i + lane] : 0u;
                    vstar = kth_largest_pl<8>(r8, TOPK, 0);
#pragma unroll
                    for (int i = 0; i < 8; ++i) { cgt += (r8[i] > vstar) ? 1 : 0; ceq += (r8[i] == vstar) ? 1 : 0; }
                } else {
                    unsigned sm[4];
#pragma unroll
                    for (int i = 0; i < 4; ++i) sm[i] = kr[64 * ((i * nj) >> 2) + lane];
                    const float E = 1024.f / (float)nj; const int m = (int)(E + 3.5f * sqrtf(E)) + 2;
                    unsigned tau = kth_largest_pl<4>(sm, m, 16);
                    int c = count_ge_row(kr, nj, lane, tau), tot; int incl = wave_scan_dpp(c, tot);
                    if (tot < TOPK) { tau = 0u; c = nj; tot = 64 * nj; incl = nj * (lane + 1); }
                    if (tot > IDX_CAND) {
                        const unsigned tau0 = tau; unsigned pre = 0u;
                        for (int bit = 31; bit >= 0; --bit) {
                            const unsigned cand = pre | (1u << bit);
                            if (cand <= tau0) { pre = cand; continue; }
                            const int c2 = count_ge_row(kr, nj, lane, cand); int tot2; const int incl2 = wave_scan_dpp(c2, tot2);
                            if (tot2 >= TOPK) { pre = cand; c = c2; tot = tot2; incl = incl2; if (tot <= IDX_CAND) break; }
                        }
                        tau = pre;
                    }
                    if (tot <= IDX_CAND) {
                        int pos = incl - c;
#pragma unroll 8
                        for (int j = 0; j < nj; ++j) { const unsigned k = kr[64 * j + lane]; if (k >= tau) { cd[pos] = k; ++pos; } }
                        __builtin_amdgcn_wave_barrier();
                        unsigned cc[12];
#pragma unroll
                        for (int i = 0; i < 12; ++i) { const int s = 64 * i + lane; cc[i] = (s < tot) ? cd[s] : 0u; }
                        vstar = kth_largest_pl<12>(cc, TOPK, 0);
#pragma unroll
                        for (int i = 0; i < 12; ++i) { cgt += (cc[i] > vstar) ? 1 : 0; ceq += (cc[i] == vstar) ? 1 : 0; }
                    } else {
                        vstar = tau;
                        for (int j = 0; j < nj; ++j) { const unsigned k = kr[64 * j + lane]; cgt += (k > vstar) ? 1 : 0; ceq += (k == vstar) ? 1 : 0; }
                    }
                }
                int cgt_t, ceq_t; (void)wave_scan_dpp(cgt, cgt_t); (void)wave_scan_dpp(ceq, ceq_t);
                allowed = TOPK - cgt_t; trim = ceq_t > allowed; thr = vstar;
            }
            typedef unsigned u32x2 __attribute__((ext_vector_type(2)));
            if (!trim) {
                int j = 0;
                for (; j + 4 <= nj; j += 4) {
                    const unsigned k0 = kr[64 * j + lane], k1 = kr[64 * j + 64 + lane], k2 = kr[64 * j + 128 + lane], k3 = kr[64 * j + 192 + lane];
                    const unsigned long long m0 = __ballot(k0 >= thr), m1 = __ballot(k1 >= thr), m2 = __ballot(k2 >= thr), m3 = __ballot(k3 >= thr);
                    if (lane < 4) { const unsigned long long mm = lane == 0 ? m0 : lane == 1 ? m1 : lane == 2 ? m2 : m3;
                        *(u32x2*)(F.BM + bm_index(b, t, j + lane)) = (u32x2){(unsigned)mm, (unsigned)(mm >> 32)}; }
                }
                for (; j < nj; ++j) {
                    const unsigned k = kr[64 * j + lane]; const unsigned long long m = __ballot(k >= thr);
                    if (lane == 0) *(u32x2*)(F.BM + bm_index(b, t, j)) = (u32x2){(unsigned)m, (unsigned)(m >> 32)};
                }
            } else {
                for (int j = 0; j < nj; ++j) {
                    const unsigned k = kr[64 * j + lane];
                    const unsigned long long gt = __ballot(k > vstar); unsigned long long eq = __ballot(k == vstar);
                    if (allowed <= 0) eq = 0ull;
                    else { while (__popcll(eq) > allowed) eq &= ~(1ull << (63 - __clzll(eq))); allowed -= __popcll(eq); }
                    const unsigned long long m = gt | eq;
                    if (lane == 0) *(u32x2*)(F.BM + bm_index(b, t, j)) = (u32x2){(unsigned)m, (unsigned)(m >> 32)};
                }
            }
            if (nj + lane < 64) *(u32x2*)(F.BM + bm_index(b, t, nj + lane)) = (u32x2){0u, 0u};
        }
        __syncthreads();
    }
}

__device__ __forceinline__ void attn_naive(const Frame& F, LAS unsigned char* lds) {
    LAS float* qf = (LAS float*)lds;
    LAS float* p = qf + 512;
    LAS int* sel = (LAS int*)(p + 2048);
    LAS int* pcs = sel + 288;
    LAS float* btab = (LAS float*)(pcs + 128);
    LAS int* nselp = (LAS int*)(btab + 1024);
    const int tid = F.tid, hh = F.wave, lane = F.lane;
    for (int i = tid; i < 1024; i += NTHR) {
        const int dist = i >> 3, h = i & 7; int bk;
        if (dist < 16) bk = dist; else { bk = 16 + (int)(log((double)dist / 16.0) / log(8.0) * 16.0); if (bk > 31) bk = 31; }
        btab[i] = F.rel_bias[bk * 8 + h];
    }
    for (int row = blockIdx.x; row < T; row += gridDim.x) {
        const int t = row & (S - 1), b = row >> 12;
        __syncthreads();
        unsigned word = 0u;
        if (tid < 128) { word = F.BM[bm_index(b, t, tid >> 1) + (tid & 1)]; pcs[tid] = __popc(word); }
        qf[tid] = (float)F.Z[(size_t)row * ZP + ZC_AQ + tid];
        __syncthreads();
        if (tid < 128) {
            int off = 0; for (int i = 0; i < tid; ++i) off += pcs[i];
            if (tid == 127) *nselp = off + pcs[127];
            while (word) { const int bpos = __ffs(word) - 1; word &= word - 1; if (off < 288) sel[off] = 32 * tid + bpos; ++off; }
        }
        __syncthreads();
        const int nsel = min(*nselp, 256);
        float lg[4]; float mx = -INFINITY;
#pragma unroll
        for (int jj = 0; jj < 4; ++jj) {
            const int j = lane + 64 * jj; lg[jj] = -INFINITY;
            if (j < nsel) {
                const int s = sel[j]; const h16* kr = F.Z + ((size_t)b * S + s) * ZP + ZC_AK + hh * 64;
                float dot = 0.f;
#pragma unroll
                for (int c = 0; c < 8; ++c) { const h16x8 v = *(const h16x8*)(kr + 8 * c);
#pragma unroll
                    for (int i = 0; i < 8; ++i) dot += qf[hh * 64 + 8 * c + i] * (float)v[i]; }
                const int dist = t - s;
                lg[jj] = dot * 0.125f + btab[(dist < 127 ? dist : 127) * 8 + hh];
                mx = fmaxf(mx, lg[jj]);
            }
        }
        mx = wave_max(mx);
        float sum = 0.f;
#pragma unroll
        for (int jj = 0; jj < 4; ++jj) { const int j = lane + 64 * jj; const float ev = (j < nsel) ? __expf(lg[jj] - mx) : 0.f; sum += ev; p[hh * 256 + j] = ev; }
        sum = wave_sum(sum);
        __syncthreads();
        float acc = 0.f;
        for (int j = 0; j < nsel; ++j) acc += p[hh * 256 + j] * (float)F.Z[((size_t)b * S + sel[j]) * ZP + ZC_AV + hh * 64 + lane];
        F.MIX[(size_t)row * D + 512 + hh * 64 + lane] = (h16)(acc / sum);
    }
}

typedef short v4i16_t __attribute__((ext_vector_type(4)));
__device__ __forceinline__ h16x4 vtr16(const LAS unsigned char* p) { return __builtin_bit_cast(h16x4, __builtin_amdgcn_ds_read_tr16_b64_v4i16((LAS v4i16_t*)p)); }
constexpr float LOG2E = 1.4426950408889634f;
constexpr int AT_K = 0, AT_V = 16384, AT_BT = 32768, AT_WS = 36864;
__device__ __forceinline__ void attn_dense(const Frame& F, LAS unsigned char* lds) {
    const int tid = F.tid, lane = F.lane, w = F.wave, q = lane & 31, hi = lane >> 5;
    LAS float* btab = (LAS float*)(lds + AT_BT);
    LAS float* wsf = (LAS float*)(lds + AT_WS) + w * 64;
    for (int i = tid; i < 1024; i += NTHR) {
        const int dist = i >> 3, h = i & 7; int bk;
        if (dist < 16) bk = dist; else { bk = 16 + (int)(log((double)dist / 16.0) / log(8.0) * 16.0); if (bk > 31) bk = 31; }
        btab[i] = F.rel_bias[bk * 8 + h] * LOG2E;
    }
    __syncthreads();
    const float c2 = 0.125f * LOG2E, THR = 8.f;
    const int vb0 = ((lane >> 4) & 1) * 32 + (lane & 3) * 8 + (4 * hi + ((lane & 15) >> 2)) * 64;
    for (int vu = blockIdx.x; vu < 256; vu += gridDim.x)
    for (int rr = 0; rr < 4; ++rr) {
        const int bh = vu >> 2, jj = vu & 3, qb = rr == 0 ? jj : rr == 1 ? 7 - jj : rr == 2 ? 8 + jj : 15 - jj, b = bh >> 3, h = bh & 7;
        const size_t rowbase = (size_t)b * S; const int q0 = qb * 256 + 32 * w, t = q0 + q, NT = 4 * (qb + 1);
        h16x8 qf[4];
#pragma unroll
        for (int ks = 0; ks < 4; ++ks) qf[ks] = *(const h16x8*)(F.Z + (rowbase + t) * ZP + ZC_AQ + h * 64 + 16 * ks + 8 * hi);
        const h16* kg = F.Z + (rowbase + lane) * ZP + ZC_AK + h * 64 + 8 * w;
        const h16* vg = F.Z + (rowbase + 16 * (w & 3) + (lane >> 2)) * ZP + ZC_AV + h * 64 + (w >> 2) * 32 + (lane & 3) * 8;
        const int sdst = w * 1024 + lane * 16;
        const unsigned* bmp = F.BM + bm_index(b, t, 0);
        typedef unsigned u32x2 __attribute__((ext_vector_type(2)));
        { const u32x4 kr = *(const u32x4*)kg, vr = *(const u32x4*)vg; *(LAS u32x4*)(lds + AT_K + sdst) = kr; *(LAS u32x4*)(lds + AT_V + sdst) = vr; }
        u32x2 mw = *(const u32x2*)bmp;
        __syncthreads();
        float m_run = -1e30f, l_part = 0.f; f32x16 o[2];
#pragma unroll
        for (int i = 0; i < 16; ++i) { o[0][i] = 0.f; o[1][i] = 0.f; }
        for (int kt = 0; kt < NT; ++kt) {
            const int cur = kt & 1; const bool more = (kt + 1 < NT);
            u32x4 kr, vr; u32x2 mwn = (u32x2){0u, 0u};
            if (more) { kr = *(const u32x4*)(kg + (size_t)(kt + 1) * 64 * ZP); vr = *(const u32x4*)(vg + (size_t)(kt + 1) * 64 * ZP); mwn = *(const u32x2*)(bmp + (size_t)(kt + 1) * 64); }
            if (64 * kt <= q0 + 31) {
                f32x16 p0, p1;
#pragma unroll
                for (int i = 0; i < 16; ++i) { p0[i] = 0.f; p1[i] = 0.f; }
                const LAS unsigned char* kb = lds + AT_K + cur * 8192 + hi * 1024 + q * 16;
#pragma unroll
                for (int d0 = 0; d0 < 4; ++d0) { const h16x8 b0 = *(const LAS h16x8*)(kb + d0 * 2048), b1 = *(const LAS h16x8*)(kb + d0 * 2048 + 512);
                    p0 = __builtin_amdgcn_mfma_f32_32x32x16_f16(b0, qf[d0], p0, 0, 0, 0); p1 = __builtin_amdgcn_mfma_f32_32x32x16_f16(b1, qf[d0], p1, 0, 0, 0); }
                if (q0 - (64 * kt + 63) >= 127) { const float bb = btab[127 * 8 + h];
#pragma unroll
                    for (int r = 0; r < 16; ++r) { p0[r] = p0[r] * c2 + bb; p1[r] = p1[r] * c2 + bb; }
                } else {
#pragma unroll
                    for (int r = 0; r < 16; ++r) { const int kv = 64 * kt + (r & 3) + 8 * (r >> 2) + 4 * hi; int d0_ = t - kv, d1_ = d0_ - 32;
                        d0_ = d0_ < 0 ? 0 : (d0_ > 127 ? 127 : d0_); d1_ = d1_ < 0 ? 0 : (d1_ > 127 ? 127 : d1_);
                        p0[r] = p0[r] * c2 + btab[d0_ * 8 + h]; p1[r] = p1[r] * c2 + btab[d1_ * 8 + h]; }
                }
                float mx = fmaxf(p0[0], p1[0]);
#pragma unroll
                for (int r = 1; r < 16; ++r) mx = fmaxf(mx, fmaxf(p0[r], p1[r]));
                mx = fmaxf(mx, __shfl_xor(mx, 32));
                if (__ballot(mx > m_run + THR) != 0ull) {
                    const float mn = fmaxf(m_run, mx), alpha = __builtin_amdgcn_exp2f(m_run - mn); m_run = mn; l_part *= alpha;
                    __builtin_amdgcn_wave_barrier();
                    if (hi == 0) wsf[q] = alpha;
                    __builtin_amdgcn_wave_barrier();
#pragma unroll
                    for (int g = 0; g < 4; ++g) { const f32x4 av = *(const LAS f32x4*)(wsf + 8 * g + 4 * hi);
#pragma unroll
                        for (int i = 0; i < 4; ++i) { o[0][4 * g + i] *= av[i]; o[1][4 * g + i] *= av[i]; } }
                    __builtin_amdgcn_wave_barrier();
                }
                const unsigned w0s = mw.x >> (4 * hi), w1s = mw.y >> (4 * hi);
#pragma unroll
                for (int r = 0; r < 16; ++r) { const int pos = (r & 3) + 8 * (r >> 2);
                    const float e0 = __builtin_amdgcn_exp2f(p0[r] - m_run), e1 = __builtin_amdgcn_exp2f(p1[r] - m_run);
                    const unsigned k0 = (unsigned)(-(int)((w0s >> pos) & 1u)), k1 = (unsigned)(-(int)((w1s >> pos) & 1u));
                    p0[r] = __uint_as_float(__float_as_uint(e0) & k0); p1[r] = __uint_as_float(__float_as_uint(e1) & k1);
                    l_part += p0[r] + p1[r]; }
                h16x8 pa[4];
#pragma unroll
                for (int j = 0; j < 8; ++j) { pa[0][j] = (h16)p0[j]; pa[1][j] = (h16)p0[8 + j]; pa[2][j] = (h16)p1[j]; pa[3][j] = (h16)p1[8 + j]; }
                const LAS unsigned char* vb = lds + AT_V + cur * 8192 + vb0;
#pragma unroll
                for (int d0 = 0; d0 < 2; ++d0)
#pragma unroll
                    for (int ks = 0; ks < 4; ++ks) { const h16x4 lo = vtr16(vb + d0 * 4096 + ks * 1024), hh = vtr16(vb + d0 * 4096 + ks * 1024 + 512);
                        h16x8 bv; bv[0] = lo[0]; bv[1] = lo[1]; bv[2] = lo[2]; bv[3] = lo[3]; bv[4] = hh[0]; bv[5] = hh[1]; bv[6] = hh[2]; bv[7] = hh[3];
                        o[d0] = __builtin_amdgcn_mfma_f32_32x32x16_f16(pa[ks], bv, o[d0], 0, 0, 0); }
            }
            if (more) { *(LAS u32x4*)(lds + AT_K + (cur ^ 1) * 8192 + sdst) = kr; *(LAS u32x4*)(lds + AT_V + (cur ^ 1) * 8192 + sdst) = vr; }
            mw = mwn;
            __syncthreads();
        }
        const float lt = l_part + __shfl_xor(l_part, 32), inv = 1.f / lt;
        __builtin_amdgcn_wave_barrier();
        if (hi == 0) wsf[q] = inv;
        __builtin_amdgcn_wave_barrier();
#pragma unroll
        for (int g = 0; g < 4; ++g) { const f32x4 av = *(const LAS f32x4*)(wsf + 8 * g + 4 * hi);
#pragma unroll
            for (int i = 0; i < 4; ++i) { const int qq = 8 * g + 4 * hi + i; h16* op = F.MIX + (rowbase + q0 + qq) * D + 512 + h * 64 + q;
                op[0] = (h16)(o[0][4 * g + i] * av[i]); op[32] = (h16)(o[1][4 * g + i] * av[i]); } }
        __builtin_amdgcn_wave_barrier();
    }
}

__device__ __forceinline__ void h2_phase(const Frame& F) {
    const int gw = blockIdx.x * 8 + F.wave, NGW = gridDim.x * 8;
    for (int m = gw; m < T; m += NGW) rms_row_to_h16(F.out + (size_t)m * D, F.norm_ffn, F.XN + (size_t)m * D, F.lane);
}
__device__ __forceinline__ void act_phase(const Frame& F, int row_lo, int row_hi) {
    constexpr int NCG = DFF / 8;
    const int nitems = ((row_hi - row_lo) / 32) * NCG;
    for (int id = blockIdx.x * NTHR + F.tid; id < nitems; id += gridDim.x * NTHR) {
        const int cg = id % NCG, run = id / NCG, c = cg * 8, pc = 256 * (c >> 7) + (c & 127);
        float wgt[3][8], wvl[3][8], bg[8], bv[8];
#pragma unroll
        for (int j = 0; j < 3; ++j) {
#pragma unroll
            for (int q4 = 0; q4 < 2; ++q4) { const f32x4 a = *(const f32x4*)(F.ffn_conv_w + j * NUP + c + 4 * q4), bq = *(const f32x4*)(F.ffn_conv_w + j * NUP + DFF + c + 4 * q4);
#pragma unroll
                for (int i = 0; i < 4; ++i) { wgt[j][4 * q4 + i] = a[i]; wvl[j][4 * q4 + i] = bq[i]; } }
        }
#pragma unroll
        for (int q4 = 0; q4 < 2; ++q4) { const f32x4 a = *(const f32x4*)(F.ffn_conv_b + c + 4 * q4), bq = *(const f32x4*)(F.ffn_conv_b + DFF + c + 4 * q4);
#pragma unroll
            for (int i = 0; i < 4; ++i) { bg[4 * q4 + i] = a[i]; bv[4 * q4 + i] = bq[i]; } }
        const int r0 = run * 32, t0 = (row_lo + r0) & (S - 1);
        const h16* yb = F.Y + (size_t)r0 * NUP + pc;
        h16x8 g2, g1, v2, v1;
#pragma unroll
        for (int i = 0; i < 8; ++i) { g2[i] = (h16)0.f; g1[i] = (h16)0.f; v2[i] = (h16)0.f; v1[i] = (h16)0.f; }
        if (t0 != 0) { g2 = *(const h16x8*)(yb - 2 * (ptrdiff_t)NUP); v2 = *(const h16x8*)(yb - 2 * (ptrdiff_t)NUP + 128); g1 = *(const h16x8*)(yb - (ptrdiff_t)NUP); v1 = *(const h16x8*)(yb - (ptrdiff_t)NUP + 128); }
        h16* ob = F.ACT + (size_t)(row_lo + r0) * DFF + c;
#pragma unroll 4
        for (int rr = 0; rr < 32; ++rr) {
            const h16x8 g0 = *(const h16x8*)(yb + (size_t)rr * NUP), v0 = *(const h16x8*)(yb + (size_t)rr * NUP + 128);
            h16x8 o;
#pragma unroll
            for (int i = 0; i < 8; ++i) {
                const float ug = bg[i] + wgt[0][i] * (float)g2[i] + wgt[1][i] * (float)g1[i] + wgt[2][i] * (float)g0[i];
                const float uv = bv[i] + wvl[0][i] * (float)v2[i] + wvl[1][i] * (float)v1[i] + wvl[2][i] * (float)v0[i];
                o[i] = (h16)(ug * sigmoidf_(ug) * uv);
            }
            *(h16x8*)(ob + (size_t)rr * DFF) = o;
            g2 = g1; g1 = g0; v2 = v1; v1 = v0;
        }
    }
}
__device__ __forceinline__ void final_norm_phase(const Frame& F) {
    const int gw = blockIdx.x * 8 + F.wave, NGW = gridDim.x * 8;
    f32x4 g[4];
#pragma unroll
    for (int j = 0; j < 4; ++j) g[j] = *(const f32x4*)(F.norm_final + 4 * F.lane + 256 * j);
    for (int m = gw; m < T; m += NGW) {
        float* xr = F.out + (size_t)m * D; const float r = pg8::rstd16(F.SS2 + (size_t)m * 16);
#pragma unroll
        for (int j = 0; j < 4; ++j) { const f32x4 v = *(const f32x4*)(xr + 4 * F.lane + 256 * j); *(f32x4*)(xr + 4 * F.lane + 256 * j) = v * r * g[j]; }
    }
}

__device__ __forceinline__ void fresh_tid(Frame& F) { int t = threadIdx.x; asm volatile("" : "+v"(t)); F.tid = t; F.lane = t & 63; F.wave = __builtin_amdgcn_readfirstlane(t >> 6); }
#ifndef MK_N_LAUNCHES
#define MK_N_LAUNCHES 1
#endif
constexpr int N_PHASES = 11;
constexpr int RING_BYTES = 131072, MISC_OFF = RING_BYTES + 320, LDS_BYTES = 157696;
constexpr int CW_BAR = 4096;
constexpr size_t CTL_ZERO_BYTES = 64 * 1024;
__global__ void __launch_bounds__(NTHR, 2) mk_fwd(Args a) {
    extern __shared__ __attribute__((aligned(16))) unsigned char lds_raw[];
    LAS unsigned char* lds = (LAS unsigned char*)lds_raw;
    Frame F;
    F.x = a.in[0]; F.norm_mix = a.in[1]; F.w_in = a.in[2]; F.conv_w = a.in[3]; F.conv_b = a.in[4]; F.i_bias = a.in[5]; F.f_bias = a.in[6]; F.mlstm_norm = a.in[7];
    F.idx_k_norm = a.in[8]; F.rel_bias = a.in[9]; F.w_out = a.in[10]; F.norm_ffn = a.in[11]; F.w_up = a.in[12]; F.ffn_conv_w = a.in[13]; F.ffn_conv_b = a.in[14];
    F.w_down = a.in[15]; F.norm_final = a.in[16]; F.out = a.out;
    unsigned char* ws = a.ws;
    F.WIN = (h16*)(ws + WS_WIN); F.WOUT = (h16*)(ws + WS_WOUT); F.WUP = (h16*)(ws + WS_WUP); F.WDN = (h16*)(ws + WS_WDN);
    F.GATES = (float*)(ws + WS_GATES); F.XN = (h16*)(ws + WS_XN); F.Z = (h16*)(ws + WS_Z); F.MIX = (h16*)(ws + WS_MIX); F.KN = (h16*)(ws + WS_KN);
    F.BM = (unsigned*)(ws + WS_BM); F.KVT = (float*)(ws + WS_KVT); F.KS = (float*)(ws + WS_KS); F.G = (float*)(ws + WS_GML); F.MLOC = F.G + 2048; F.MPREV = F.G + 4096; F.SS = (float*)(ws + WS_SS); F.SS2 = (float*)(ws + WS_SS2); F.YH = (float*)(ws + WS_YH); F.RSTD = (float*)(ws + WS_YH + 6 * MiB); F.Y = (h16*)(ws + WS_Y); F.ACT = (h16*)(ws + WS_ACT);
    F.tid = threadIdx.x; F.lane = F.tid & 63; F.wave = __builtin_amdgcn_readfirstlane(F.tid >> 6);
    volatile LAS unsigned* MISC = (volatile LAS unsigned*)(lds + MISC_OFF);
    for (int u = F.tid; u < (LDS_BYTES - RING_BYTES) / 4; u += NTHR) ((LAS unsigned*)(lds + RING_BYTES))[u] = 0u;
    __syncthreads();
    XcdBarrier bar; bar.bar = (unsigned*)(ws + WS_CTL) + CW_BAR; bar.x = 0; bar.st = nullptr;
    if (MK_N_LAUNCHES == 1) bar = xcd_barrier_post((unsigned*)(ws + WS_CTL) + CW_BAR, MISC + 8);
    const int lo = a.ph_lo, hi = a.ph_hi, G = gridDim.x;
#define IN(k) (fresh_tid(F), lo <= (k) && (k) < hi)
#define SEAM(k) do { if (IN(k) && IN((k) + 1)) xcd_barrier(bar); } while (0)
#ifndef PROBE_DUP
#define PROBE_DUP 0
#endif
#define REP(k) for (int rep_ = 0; rep_ <= ((PROBE_DUP >> (k)) & 1); ++rep_)
    if (IN(0)) REP(0) p0_prologue(F, lds);
    SEAM(0);
    if (IN(1)) { pg8::Gemm g{(const pg8::bf16_t*)F.XN, (const pg8::bf16_t*)F.WIN, T, ZP, D}; pg8::StaticOrder So; So.init(T, ZP, G, (int)blockIdx.x);
        pg8::EpiH16 E{F.Z, ZP, 0, F.GATES, ZC_G}; pg8::gemm_phase<pg8::EpiH16, pg8::StaticOrder, true, true>(lds, g, So, E); }
    SEAM(1);
    if (IN(2)) { kn_phase(F); REP(2) mlstm_A(F, lds); }
    SEAM(2);
    if (IN(3)) mlstm_B(F);
    SEAM(3);
    if (IN(4)) { REP(4) mlstm_C(F, lds); index_mfma<0>(F, lds);
#ifdef PROBE_IDX
        index_mfma<PROBE_IDX>(F, lds);
#endif
 }
    SEAM(4);
    if (IN(5)) REP(5) attn_dense(F, lds);
    SEAM(5);
    if (IN(6)) { pg8::Gemm g{(const pg8::bf16_t*)F.MIX, (const pg8::bf16_t*)F.WOUT, T, D, D}; pg8::StaticOrder So; So.init(T, D, G, (int)blockIdx.x);
        pg8::EpiOut E{F.x, F.out, F.XN, F.SS}; pg8::gemm_phase<pg8::EpiOut, pg8::StaticOrder, true, true>(lds, g, So, E); }
    SEAM(6);
    if (IN(7)) { for (int m = blockIdx.x * NTHR + F.tid; m < T; m += G * NTHR) F.RSTD[m] = pg8::rstd16(F.SS + (size_t)m * 16);
        pg8::Gemm g{(const pg8::bf16_t*)(F.XN - 2 * D), (const pg8::bf16_t*)F.WUP, 256, NUP, D}; pg8::StaticOrder So; So.init(256, NUP, G, (int)blockIdx.x);
        pg8::EpiHalo E{F.YH, NUP, F.SS}; pg8::gemm_phase<pg8::EpiHalo, pg8::StaticOrder, true, true, 2>(lds, g, So, E); }
    SEAM(7);
    if (IN(8)) { pg8::Gemm g{(const pg8::bf16_t*)F.XN, (const pg8::bf16_t*)F.WUP, T, NUP, D}; pg8::StaticOrder So; So.init(T, NUP, G, (int)blockIdx.x);
        pg8::EpiAct E{F.ACT, F.RSTD, F.YH, F.ffn_conv_w, F.ffn_conv_b, (LAS float*)(lds + RING_BYTES + 1024)};
        pg8::gemm_phase<pg8::EpiAct, pg8::StaticOrder, true, true, 1>(lds, g, So, E); }
    SEAM(8);
    if (IN(9)) { pg8::Gemm g{(const pg8::bf16_t*)F.ACT, (const pg8::bf16_t*)F.WDN, T, D, DFF}; pg8::StaticOrder So; So.init(T, D, G, (int)blockIdx.x);
        pg8::EpiOut E{F.out, F.out, nullptr, F.SS2}; pg8::gemm_phase<pg8::EpiOut, pg8::StaticOrder, true, true>(lds, g, So, E); }
    SEAM(9);
    if (IN(10)) final_norm_phase(F);
#undef IN
#undef SEAM
}

extern "C" void kernel_launch(void* const* d_in, const int* in_sizes, int n_in, void* d_out, int out_size, void* d_ws, size_t ws_size, hipStream_t stream) {
    static int grid = 0;
    if (grid == 0) {
        if (n_in != 17 || in_sizes[0] != T * D || out_size != T * D || ws_size < WS_END) { fprintf(stderr, "kernel_launch: unexpected shapes (n_in %d, in0 %d, out %d, ws %zu)\n", n_in, n_in > 0 ? in_sizes[0] : -1, out_size, ws_size); grid = -1; return; }
        int dev = 0, cus = 0, per_cu = 0;
        if (hipGetDevice(&dev) != hipSuccess || hipDeviceGetAttribute(&cus, hipDeviceAttributeMultiprocessorCount, dev) != hipSuccess) { fprintf(stderr, "kernel_launch: device query failed\n"); grid = -1; return; }
        if (hipFuncSetAttribute((const void*)mk_fwd, hipFuncAttributeMaxDynamicSharedMemorySize, LDS_BYTES) != hipSuccess) { fprintf(stderr, "kernel_launch: hipFuncSetAttribute failed\n"); grid = -1; return; }
        if (hipOccupancyMaxActiveBlocksPerMultiprocessor(&per_cu, (const void*)mk_fwd, NTHR, LDS_BYTES) != hipSuccess || per_cu < 1) fprintf(stderr, "kernel_launch: note: occupancy query reports %d workgroups per CU\n", per_cu);
        (void)hipGetLastError();
        grid = cus;
    }
    if (grid < 0) return;
    if (hipMemsetAsync((char*)d_ws + WS_CTL, 0, CTL_ZERO_BYTES, stream) != hipSuccess) { fprintf(stderr, "kernel_launch: memset failed\n"); return; }
    Args a{};
    for (int i = 0; i < 17; ++i) a.in[i] = (const float*)d_in[i];
    a.out = (float*)d_out; a.ws = (unsigned char*)d_ws;
    if (MK_N_LAUNCHES == 1) { a.ph_lo = 0; a.ph_hi = N_PHASES; hipLaunchKernelGGL(mk_fwd, dim3(grid), dim3(NTHR), LDS_BYTES, stream, a); }
    else for (int ph = 0; ph < N_PHASES; ++ph) { a.ph_lo = ph; a.ph_hi = ph + 1; hipLaunchKernelGGL(mk_fwd, dim3(grid), dim3(NTHR), LDS_BYTES, stream, a); }
}
```

```cpp
#include <hip/hip_runtime.h>
#include <cstdio>
#include <cstdint>

#define LAS __attribute__((address_space(3)))
typedef _Float16 h16;
typedef _Float16 h16x8 __attribute__((ext_vector_type(8)));
typedef float f32x4 __attribute__((ext_vector_type(4)));
typedef unsigned u32x4 __attribute__((ext_vector_type(4)));

constexpr int NB = 8, S = 4096, T = NB * S, D = 1024;
constexpr int ZP = 3840;
constexpr int DFF = 2816, NUP = 2 * DFF;
constexpr int ZC_MQ = 0, ZC_MK = 256, ZC_MV = 512, ZC_MO = 1024, ZC_AQ = 1536, ZC_AK = 2048, ZC_AV = 2560, ZC_IQ = 3072, ZC_IK = 3584, ZC_G = 3648;
constexpr int TOPK = 256;
constexpr float EPS = 1e-6f;
constexpr int NTHR = 512;

constexpr size_t MiB = 1u << 20;
constexpr size_t WS_CTL = 0;
constexpr size_t WS_WIN = 2 * MiB;
constexpr size_t WS_WOUT = 10 * MiB;
constexpr size_t WS_WUP = 12 * MiB;
constexpr size_t WS_WDN = 23 * MiB;
constexpr size_t WS_GATES = 29 * MiB;
constexpr size_t WS_XN = 32 * MiB;
constexpr size_t WS_Z = 96 * MiB;
constexpr size_t WS_MIX = 336 * MiB;
constexpr size_t WS_KN = 400 * MiB;
constexpr size_t WS_BM = 404 * MiB;
constexpr size_t WS_Y = 96 * MiB;
constexpr size_t WS_ACT = 96 * MiB;
constexpr size_t WS_SS = 404 * MiB;
constexpr size_t WS_SS2 = 406 * MiB;
constexpr size_t WS_YH = 408 * MiB;
constexpr size_t WS_KVT = 420 * MiB;
constexpr size_t WS_KS = 484 * MiB;
constexpr size_t WS_GML = 485 * MiB;
constexpr size_t WS_END = 486 * MiB;

struct Args { const float* in[17]; float* out; unsigned char* ws; int ph_lo, ph_hi; };

struct Frame {
    const float *x, *norm_mix, *w_in, *conv_w, *conv_b, *i_bias, *f_bias, *mlstm_norm, *idx_k_norm, *rel_bias, *w_out, *norm_ffn, *w_up, *ffn_conv_w, *ffn_conv_b, *w_down, *norm_final;
    float* out;
    h16 *WIN, *WOUT, *WUP, *WDN, *XN, *Z, *MIX, *KN, *Y, *ACT;
    float* GATES; unsigned* BM;
    float *KVT, *KS, *G, *MLOC, *MPREV;
    float *SS, *SS2, *YH, *RSTD;
    int tid, lane, wave;
};

__device__ __forceinline__ float wave_sum(float v) {
#pragma unroll
    for (int o = 1; o < 64; o <<= 1) v += __shfl_xor(v, o);
    return v;
}
__device__ __forceinline__ float wave_max(float v) {
#pragma unroll
    for (int o = 1; o < 64; o <<= 1) v = fmaxf(v, __shfl_xor(v, o));
    return v;
}
__device__ __forceinline__ int wave_isum(int v) {
#pragma unroll
    for (int o = 1; o < 64; o <<= 1) v += __shfl_xor(v, o);
    return v;
}
__device__ __forceinline__ float sigmoidf_(float x) { return 1.f / (1.f + __expf(-x)); }

__device__ __forceinline__ int src_col_in(int n) { return n < 1536 ? n : n < 3648 ? n + 8 : n < 3656 ? n - 3648 + 1536 : n < 3664 ? n : -1; }
__device__ __forceinline__ int src_col_up(int n) { const int pn = n >> 8, r = n & 255; return (r >> 7) * DFF + pn * 128 + (r & 127); }

template <int MODE>
__device__ __forceinline__ void transpose_item(const float* W, int K, int N, h16* WT, int NOUT, LAS float* scr, int item, int lane, const float* kscale = nullptr) {
    const int nblk = NOUT / 32, kb = item / nblk, nb = item % nblk, k0 = 64 * kb, n0 = 32 * nb;
    const int n = n0 + (lane & 31);
    const int sc = MODE == 1 ? src_col_in(n) : MODE == 2 ? src_col_up(n) : n;
#pragma unroll 8
    for (int i = 0; i < 32; ++i) { const int kk = 2 * i + (lane >> 5); scr[kk * 33 + (lane & 31)] = sc >= 0 ? W[(size_t)(k0 + kk) * N + sc] * (kscale ? kscale[k0 + kk] : 1.f) : 0.f; }
    __builtin_amdgcn_s_waitcnt(0xc07f); __builtin_amdgcn_wave_barrier();
    const int c = lane & 7;
#pragma unroll
    for (int j = 0; j < 4; ++j) {
        const int nn = (lane >> 3) + 8 * j; const LAS float* s = scr + (8 * c) * 33 + nn;
        h16x8 o;
#pragma unroll
        for (int i = 0; i < 8; ++i) o[i] = (h16)s[i * 33];
        *(h16x8*)(WT + (size_t)(n0 + nn) * K + k0 + 8 * c) = o;
    }
    __builtin_amdgcn_s_waitcnt(0xc07f); __builtin_amdgcn_wave_barrier();
}

__device__ __forceinline__ void rms_row_to_h16(const float* xrow, const float* g, h16* orow, int lane) {
    f32x4 v[4]; float s = 0.f;
#pragma unroll
    for (int j = 0; j < 4; ++j) { v[j] = *(const f32x4*)(xrow + 4 * lane + 256 * j); s += (v[j].x * v[j].x + v[j].y * v[j].y) + (v[j].z * v[j].z + v[j].w * v[j].w); }
    const float r = 1.f / sqrtf(wave_sum(s) * (1.f / D) + EPS);
#pragma unroll
    for (int j = 0; j < 4; ++j) {
        const f32x4 gg = *(const f32x4*)(g + 4 * lane + 256 * j);
        typedef _Float16 h16x4 __attribute__((ext_vector_type(4)));
        h16x4 o; o[0] = (h16)(v[j].x * r * gg.x); o[1] = (h16)(v[j].y * r * gg.y); o[2] = (h16)(v[j].z * r * gg.z); o[3] = (h16)(v[j].w * r * gg.w);
        *(h16x4*)(orow + 4 * lane + 256 * j) = o;
    }
}

__device__ __forceinline__ void p0_prologue(const Frame& F, LAS unsigned char* lds) {
    LAS float* scr = (LAS float*)lds + F.wave * (64 * 33);
    const int gw = blockIdx.x * 8 + F.wave, NGW = gridDim.x * 8;
    constexpr int I_IN = 16 * (ZP / 32), I_OUT = 16 * (D / 32), I_UP = 16 * (NUP / 32), I_DN = (DFF / 64) * (D / 32);
    for (int it = gw; it < I_IN + I_OUT + I_UP + I_DN; it += NGW) {
        int r = it;
        if (r < I_IN) { transpose_item<1>(F.w_in, D, 3664, F.WIN, ZP, scr, r, F.lane); continue; } r -= I_IN;
        if (r < I_OUT) { transpose_item<0>(F.w_out, D, D, F.WOUT, D, scr, r, F.lane); continue; } r -= I_OUT;
        if (r < I_UP) { transpose_item<2>(F.w_up, D, NUP, F.WUP, NUP, scr, r, F.lane, F.norm_ffn); continue; } r -= I_UP;
        transpose_item<0>(F.w_down, DFF, D, F.WDN, D, scr, r, F.lane);
    }
    for (int m = gw; m < T; m += NGW) rms_row_to_h16(F.x + (size_t)m * D, F.norm_mix, F.XN + (size_t)m * D, F.lane);
}

namespace pg8 {
#define PG8_LAS __attribute__((address_space(3)))
typedef unsigned short bf16_t;
typedef short bf16x8 __attribute__((ext_vector_type(8)));
typedef float f32x4 __attribute__((ext_vector_type(4)));
typedef unsigned u32x4 __attribute__((ext_vector_type(4)));
constexpr int BM = 256, BK = 64, HALF = 128, HTB = HALF * BK * 2  , STAGE_BYTES = 8 * HTB, NXCD = 8, WGM = 8;

__host__ __device__ __forceinline__ int lds_byte(int r, int c) { const int st = (r >> 4) * 2 + (c >> 5), rr = r & 15, cc = c & 31, ob = rr * 64 + cc * 2; return st * 1024 + (ob ^ (((ob >> 9) & 1) << 5)); }
__host__ __device__ __forceinline__ void stage_rc(int b, int& R, int& C) { const int st = b / 1024, sb = b % 1024, swz = sb ^ (((sb >> 9) & 1) << 5); R = (st >> 1) * 16 + swz / 64; C = (st & 1) * 32 + (swz % 64) / 2; }
__host__ __device__ __forceinline__ int perm32(int rho) { const int n = rho >> 4, i = rho & 15; return 8 * (i >> 2) + 4 * n + (i & 3); }

struct Unit { int pm, pn; };
struct Gemm { const bf16_t* A; const bf16_t* Bt; int M, N, K; };

struct StaticOrder {
    int nM, nN, nwg, G, c;
    __host__ __device__ void init(int M, int N, int G_, int c_) { nM = M / BM; nN = N / BM; nwg = nM * nN; G = G_; c = c_; }
    __host__ __device__ bool next(int i, Unit& u) const {
        const long L = (long)i * G + c; if (L >= nwg) return false;
        int wgid = (int)L; { const int q = nwg / NXCD, r = nwg % NXCD, xcd = wgid % NXCD, off = wgid / NXCD; wgid = (xcd < r ? xcd * (q + 1) : r * (q + 1) + (xcd - r) * q) + off; }
        const int nig = WGM * nN, gid = wgid / nig, fm = gid * WGM, gsz = (nM - fm) < WGM ? (nM - fm) : WGM;
        u.pm = fm + ((wgid % nig) % gsz); u.pn = (wgid % nig) / gsz; return true;
    }
    __device__ __forceinline__ void a_ready(const Unit&) const {}
    __device__ __forceinline__ void done(const Unit&) const {}
};

typedef _Float16 f16x8 __attribute__((ext_vector_type(8)));
struct EpiH16 {
    static constexpr bool PERM = true, AFTER_DRAIN = false;
    _Float16* O; int ldc; int row_off; float* G; int gc0;
    __device__ __forceinline__ void operator()(const f32x4 (&acc)[2][2][4][2], const Unit& u, int wr, int wc, int fr, int fq) const {
        const int row0 = row_off + u.pm * BM + wr * 64 + fr, col0 = u.pn * BM + wc * 32 + 8 * fq;
#pragma unroll
        for (int ai = 0; ai < 2; ++ai)
#pragma unroll
            for (int m = 0; m < 4; ++m) { const size_t r = (size_t)(row0 + ai * HALF + m * 16);
#pragma unroll
                for (int bj = 0; bj < 2; ++bj) { const int c = col0 + bj * HALF; const f32x4 v0 = acc[ai][bj][m][0], v1 = acc[ai][bj][m][1];
                    f16x8 o; o[0] = (_Float16)v0[0]; o[1] = (_Float16)v0[1]; o[2] = (_Float16)v0[2]; o[3] = (_Float16)v0[3]; o[4] = (_Float16)v1[0]; o[5] = (_Float16)v1[1]; o[6] = (_Float16)v1[2]; o[7] = (_Float16)v1[3];
                    *(f16x8*)(O + r * ldc + c) = o;
                    if (G && c >= gc0 && c < gc0 + 16) { *(f32x4*)(G + r * 16 + (c - gc0)) = v0; *(f32x4*)(G + r * 16 + (c - gc0) + 4) = v1; } } }
    }
};
struct EpiRes32 {
    static constexpr bool PERM = false, AFTER_DRAIN = false;
    const float* base; float* out; int ldc;
    __device__ __forceinline__ void operator()(const f32x4 (&acc)[2][2][4][2], const Unit& u, int wr, int wc, int fr, int fq) const {
        const int row0 = u.pm * BM + wr * 64 + fr, col0 = u.pn * BM + wc * 32 + 4 * fq;
#pragma unroll
        for (int ai = 0; ai < 2; ++ai)
#pragma unroll
            for (int m = 0; m < 4; ++m) { const size_t off = (size_t)(row0 + ai * HALF + m * 16) * ldc + col0;
#pragma unroll
                for (int bj = 0; bj < 2; ++bj)
#pragma unroll
                    for (int n = 0; n < 2; ++n) { const f32x4 b = *(const f32x4*)(base + off + bj * HALF + n * 16); *(f32x4*)(out + off + bj * HALF + n * 16) = b + acc[ai][bj][m][n]; } }
    }
};

struct EpiOut {
    static constexpr bool PERM = false, AFTER_DRAIN = false;
    const float* base; float* out; _Float16* xn; float* ss;
    __device__ __forceinline__ void operator()(const f32x4 (&acc)[2][2][4][2], const Unit& u, int wr, int wc, int fr, int fq) const {
        typedef _Float16 f16x4 __attribute__((ext_vector_type(4)));
        const int row0 = u.pm * BM + wr * 64 + fr, col0 = u.pn * BM + wc * 32 + 4 * fq;
#pragma unroll
        for (int ai = 0; ai < 2; ++ai)
#pragma unroll
            for (int m = 0; m < 4; ++m) { const size_t row = (size_t)(row0 + ai * HALF + m * 16), off = row * 1024 + col0; float sq = 0.f;
#pragma unroll
                for (int bj = 0; bj < 2; ++bj)
#pragma unroll
                    for (int n = 0; n < 2; ++n) { const f32x4 b = *(const f32x4*)(base + off + bj * HALF + n * 16), v = b + acc[ai][bj][m][n];
                        *(f32x4*)(out + off + bj * HALF + n * 16) = v; sq += (v[0] * v[0] + v[1] * v[1]) + (v[2] * v[2] + v[3] * v[3]);
                        if (xn) { f16x4 h; h[0] = (_Float16)v[0]; h[1] = (_Float16)v[1]; h[2] = (_Float16)v[2]; h[3] = (_Float16)v[3]; *(f16x4*)(xn + off + bj * HALF + n * 16) = h; } }
                sq += __shfl_xor(sq, 16); sq += __shfl_xor(sq, 32);
                if (fq == 0) ss[row * 16 + 4 * u.pn + wc] = sq; }
    }
};
__device__ __forceinline__ float rstd16(const float* sp) {
    const f32x4 a = *(const f32x4*)sp, b = *(const f32x4*)(sp + 4), c = *(const f32x4*)(sp + 8), d = *(const f32x4*)(sp + 12);
    const float s = ((a[0] + a[1]) + (a[2] + a[3])) + ((b[0] + b[1]) + (b[2] + b[3])) + ((c[0] + c[1]) + (c[2] + c[3])) + ((d[0] + d[1]) + (d[2] + d[3]));
    return 1.0f / sqrtf(s * (1.0f / 1024.0f) + 1e-6f);
}
struct EpiHalo {
    static constexpr bool PERM = true, AFTER_DRAIN = false;
    float* yh; int ldc; const float* ss;
    __device__ __forceinline__ void operator()(const f32x4 (&acc)[2][2][4][2], const Unit& u, int wr, int wc, int fr, int fq) const {
        const int r0 = wr * 64 + fr, col0 = u.pn * BM + wc * 32 + 8 * fq;
#pragma unroll
        for (int ai = 0; ai < 2; ++ai)
#pragma unroll
            for (int m = 0; m < 4; ++m) { const int rp = r0 + ai * HALF + m * 16, tok = 256 * (rp >> 1) - 2 + (rp & 1); const float rs = tok >= 0 ? rstd16(ss + (size_t)tok * 16) : 0.f;
#pragma unroll
                for (int bj = 0; bj < 2; ++bj) { float* p = yh + (size_t)rp * ldc + col0 + bj * HALF; const f32x4 z = (f32x4){0.f, 0.f, 0.f, 0.f};
                    *(f32x4*)p = tok >= 0 ? acc[ai][bj][m][0] * rs : z; *(f32x4*)(p + 4) = tok >= 0 ? acc[ai][bj][m][1] * rs : z; }  asm volatile("" ::: "memory"); }
    }
};
struct EpiAct {
    static constexpr bool PERM = true, AFTER_DRAIN = false;
    _Float16* act; const float* rstd; const float* yh; const float* cw; const float* cb; PG8_LAS float* X;
    __device__ __forceinline__ void operator()(f32x4 (&acc)[2][2][4][2], const Unit& u, int wr, int wc, int fr, int fq) const {
        typedef _Float16 f16x4 __attribute__((ext_vector_type(4)));
        const size_t rowb = (size_t)u.pm * BM + wr * 64 + 4 * fr;
        const int gc0 = u.pn * 128 + wc * 32 + 8 * fq;
#pragma unroll
        for (int ai = 0; ai < 2; ++ai)
#pragma unroll
            for (int m = 0; m < 4; ++m) { const float rs = rstd[rowb + ai * HALF + m];
#pragma unroll
                for (int bj = 0; bj < 2; ++bj)
#pragma unroll
                    for (int n = 0; n < 2; ++n) acc[ai][bj][m][n] *= rs; }
        if (fr == 15) {
#pragma unroll
            for (int ai = 0; ai < 2; ++ai)
#pragma unroll
                for (int j = 0; j < 2; ++j) { PG8_LAS float* xp = X + ((((wr * 2 + ai) * 4 + wc) * 2 + j) * 64) + fq * 16;
#pragma unroll
                    for (int bj = 0; bj < 2; ++bj)
#pragma unroll
                        for (int n = 0; n < 2; ++n) *(PG8_LAS f32x4*)(xp + bj * 8 + n * 4) = acc[ai][bj][2 + j][n]; }
        }
        asm volatile("s_waitcnt lgkmcnt(0)" ::: "memory"); __builtin_amdgcn_s_barrier(); asm volatile("" ::: "memory");
        const bool seqstart = (u.pm & 15) == 0;
#pragma unroll
        for (int ai = 0; ai < 2; ++ai)
#pragma unroll
            for (int n = 0; n < 2; ++n) {
                f32x4 ug[4];
#pragma unroll
                for (int bj = 0; bj < 2; ++bj) {
                    f32x4 w3[3];
#pragma unroll
                    for (int j = 0; j < 3; ++j) w3[j] = *(const f32x4*)(cw + j * 5632 + bj * 2816 + gc0 + 4 * n);
                    const f32x4 bb = *(const f32x4*)(cb + bj * 2816 + gc0 + 4 * n);
                    f32x4 p[2];
                    p[0] = (f32x4){0.f, 0.f, 0.f, 0.f}; p[1] = (f32x4){0.f, 0.f, 0.f, 0.f};
                    if (fr == 0) {
                        if (wr == 1 || ai == 1) { const int swr = (wr == 1) ? 0 : 1, sai = (wr == 1) ? ai : 0;
#pragma unroll
                            for (int j = 0; j < 2; ++j) p[j] = *(const PG8_LAS f32x4*)(X + ((((swr * 2 + sai) * 4 + wc) * 2 + j) * 64) + fq * 16 + bj * 8 + n * 4);
                        } else if (!seqstart) {
#pragma unroll
                            for (int j = 0; j < 2; ++j) p[j] = *(const f32x4*)(yh + (size_t)(2 * u.pm + j) * 5632 + u.pn * BM + bj * HALF + wc * 32 + 8 * fq + 4 * n);
                        }
                    }
#pragma unroll
                    for (int j = 0; j < 2; ++j)
#pragma unroll
                        for (int i = 0; i < 4; ++i) p[j][i] = __int_as_float(__builtin_amdgcn_update_dpp(__float_as_int(p[j][i]), __float_as_int(acc[ai][bj][2 + j][n][i]), 0x111, 0xF, 0xF, false));
#pragma unroll
                    for (int m = 0; m < 4; ++m) {
                        const f32x4 y2 = m >= 2 ? acc[ai][bj][m - 2][n] : p[m], y1 = m >= 1 ? acc[ai][bj][m - 1][n] : p[1];
                        const f32x4 uu = bb + w3[0] * y2 + w3[1] * y1 + w3[2] * acc[ai][bj][m][n];
                        if (bj == 0) ug[m] = uu;
                        else { f16x4 o;
#pragma unroll
                            for (int i = 0; i < 4; ++i) o[i] = (_Float16)(ug[m][i] / (1.0f + __expf(-ug[m][i])) * uu[i]);
                            *(f16x4*)(act + (rowb + ai * HALF + m) * 2816 + gc0 + 4 * n) = o; }
                    }
                }
                asm volatile("" ::: "memory");
            }
    }
};
template <int AMAP> __host__ __device__ __forceinline__ int amap_row(int R) {
    if (AMAP == 1) return (R & 64) + 4 * (R & 15) + ((R >> 4) & 3);
    if (AMAP == 2) return 256 * (R >> 1) + (R & 1);
    return R;
}
template <class Epi, class Sched, bool ALIGN_EPI = false, bool SP2 = false, int AMAP = 0>
__device__ __forceinline__ void gemm_phase(PG8_LAS unsigned char* lds, const Gemm g, const Sched& S, const Epi& E) {
    const int tid = threadIdx.x, wid = __builtin_amdgcn_readfirstlane(tid >> 6), lane = tid & 63, wr = wid >> 2, wc = wid & 3, fr = lane & 15, fq = lane >> 4;
    const int K = g.K, nt = K / BK;
    unsigned voffA[2], voffB[2];
#pragma unroll
    for (int i = 0; i < 2; ++i) { int R, C; stage_rc(tid * 16 + i * 8192, R, C); const int Rb = Epi::PERM ? ((R & ~31) + perm32(R & 31)) : R;
        voffA[i] = (unsigned)(amap_row<AMAP>(R) * K + C) * 2u; voffB[i] = (unsigned)(Rb * K + C) * 2u; }
    const size_t kstep = (size_t)(BK * 2);
    const size_t hstep = (size_t)HALF * K * 2;
    const size_t hstepA = (AMAP == 2) ? (size_t)16384 * K * 2 : hstep;
    const size_t tstep = 2 * hstep;
    const unsigned ldsw = (unsigned)wid * 1024u;
    const int aoff = lds_byte(wr * 64 + fr, fq * 8), boff = lds_byte(wc * 32 + fr, fq * 8);
#define PG8_SA(b, h) (((b) * 2 + (h)) * HTB)
#define PG8_SB(b, h) ((4 + (b) * 2 + (h)) * HTB)
#define PG8_STAGE(bufoff, gbase, voff) do { _Pragma("unroll") for (int _i = 0; _i < 2; ++_i) \
        __builtin_amdgcn_global_load_lds((const unsigned*)((const char*)(gbase) + (voff)[_i]), (PG8_LAS unsigned*)(lds + (bufoff) + ldsw + _i * 8192), 16, 0, 0); } while (0)
#define PG8_LDA(dst, b, h) do { _Pragma("unroll") for (int m = 0; m < 4; ++m) _Pragma("unroll") for (int k = 0; k < 2; ++k) dst[m][k] = *(const PG8_LAS bf16x8*)(lds + PG8_SA(b, h) + aoff + m * 2048 + k * 1024); } while (0)
#define PG8_LDB(dst, b, h) do { _Pragma("unroll") for (int n = 0; n < 2; ++n) _Pragma("unroll") for (int k = 0; k < 2; ++k) dst[n][k] = *(const PG8_LAS bf16x8*)(lds + PG8_SB(b, h) + boff + n * 2048 + k * 1024); } while (0)
#define PG8_MMA(ai, bj, At, Bt) do { __builtin_amdgcn_s_setprio(1); _Pragma("unroll") for (int m = 0; m < 4; ++m) _Pragma("unroll") for (int n = 0; n < 2; ++n) _Pragma("unroll") for (int k = 0; k < 2; ++k) \
        acc[ai][bj][m][n] = __builtin_amdgcn_mfma_f32_16x16x32_f16(__builtin_bit_cast(f16x8, Bt[n][k]), __builtin_bit_cast(f16x8, At[m][k]), acc[ai][bj][m][n], 0, 0, 0); __builtin_amdgcn_s_setprio(0); } while (0)
#define PG8_WAIT_V(n) asm volatile("s_waitcnt vmcnt(" #n ")" ::: "memory")
#define PG8_WAIT_L(n) asm volatile("s_waitcnt lgkmcnt(" #n ")" ::: "memory")
#define PG8_BAR __builtin_amdgcn_s_barrier()
#define PG8_SCHED __builtin_amdgcn_sched_barrier(0)
    Unit cur, nxt; int ui = 0;
    if (!S.next(0, cur)) return;
    f32x4 acc[2][2][4][2];
#pragma unroll
    for (int a = 0; a < 2; ++a)
#pragma unroll
        for (int b = 0; b < 2; ++b)
#pragma unroll
            for (int m = 0; m < 4; ++m)
#pragma unroll
                for (int n = 0; n < 2; ++n) acc[a][b][m][n] = (f32x4){0.f, 0.f, 0.f, 0.f};
    bf16x8 At[4][2], B0[2][2], B1[2][2];
    const char* cA = (const char*)g.A + (size_t)cur.pm * tstep; const char* cB = (const char*)g.Bt + (size_t)cur.pn * tstep;
    S.a_ready(cur);
    if constexpr (SP2) {
        PG8_STAGE(PG8_SB(0, 0), cB, voffB); PG8_STAGE(PG8_SB(0, 1), cB + hstep, voffB); PG8_STAGE(PG8_SA(0, 0), cA, voffA); PG8_STAGE(PG8_SA(0, 1), cA + hstepA, voffA);
        if (wr == 1) PG8_BAR;
        PG8_WAIT_V(2); PG8_BAR;
        PG8_STAGE(PG8_SB(1, 0), cB + kstep, voffB); PG8_STAGE(PG8_SA(1, 0), cA + kstep, voffA); PG8_STAGE(PG8_SB(1, 1), cB + hstep + kstep, voffB);
        PG8_WAIT_V(6); PG8_BAR;
    } else {
        PG8_STAGE(PG8_SB(0, 0), cB, voffB); PG8_STAGE(PG8_SA(0, 0), cA, voffA); PG8_STAGE(PG8_SB(0, 1), cB + hstep, voffB); PG8_STAGE(PG8_SA(0, 1), cA + hstepA, voffA);
        if (wr == 1) PG8_BAR;
        PG8_WAIT_V(4); PG8_BAR;
        PG8_STAGE(PG8_SB(1, 0), cB + kstep, voffB); PG8_STAGE(PG8_SA(1, 0), cA + kstep, voffA); PG8_STAGE(PG8_SB(1, 1), cB + hstep + kstep, voffB);
        PG8_WAIT_V(6); PG8_BAR;
    }
    for (;;) {
        const bool has_next = S.next(ui + 1, nxt);
        const char* nA = has_next ? (const char*)g.A + (size_t)nxt.pm * tstep : cA; const char* nB = has_next ? (const char*)g.Bt + (size_t)nxt.pn * tstep : cB;
        for (int t = 0; t < nt; t += 2) {
            const bool last = (t == nt - 2);
            const char* a1 = cA + (size_t)(t + 1) * kstep;
            const char* a2 = last ? nA : cA + (size_t)(t + 2) * kstep; const char* b2 = last ? nB : cB + (size_t)(t + 2) * kstep;
            const char* a3 = a2 + kstep; const char* b3 = b2 + kstep;
            if (last && has_next) S.a_ready(nxt);
            if constexpr (SP2) {
            PG8_LDB(B0, 0, 0); PG8_LDB(B1, 0, 1); PG8_SCHED; PG8_LDA(At, 0, 0); PG8_STAGE(PG8_SA(1, 1), a1 + hstepA, voffA);
            PG8_WAIT_V(8); PG8_WAIT_L(0); PG8_BAR; PG8_MMA(0, 0, At, B0); PG8_MMA(0, 1, At, B1); PG8_BAR; PG8_SCHED;
            PG8_LDA(At, 0, 1); PG8_STAGE(PG8_SB(0, 0), b2, voffB); PG8_STAGE(PG8_SB(0, 1), b2 + hstep, voffB); PG8_STAGE(PG8_SA(0, 0), a2, voffA);
            PG8_WAIT_V(8); PG8_WAIT_L(0); PG8_BAR; PG8_MMA(1, 0, At, B0); PG8_MMA(1, 1, At, B1); PG8_BAR; PG8_SCHED;
            PG8_LDB(B0, 1, 0); PG8_LDB(B1, 1, 1); PG8_SCHED; PG8_LDA(At, 1, 0); PG8_STAGE(PG8_SA(0, 1), a2 + hstepA, voffA);
            PG8_WAIT_V(8); PG8_WAIT_L(0); PG8_BAR; PG8_MMA(0, 0, At, B0); PG8_MMA(0, 1, At, B1); PG8_BAR; PG8_SCHED;
            PG8_LDA(At, 1, 1); PG8_STAGE(PG8_SB(1, 0), b3, voffB); PG8_STAGE(PG8_SB(1, 1), b3 + hstep, voffB); PG8_STAGE(PG8_SA(1, 0), a3, voffA);
            PG8_WAIT_V(8); PG8_WAIT_L(0); PG8_BAR; PG8_MMA(1, 0, At, B0); PG8_MMA(1, 1, At, B1); PG8_BAR; PG8_SCHED;
            } else {
            PG8_LDB(B0, 0, 0); PG8_SCHED; PG8_LDA(At, 0, 0); PG8_STAGE(PG8_SA(1, 1), a1 + hstepA, voffA);
            PG8_WAIT_L(8); PG8_BAR; PG8_WAIT_L(0); PG8_MMA(0, 0, At, B0); PG8_BAR; PG8_SCHED;
            PG8_LDB(B1, 0, 1); PG8_STAGE(PG8_SB(0, 0), b2, voffB);
            PG8_BAR; PG8_WAIT_L(0); PG8_MMA(0, 1, At, B1); PG8_BAR;
            PG8_LDA(At, 0, 1); PG8_STAGE(PG8_SA(0, 0), a2, voffA);
            PG8_BAR; PG8_WAIT_L(0); PG8_MMA(1, 0, At, B0); PG8_BAR; PG8_SCHED;
            PG8_STAGE(PG8_SB(0, 1), b2 + hstep, voffB);
            PG8_WAIT_V(6); PG8_BAR; PG8_MMA(1, 1, At, B1); PG8_BAR;
            PG8_LDB(B0, 1, 0); PG8_SCHED; PG8_LDA(At, 1, 0); PG8_STAGE(PG8_SA(0, 1), a2 + hstepA, voffA);
            PG8_WAIT_L(8); PG8_BAR; PG8_WAIT_L(0); PG8_MMA(0, 0, At, B0); PG8_BAR; PG8_SCHED;
            PG8_LDB(B1, 1, 1); PG8_STAGE(PG8_SB(1, 0), b3, voffB);
            PG8_BAR; PG8_WAIT_L(0); PG8_MMA(0, 1, At, B1); PG8_BAR;
            PG8_LDA(At, 1, 1); PG8_STAGE(PG8_SA(1, 0), a3, voffA);
            PG8_BAR; PG8_WAIT_L(0); PG8_MMA(1, 0, At, B0); PG8_BAR; PG8_SCHED;
            PG8_STAGE(PG8_SB(1, 1), b3 + hstep, voffB);
            PG8_WAIT_V(6); PG8_BAR; PG8_MMA(1, 1, At, B1); PG8_BAR;
            }
        }
        if constexpr (ALIGN_EPI) { if (wr == 0) PG8_BAR; }
        if constexpr (!Epi::AFTER_DRAIN) { E(acc, cur, wr, wc, fr, fq); S.done(cur); }
        if (!has_next) break;
#pragma unroll
        for (int a = 0; a < 2; ++a)
#pragma unroll
            for (int b = 0; b < 2; ++b)
#pragma unroll
                for (int m = 0; m < 4; ++m)
#pragma unroll
                    for (int n = 0; n < 2; ++n) acc[a][b][m][n] = (f32x4){0.f, 0.f, 0.f, 0.f};
        cur = nxt; cA = nA; cB = nB; ++ui;
        if constexpr (ALIGN_EPI) { if (wr == 1) PG8_BAR; }
    }
    PG8_WAIT_V(0);
    if constexpr (!ALIGN_EPI) { if (wr == 0) PG8_BAR; }
    PG8_BAR;
    if constexpr (Epi::AFTER_DRAIN) { E.fused(acc, cur, wr, wc, fr, fq, lds, wid, lane); S.done(cur); }
#undef PG8_SA
#undef PG8_SB
#undef PG8_STAGE
#undef PG8_LDA
#undef PG8_LDB
#undef PG8_MMA
#undef PG8_WAIT_V
#undef PG8_WAIT_L
#undef PG8_BAR
#undef PG8_SCHED
}
}


#define XB_TMO      128
#define XB_XCNT(j)  (256  + 64 * (j))
#define XB_XSUB(j)  (1280 + 64 * (j))
#define XB_XGEN(j)  (2304 + 64 * (j))
#define XB_TOP      3328
#define XB_TOPGEN   3392
#define XCD_BAR_WORDS 3456
#define XB_SPIN_CAP (1u << 18)

__device__ __forceinline__ unsigned xb_ld(unsigned* p)              { return __hip_atomic_load(p, __ATOMIC_RELAXED, __HIP_MEMORY_SCOPE_AGENT); }
__device__ __forceinline__ unsigned xb_add(unsigned* p, unsigned v) { return __hip_atomic_fetch_add(p, v, __ATOMIC_RELAXED, __HIP_MEMORY_SCOPE_AGENT); }
__device__ __forceinline__ unsigned xb_xcc_id() { return (unsigned)__builtin_amdgcn_s_getreg((3 << 11) | 20) & 0xFu; }
#define XB_SPIN(cond, bar) do { unsigned _sp = 0; while (cond) { __builtin_amdgcn_s_sleep(1); \
    if ((++_sp & 255u) == 0u) { if (xb_ld(&(bar)[XB_TMO])) break; if (_sp > XB_SPIN_CAP) { atomicAdd(&(bar)[XB_TMO], 1u); break; } } } } while (0)

struct XcdBarrier {
    unsigned* bar; unsigned x;
    volatile LAS unsigned* st;
};

__device__ __forceinline__ XcdBarrier xcd_barrier_post(unsigned* bar, volatile LAS unsigned* st) {
    XcdBarrier b; b.bar = bar; b.x = xb_xcc_id(); b.st = st;
    if (threadIdx.x == 0) (void)xb_add(&bar[XB_XCNT(b.x)], 1u);
    return b;
}
__device__ __forceinline__ void xcd_barrier_complete(unsigned* bar, unsigned x, unsigned& nloc, unsigned& nx) {
    const unsigned G = gridDim.x * gridDim.y * gridDim.z;
    unsigned sum, cnt, mine, sp = 0u;
    for (;;) {
        sum = 0u; cnt = 0u; mine = 0u;
#pragma unroll
        for (unsigned j = 0; j < 16; ++j) { const unsigned c = xb_ld(&bar[XB_XCNT(j)]); sum += c; cnt += (c > 0u) ? 1u : 0u; mine = (j == x) ? c : mine; }
        if (sum == G) break;
        __builtin_amdgcn_s_sleep(1);
        if ((++sp & 255u) == 0u) { if (xb_ld(&bar[XB_TMO])) break; if (sp > XB_SPIN_CAP) { atomicAdd(&bar[XB_TMO], 1u); break; } }
    }
    nloc = mine > 0u ? mine : 1u; nx = cnt > 0u ? cnt : 1u;
}

__device__ __forceinline__ void xcd_barrier(const XcdBarrier& b) {
    asm volatile("s_waitcnt vmcnt(0)" ::: "memory");
    __syncthreads();
    if (threadIdx.x == 0) {
        unsigned* bar = b.bar;
        __builtin_amdgcn_s_waitcnt(0);
        unsigned nloc = b.st[0], nx = b.st[1];
        if (nloc == 0u) { xcd_barrier_complete(bar, b.x, nloc, nx); b.st[0] = nloc; b.st[1] = nx; }
        const unsigned old = xb_add(&bar[XB_XSUB(b.x)], 1u);
        const unsigned gen = old / nloc;
        if (old + 1u == (gen + 1u) * nloc) {
            __builtin_amdgcn_fence(__ATOMIC_RELEASE, "agent");
            asm volatile("s_waitcnt vmcnt(0)" ::: "memory");
            const unsigned og = xb_add(&bar[XB_TOP], 1u);
            const unsigned tg = og / nx;
            if (og + 1u == (tg + 1u) * nx) xb_add(&bar[XB_TOPGEN], 1u);
            else XB_SPIN(xb_ld(&bar[XB_TOPGEN]) == tg, bar);
            __builtin_amdgcn_fence(__ATOMIC_ACQUIRE, "agent");
            xb_add(&bar[XB_XGEN(b.x)], 1u);
            asm volatile("s_waitcnt vmcnt(0)" ::: "memory");
        } else {
            XB_SPIN(xb_ld(&bar[XB_XGEN(b.x)]) == gen, bar);
            __builtin_amdgcn_fence(__ATOMIC_ACQUIRE, "agent");
            asm volatile("s_waitcnt vmcnt(0)" ::: "memory");
        }
    }
    __syncthreads();
}

__device__ __forceinline__ void mlstm_naive(const Frame& F, LAS unsigned char* lds) {
    LAS float* qs = (LAS float*)lds; LAS float* ks = qs + 64; LAS float* part = ks + 64; LAS float* red = part + 512;
    const int tid = F.tid, e = tid & 127, qd = tid >> 7;
    for (int unit = blockIdx.x; unit < NB * 4; unit += gridDim.x) {
        const int b = unit >> 2, h = unit & 3;
        float C[16]; float n_d = 0.f, m = 0.f;
#pragma unroll
        for (int i = 0; i < 16; ++i) C[i] = 0.f;
        const float ib = F.i_bias[h], fb = F.f_bias[h];
        for (int t = 0; t < S; ++t) {
            const size_t row = (size_t)b * S + t;
            if (tid < 128) {
                const int cc = (tid < 64) ? (h * 64 + tid) : (256 + h * 64 + (tid - 64));
                float a = F.conv_b[cc];
#pragma unroll
                for (int j = 0; j < 4; ++j) { const int tt = t - 3 + j; if (tt >= 0) a += F.conv_w[j * 512 + cc] * (float)F.Z[(row - 3 + j) * ZP + cc]; }
                float v = a * sigmoidf_(a);
                if (tid < 64) qs[tid] = v * 0.125f; else ks[tid - 64] = v;
            }
            const float ig = F.GATES[row * 16 + h] + ib, fp = F.GATES[row * 16 + 4 + h] + fb;
            const float logf = fminf(fp, 0.f) - log1pf(__expf(-fabsf(fp)));
            const float m_new = fmaxf(logf + m, ig), fs = __expf(logf + m - m_new), is = __expf(ig - m_new); m = m_new;
            __syncthreads();
            const float ve = (float)F.Z[row * ZP + ZC_MV + h * 128 + e];
            float pn = 0.f;
#pragma unroll
            for (int i = 0; i < 16; ++i) { const int d = qd * 16 + i; C[i] = fs * C[i] + is * ks[d] * ve; pn += qs[d] * C[i]; }
            part[qd * 128 + e] = pn;
            if (tid < 64) { n_d = fs * n_d + is * ks[tid]; const float dn = wave_sum(qs[tid] * n_d); if (tid == 0) red[0] = dn; }
            __syncthreads();
            float hv = 0.f;
            if (tid < 128) {
                const float num = (part[e] + part[128 + e]) + (part[256 + e] + part[384 + e]), den = red[0];
                hv = num / fmaxf(fabsf(den), __expf(-m));
                const float sq = wave_sum(hv * hv); if (F.lane == 0) red[1 + F.wave] = sq;
            }
            __syncthreads();
            if (tid < 128) {
                const float r = 1.f / sqrtf((red[1] + red[2]) * (1.f / 128.f) + EPS);
                const float og = (float)F.Z[row * ZP + ZC_MO + h * 128 + e];
                F.MIX[row * D + h * 128 + e] = (h16)(hv * r * F.mlstm_norm[h * 128 + e] * sigmoidf_(og));
            }
        }
        __syncthreads();
    }
}

constexpr int LQ = 72;
constexpr int LW = 136;
typedef _Float16 h16x4 __attribute__((ext_vector_type(4)));

__device__ __forceinline__ void conv_silu8(const Frame& F, size_t row, int t, int cb, float (&o)[8]) {
#pragma unroll
    for (int i = 0; i < 8; ++i) o[i] = F.conv_b[cb + i];
#pragma unroll
    for (int j = 0; j < 4; ++j) {
        if (t - 3 + j >= 0) {
            const h16x8 z = *(const h16x8*)(F.Z + (row - 3 + j) * ZP + cb);
#pragma unroll
            for (int i = 0; i < 8; ++i) o[i] += F.conv_w[j * 512 + cb + i] * (float)z[i];
        }
    }
#pragma unroll
    for (int i = 0; i < 8; ++i) o[i] = o[i] * sigmoidf_(o[i]);
}
__device__ __forceinline__ float wave_scan_add(float x, int lane) {
#pragma unroll
    for (int o = 1; o < 64; o <<= 1) { const float v = __shfl_up(x, o); if (lane >= o) x += v; }
    return x;
}
__device__ __forceinline__ float wave_scan_max(float x, int lane) {
#pragma unroll
    for (int o = 1; o < 64; o <<= 1) { const float v = __shfl_up(x, o); if (lane >= o) x = fmaxf(x, v); }
    return x;
}

__device__ __forceinline__ void mlstm_A(const Frame& F, LAS unsigned char* lds) {
    LAS h16* KT = (LAS h16*)lds;
    LAS h16* VT = KT + 64 * LQ;
    LAS float* wg = (LAS float*)(VT + 128 * LQ);
    const int tid = F.tid, lane = F.lane, w = F.wave, fr = lane & 15, fq = lane >> 4;
    for (int u = blockIdx.x; u < NB * 4 * 64; u += gridDim.x) {
        const int c = u & 63, h = (u >> 6) & 3, b = u >> 8; const size_t row0 = (size_t)b * S + c * 64;
        if (w == 0) {
            const float ig = F.GATES[(row0 + lane) * 16 + h] + F.i_bias[h], fp = F.GATES[(row0 + lane) * 16 + 4 + h] + F.f_bias[h];
            const float logf = fminf(fp, 0.f) - log1pf(__expf(-fabsf(fp)));
            const float bl = wave_scan_add(logf, lane), g = __shfl(bl, 63);
            const float a = g - bl + ig, ml = wave_max(a);
            wg[lane] = __expf(a - ml);
            if (lane == 0) { F.G[u] = g; F.MLOC[u] = ml; }
        }
        __syncthreads();
        { const int l = tid >> 3, c8 = (tid & 7) * 8; float o[8]; conv_silu8(F, row0 + l, c * 64 + l, ZC_MK + h * 64 + c8, o);
#pragma unroll
          for (int i = 0; i < 8; ++i) KT[(c8 + i) * LQ + l] = (h16)o[i]; }
#pragma unroll
        for (int j = 0; j < 2; ++j) { const int id = tid + 512 * j, l = id >> 4, e8 = (id & 15) * 8; const float wl = wg[l];
            const h16x8 v = *(const h16x8*)(F.Z + (row0 + l) * ZP + ZC_MV + h * 128 + e8);
#pragma unroll
            for (int i = 0; i < 8; ++i) VT[(e8 + i) * LQ + l] = (h16)((float)v[i] * wl); }
        __syncthreads();
        f32x4 acc[4];
#pragma unroll
        for (int db = 0; db < 4; ++db) acc[db] = (f32x4){0.f, 0.f, 0.f, 0.f};
#pragma unroll
        for (int ks = 0; ks < 2; ++ks) {
            const h16x8 a = *(const LAS h16x8*)(VT + (16 * w + fr) * LQ + 32 * ks + 8 * fq);
#pragma unroll
            for (int db = 0; db < 4; ++db) { const h16x8 bb = *(const LAS h16x8*)(KT + (16 * db + fr) * LQ + 32 * ks + 8 * fq);
                acc[db] = __builtin_amdgcn_mfma_f32_16x16x32_f16(a, bb, acc[db], 0, 0, 0); }
        }
        float* kvt = F.KVT + (size_t)u * 8192;
#pragma unroll
        for (int db = 0; db < 4; ++db)
#pragma unroll
            for (int i = 0; i < 4; ++i) kvt[(16 * w + 4 * fq + i) * 64 + 16 * db + fr] = acc[db][i];
        if (tid < 64) { float s = 0.f; for (int l = 0; l < 64; ++l) s += wg[l] * (float)KT[tid * LQ + l]; F.KS[(size_t)u * 64 + tid] = s; }
        __syncthreads();
    }
}

__device__ __forceinline__ void mlstm_B(const Frame& F) {
    typedef float f32x2 __attribute__((ext_vector_type(2)));
    const int tid = F.tid;
    for (int slot = blockIdx.x; slot < 256; slot += gridDim.x) {
        const int bh = slot >> 3, part = slot & 7; const int idx = part * 1024 + tid * 2;
        float* base = F.KVT + (size_t)bh * 64 * 8192 + idx;
        const bool do_n = (part == 0 && tid < 64);
        f32x2 st = (f32x2){0.f, 0.f}; float nst = 0.f, m = 0.f;
        for (int c0 = 0; c0 < 64; c0 += 8) {
            f32x2 kv[8]; float ksv[8];
#pragma unroll
            for (int j = 0; j < 8; ++j) { kv[j] = *(const f32x2*)(base + (size_t)(c0 + j) * 8192); ksv[j] = do_n ? F.KS[(size_t)(bh * 64 + c0 + j) * 64 + tid] : 0.f; }
#pragma unroll
            for (int j = 0; j < 8; ++j) {
                const int u = bh * 64 + c0 + j; const float g = F.G[u], ml = F.MLOC[u];
                *(f32x2*)(base + (size_t)(c0 + j) * 8192) = st;
                if (do_n) F.KS[(size_t)u * 64 + tid] = nst;
                if (part == 0 && tid == 0) F.MPREV[u] = m;
                const float mn = fmaxf(g + m, ml), dec = __expf(g + m - mn), sc = __expf(ml - mn);
                st = dec * st + sc * kv[j]; nst = dec * nst + sc * ksv[j]; m = mn;
            }
        }
    }
}

struct MlstmCIn { h16x8 zq[4], zk[4], vv[2], og[2]; f32x4 cp[4]; float g_ig, g_fp, nbv; };
__device__ __forceinline__ void mlstm_C_load(const Frame& F, int u, int tid, MlstmCIn& I) {
    const int c = u & 63, h = (u >> 6) & 3, b = u >> 8; const size_t row0 = (size_t)b * S + c * 64;
    { const int l = tid >> 3, c8 = (tid & 7) * 8, t = c * 64 + l; const h16x8 z0 = (h16x8){0, 0, 0, 0, 0, 0, 0, 0};
#pragma unroll
      for (int j = 0; j < 4; ++j) { const bool ok = (t - 3 + j >= 0); const h16* zp = F.Z + (row0 + l - 3 + j) * ZP + h * 64 + c8;
          I.zq[j] = ok ? *(const h16x8*)(zp + ZC_MQ) : z0; I.zk[j] = ok ? *(const h16x8*)(zp + ZC_MK) : z0; } }
#pragma unroll
    for (int j = 0; j < 2; ++j) { const int id = tid + 512 * j;
        { const int l = id >> 4, e8 = (id & 15) * 8; I.vv[j] = *(const h16x8*)(F.Z + (row0 + l) * ZP + ZC_MV + h * 128 + e8); }
        { const int e = id >> 3, d8 = (id & 7) * 8; const float* cp = F.KVT + (size_t)u * 8192 + e * 64 + d8; I.cp[2 * j] = *(const f32x4*)cp; I.cp[2 * j + 1] = *(const f32x4*)(cp + 4); } }
    { const int l = tid >> 3, e16 = (tid & 7) * 16; const h16* op = F.Z + (row0 + l) * ZP + ZC_MO + h * 128 + e16; I.og[0] = *(const h16x8*)op; I.og[1] = *(const h16x8*)(op + 8); }
    const int lane = tid & 63;
    I.g_ig = F.GATES[(row0 + lane) * 16 + h]; I.g_fp = F.GATES[(row0 + lane) * 16 + 4 + h];
    I.nbv = F.KS[(size_t)u * 64 + lane];
}
template <int VAR> __device__ __forceinline__ void mlstm_C(const Frame& F, LAS unsigned char* lds, h16* OUT) {
    LAS h16* Qs = (LAS h16*)lds;
    LAS h16* Ks = Qs + 64 * LQ;
    LAS h16* QS = Ks + 64 * LQ;
    LAS h16* BT = QS + 64 * LW;
    LAS float* fa = (LAS float*)(BT + 128 * LW);
    LAS float *ul = fa, *wl = fa + 64, *iw = fa + 128, *emt = fa + 192, *den = fa + 256, *nb = fa + 320, *rowsq = fa + 384;
    const int tid = F.tid, lane = F.lane, w = F.wave, fr = lane & 15, fq = lane >> 4;
    constexpr int NU = NB * 4 * 64;
    MlstmCIn I;
    if ((int)blockIdx.x < NU) mlstm_C_load(F, blockIdx.x, tid, I);
    for (int u = blockIdx.x; u < NU; u += gridDim.x) {
        const int c = u & 63, h = (u >> 6) & 3, b = u >> 8; const size_t row0 = (size_t)b * S + c * 64;
        if (w == 0) {
            const float ig = I.g_ig + F.i_bias[h], fp = I.g_fp + F.f_bias[h];
            const float logf = fminf(fp, 0.f) - log1pf(__expf(-fabsf(fp)));
            const float bl = wave_scan_add(logf, lane), ww = ig - bl, pm = wave_scan_max(ww, lane);
            const float il = bl + F.MPREV[u], mt = fmaxf(il, bl + pm);
            ul[lane] = bl - mt; wl[lane] = ww; iw[lane] = __expf(il - mt); emt[lane] = __expf(-mt); nb[lane] = I.nbv;
        }
        {
            const int l = tid >> 3, c8 = (tid & 7) * 8; float oq[8], ok_[8];
#pragma unroll
            for (int i = 0; i < 8; ++i) { oq[i] = F.conv_b[ZC_MQ + h * 64 + c8 + i]; ok_[i] = F.conv_b[ZC_MK + h * 64 + c8 + i]; }
#pragma unroll
            for (int j = 0; j < 4; ++j)
#pragma unroll
                for (int i = 0; i < 8; ++i) { oq[i] += F.conv_w[j * 512 + ZC_MQ + h * 64 + c8 + i] * (float)I.zq[j][i]; ok_[i] += F.conv_w[j * 512 + ZC_MK + h * 64 + c8 + i] * (float)I.zk[j][i]; }
            h16x8 hq, hk;
#pragma unroll
            for (int i = 0; i < 8; ++i) { hq[i] = (h16)(oq[i] * sigmoidf_(oq[i]) * 0.125f); hk[i] = (h16)(ok_[i] * sigmoidf_(ok_[i])); }
            *(LAS h16x8*)(Qs + l * LQ + c8) = hq; *(LAS h16x8*)(Ks + l * LQ + c8) = hk;
        }
#pragma unroll
        for (int j = 0; j < 2; ++j) { const int id = tid + 512 * j;
            { const int l = id >> 4, e8 = (id & 15) * 8;
#pragma unroll
              for (int i = 0; i < 8; ++i) BT[(e8 + i) * LW + 64 + l] = I.vv[j][i]; }
            { const int e = id >> 3, d8 = (id & 7) * 8; const f32x4 c0 = I.cp[2 * j], c1 = I.cp[2 * j + 1];
              h16x8 hv; hv[0] = (h16)c0[0]; hv[1] = (h16)c0[1]; hv[2] = (h16)c0[2]; hv[3] = (h16)c0[3]; hv[4] = (h16)c1[0]; hv[5] = (h16)c1[1]; hv[6] = (h16)c1[2]; hv[7] = (h16)c1[3];
              *(LAS h16x8*)(BT + e * LW + d8) = hv; } }
        const h16x8 og0 = I.og[0], og1 = I.og[1];
        { const int un = u + gridDim.x; if (un < NU) mlstm_C_load(F, un, tid, I); }
        __syncthreads();
        { const int l = tid >> 3, c8 = (tid & 7) * 8; const h16x8 q = *(const LAS h16x8*)(Qs + l * LQ + c8); const float s = iw[l]; h16x8 hv;
#pragma unroll
          for (int i = 0; i < 8; ++i) hv[i] = (h16)((float)q[i] * s);
          *(LAS h16x8*)(QS + l * LW + c8) = hv; }
#pragma unroll
        for (int tt = 0; tt < 2; ++tt) {
            const int lb = w & 3, sb = 2 * (w >> 2) + tt;
            f32x4 acc = (f32x4){0.f, 0.f, 0.f, 0.f};
            if (sb <= lb) {
#pragma unroll
                for (int ks = 0; ks < 2; ++ks) { const h16x8 a = *(const LAS h16x8*)(Qs + (16 * lb + fr) * LQ + 32 * ks + 8 * fq), bb = *(const LAS h16x8*)(Ks + (16 * sb + fr) * LQ + 32 * ks + 8 * fq);
                    acc = __builtin_amdgcn_mfma_f32_16x16x32_f16(a, bb, acc, 0, 0, 0); }
            }
            const int s = 16 * sb + fr; const float ws = wl[s];
#pragma unroll
            for (int i = 0; i < 4; ++i) { const int l = 16 * lb + 4 * fq + i; const float v = (s <= l) ? acc[i] * __expf(ul[l] + ws) : 0.f; QS[l * LW + 64 + s] = (h16)v; }
        }
        __syncthreads();
        { const int l = tid >> 3, part = tid & 7; float s = 0.f;
#pragma unroll
          for (int j = 0; j < 2; ++j) { const h16x8 q = *(const LAS h16x8*)(QS + l * LW + 16 * part + 8 * j);
#pragma unroll
              for (int i = 0; i < 8; ++i) { const int k = 16 * part + 8 * j + i; s += (float)q[i] * (k < 64 ? nb[k] : 1.f); } }
          s += __shfl_xor(s, 1); s += __shfl_xor(s, 2); s += __shfl_xor(s, 4);
          if (part == 0) den[l] = s; }
        f32x4 acc[4];
#pragma unroll
        for (int lb = 0; lb < 4; ++lb) acc[lb] = (f32x4){0.f, 0.f, 0.f, 0.f};
#pragma unroll
        for (int ks = 0; ks < 4; ++ks) { const h16x8 bb = *(const LAS h16x8*)(BT + (16 * w + fr) * LW + 32 * ks + 8 * fq);
#pragma unroll
            for (int lb = 0; lb < 4; ++lb) { const h16x8 a = *(const LAS h16x8*)(QS + (16 * lb + fr) * LW + 32 * ks + 8 * fq);
                acc[lb] = __builtin_amdgcn_mfma_f32_16x16x32_f16(a, bb, acc[lb], 0, 0, 0); } }
        __syncthreads();
#pragma unroll
        for (int lb = 0; lb < 4; ++lb)
#pragma unroll
            for (int i = 0; i < 4; ++i) { const int l = 16 * lb + 4 * fq + i; const float hv = acc[lb][i] / fmaxf(fabsf(den[l]), emt[l]); acc[lb][i] = hv;
                float sq = hv * hv; sq += __shfl_xor(sq, 1); sq += __shfl_xor(sq, 2); sq += __shfl_xor(sq, 4); sq += __shfl_xor(sq, 8);
                if (fr == 0) rowsq[w * 64 + l] = sq; }
        __syncthreads();
        {
            const int e = 16 * w + fr; const float gn = F.mlstm_norm[h * 128 + e];
#pragma unroll
            for (int lb = 0; lb < 4; ++lb)
#pragma unroll
                for (int i = 0; i < 4; ++i) { const int l = 16 * lb + 4 * fq + i; float tot = 0.f;
#pragma unroll
                    for (int ww = 0; ww < 8; ++ww) tot += rowsq[ww * 64 + l];
                    BT[l * LW + e] = (h16)(acc[lb][i] * (1.f / sqrtf(tot * (1.f / 128.f) + EPS)) * gn); }
        }
        __syncthreads();
        {
            const int l = tid >> 3, e16 = (tid & 7) * 16; const h16x8 t0 = *(const LAS h16x8*)(BT + l * LW + e16), t1 = *(const LAS h16x8*)(BT + l * LW + e16 + 8); h16x8 o0, o1;
#pragma unroll
            for (int i = 0; i < 8; ++i) { o0[i] = (h16)((float)t0[i] * sigmoidf_((float)og0[i])); o1[i] = (h16)((float)t1[i] * sigmoidf_((float)og1[i])); }
            h16* op = OUT + (row0 + l) * D + h * 128 + e16; *(h16x8*)op = o0; *(h16x8*)(op + 8) = o1;
        }
        __syncthreads();
    }
}

__device__ __forceinline__ void kn_phase(const Frame& F) {
    const int gw = blockIdx.x * 8 + F.wave, NGW = gridDim.x * 8;
    const float g = F.idx_k_norm[F.lane];
    for (int m = gw; m < T; m += NGW) {
        const float v = (float)F.Z[(size_t)m * ZP + ZC_IK + F.lane];
        const float r = 1.f / sqrtf(wave_sum(v * v) * (1.f / 64.f) + EPS);
        { const int s = m & (S - 1), d = F.lane;
          F.KN[(size_t)(m - s) * 64 + ((((size_t)(s >> 5) * 4 + (d >> 4)) * 2 + ((d >> 3) & 1)) * 32 + (s & 31)) * 8 + (d & 7)] = (h16)(v * r * g); }
    }
}

__device__ __forceinline__ unsigned ord_key(float f) { const unsigned u = __float_as_uint(f); return (u & 0x80000000u) ? ~u : (u | 0x80000000u); }

__device__ __forceinline__ void index_naive(const Frame& F, LAS unsigned char* lds) {
    LAS float* qf = (LAS float*)lds;
    LAS float* wq = qf + 512;
    LAS unsigned* cnt = (LAS unsigned*)(wq + 8);
    LAS unsigned* keys = cnt + 40;
    const int tid = F.tid;
    for (int row = blockIdx.x; row < T; row += gridDim.x) {
        const int t = row & (S - 1), b = row >> 12;
        __syncthreads();
        qf[tid] = (float)F.Z[(size_t)row * ZP + ZC_IQ + tid];
        if (tid < 8) wq[tid] = F.GATES[(size_t)row * 16 + 8 + tid] * 0.35355339059327373f;
        if (tid < 40) cnt[tid] = 0u;
        __syncthreads();
        unsigned kk[8];
#pragma unroll
        for (int j = 0; j < 8; ++j) {
            const int s = tid + 512 * j; kk[j] = 0u;
            if (s <= t) {
                const h16* kr = F.KN + ((size_t)b * S + s) * 64;
                float kf[64];
#pragma unroll
                for (int c = 0; c < 8; ++c) { const h16x8 v = *(const h16x8*)(kr + 8 * c);
#pragma unroll
                    for (int i = 0; i < 8; ++i) kf[8 * c + i] = (float)v[i]; }
                float score = 0.f;
#pragma unroll
                for (int hh = 0; hh < 8; ++hh) { float dot = 0.f;
#pragma unroll
                    for (int d = 0; d < 64; ++d) dot += qf[hh * 64 + d] * kf[d];
                    score += fmaxf(dot * 0.125f, 0.f) * wq[hh]; }
                kk[j] = ord_key(score); keys[s] = kk[j];
            }
        }
        unsigned vstar = 0u;
        if (t >= TOPK) {
            unsigned prefix = 0u;
            for (int bit = 31; bit >= 0; --bit) {
                const unsigned cand = prefix | (1u << bit); int c = 0;
#pragma unroll
                for (int j = 0; j < 8; ++j) c += (kk[j] >= cand) ? 1 : 0;
                c = wave_isum(c); if (F.lane == 0) atomicAdd((unsigned*)&cnt[bit], (unsigned)c);
                __syncthreads();
                if (cnt[bit] >= (unsigned)TOPK) prefix = cand;
            }
            vstar = prefix;
            int cg = 0, ce = 0;
#pragma unroll
            for (int j = 0; j < 8; ++j) { cg += (kk[j] > vstar) ? 1 : 0; ce += (kk[j] == vstar) ? 1 : 0; }
            cg = wave_isum(cg); ce = wave_isum(ce);
            if (F.lane == 0) { atomicAdd((unsigned*)&cnt[32], (unsigned)cg); atomicAdd((unsigned*)&cnt[33], (unsigned)ce); }
            __syncthreads();
            const int need = TOPK - (int)cnt[32];
            if ((int)cnt[33] > need) {
                if (tid == 0) { int nd = need; for (int s = 0; s <= t; ++s) if (keys[s] == vstar) { if (nd > 0) --nd; else keys[s] = 0u; } }
            }
        }
        __syncthreads();
        if (tid < 128) {
            unsigned word = 0u;
            for (int i = 0; i < 32; ++i) { const int s = 32 * tid + i; if (s <= t && keys[s] >= vstar) word |= (1u << i); }
            F.BM[(size_t)row * 128 + tid] = word;
        }
    }
}

typedef float f32x16 __attribute__((ext_vector_type(16)));
__device__ __forceinline__ size_t bm_index(int b, int t, int kt) { return ((((size_t)(b * 128 + (t >> 5)) * 64 + kt) * 32) + (t & 31)) * 2; }

__device__ __forceinline__ int wave_scan_dpp(int v, int& tot) {
    v += __builtin_amdgcn_update_dpp(0, v, 0x111, 0xF, 0xF, false);
    v += __builtin_amdgcn_update_dpp(0, v, 0x112, 0xF, 0xF, false);
    v += __builtin_amdgcn_update_dpp(0, v, 0x114, 0xF, 0xF, false);
    v += __builtin_amdgcn_update_dpp(0, v, 0x118, 0xF, 0xF, false);
    v += __builtin_amdgcn_update_dpp(0, v, 0x142, 0xA, 0xF, false);
    v += __builtin_amdgcn_update_dpp(0, v, 0x143, 0xC, 0xF, false);
    tot = __builtin_amdgcn_readlane(v, 63);
    return v;
}
template <int NR> __device__ __forceinline__ unsigned kth_largest_pl(const unsigned (&r)[NR], int K, int lowbit) {
    unsigned prefix = 0u;
    for (int bit = 31; bit >= lowbit; --bit) {
        const unsigned cand = prefix | (1u << bit); int c = 0;
#pragma unroll
        for (int j = 0; j < NR; ++j) c += (r[j] >= cand) ? 1 : 0;
        int tot; (void)wave_scan_dpp(c, tot);
        if (tot >= K) prefix = cand;
    }
    return prefix;
}
__device__ __forceinline__ int count_ge_row(const LAS unsigned* kr, int nj, int lane, unsigned thr) {
    int c = 0;
#pragma unroll 8
    for (int j = 0; j < nj; ++j) c += (kr[64 * j + lane] >= thr) ? 1 : 0;
    return c;
}
constexpr int IDX_CAND_OFF = 131072 + 1024, IDX_CAND = 768;
template <int VAR> __device__ __forceinline__ void index_mfma(const Frame& F, LAS unsigned char* lds) {
    LAS unsigned* keys = (LAS unsigned*)lds;
    const int lane = F.lane, w = F.wave, c32 = lane & 31, hi = lane >> 5;
    const int qa = 2 * ((c32 >> 2) & 1) + ((((c32 & 3) + 4 * (c32 >> 3))) >> 3), ha = ((c32 & 3) + 4 * (c32 >> 3)) & 7;
#define IDX_LOAD_AW(U) do { const int b_ = (U) & 7, t0_ = 8 * ((U) >> 3); const size_t rb_ = (size_t)b_ * S; \
        _Pragma("unroll") for (int blk = 0; blk < 2; ++blk) { \
            _Pragma("unroll") for (int ks = 0; ks < 4; ++ks) a[blk][ks] = *(const h16x8*)(F.Z + (rb_ + t0_ + 4 * blk + qa) * ZP + ZC_IQ + ha * 64 + 16 * ks + 8 * hi); \
            _Pragma("unroll") for (int qq = 0; qq < 2; ++qq) { const float* gp = F.GATES + (rb_ + t0_ + 4 * blk + 2 * hi + qq) * 16 + 8; const f32x4 g0 = *(const f32x4*)gp, g1 = *(const f32x4*)(gp + 4); \
                _Pragma("unroll") for (int i = 0; i < 4; ++i) { wv[blk][qq * 8 + i] = g0[i] * (0.125f * 0.35355339059327373f); wv[blk][qq * 8 + 4 + i] = g1[i] * (0.125f * 0.35355339059327373f); } } } } while (0)
#define IDX_LOAD_B(BF, KP0, TILE0, NTILE) do { _Pragma("unroll") for (int k2 = 0; k2 < 2; ++k2) { if (VAR != 4 && VAR != 5 && (TILE0) + 8 * k2 < (NTILE)) { \
            _Pragma("unroll") for (int ks = 0; ks < 4; ++ks) BF[k2][ks] = *(const h16x8*)((KP0) + (size_t)((TILE0) + 8 * k2) * 2048 + 512 * ks); } } } while (0)
#define IDX_COMPUTE_B(BF, TILE0) do { _Pragma("unroll") for (int k2 = 0; k2 < 2; ++k2) { const int tile = (TILE0) + 8 * k2; if (VAR != 5 && tile < ntile) { const int s = 32 * tile + c32; \
            _Pragma("unroll") for (int blk = 0; blk < 2; ++blk) { f32x16 acc; \
                _Pragma("unroll") for (int i = 0; i < 16; ++i) acc[i] = 0.f; \
                if (VAR != 2) { _Pragma("unroll") for (int ks = 0; ks < 4; ++ks) acc = __builtin_amdgcn_mfma_f32_32x32x16_f16(a[blk][ks], BF[k2][ks], acc, 0, 0, 0); } else { asm volatile("" : "+v"(acc) : "v"(BF[k2][0]), "v"(BF[k2][1]), "v"(BF[k2][2]), "v"(BF[k2][3])); } \
                _Pragma("unroll") for (int qq = 0; qq < 2; ++qq) { float sc = 0.f; \
                    if (VAR != 3) { _Pragma("unroll") for (int hh = 0; hh < 8; ++hh) sc += __builtin_amdgcn_fmed3f(acc[qq * 8 + hh], 0.f, __builtin_inff()) * wv[blk][qq * 8 + hh]; } else { sc = acc[qq * 8] + acc[qq * 8 + 7]; } \
                    const int ql = 4 * blk + 2 * hi + qq; keys[ql * 4096 + s] = (s <= t0 + ql) ? ord_key(sc) : 0u; } } } } } while (0)
    h16x8 a[2][4]; float wv[2][16]; h16x8 bfA[2][4], bfB[2][4];
#pragma unroll
    for (int k2 = 0; k2 < 2; ++k2)
#pragma unroll
        for (int ks = 0; ks < 4; ++ks) { bfA[k2][ks] = (h16x8){0, 0, 0, 0, 0, 0, 0, 0}; bfB[k2][ks] = bfA[k2][ks]; }
    if ((int)blockIdx.x < NB * 512) {
        const int u0 = blockIdx.x; IDX_LOAD_AW(u0);
        const int nt0 = (8 * (u0 >> 3) + 7) / 32 + 1; const h16* kq = F.KN + (size_t)(u0 & 7) * S * 64 + (hi * 32 + c32) * 8; IDX_LOAD_B(bfA, kq, w, nt0);
    }
    for (int unit = blockIdx.x; unit < NB * 512; unit += gridDim.x) {
        const int b = unit & 7, qg = unit >> 3, t0 = 8 * qg; const size_t rowbase = (size_t)b * S;
        const int ntile = (t0 + 7) / 32 + 1, L = 32 * ntile;
        {
            const h16* kp0 = F.KN + rowbase * 64 + (hi * 32 + c32) * 8;
            for (int tb = w; tb < ntile; tb += 32) {
                IDX_LOAD_B(bfB, kp0, tb + 16, ntile);
                IDX_COMPUTE_B(bfA, tb);
                IDX_LOAD_B(bfA, kp0, tb + 32, ntile);
                IDX_COMPUTE_B(bfB, tb + 16);
            }
        }
        __syncthreads();
        {
            const int un = unit + gridDim.x;
            if (un < NB * 512) { IDX_LOAD_AW(un); const int ntn = (8 * (un >> 3) + 7) / 32 + 1; const h16* kq = F.KN + (size_t)(un & 7) * S * 64 + (hi * 32 + c32) * 8; IDX_LOAD_B(bfA, kq, w, ntn); }
        }
        if (VAR == 0) {
            const int t = t0 + w, nj = (L + 63) >> 6; LAS unsigned* kr = keys + w * 4096; LAS unsigned* cd = (LAS unsigned*)(lds + IDX_CAND_OFF) + w * IDX_CAND;
            if ((L & 32) && lane >= 32) kr[64 * (nj - 1) + lane] = 0u;
            __builtin_amdgcn_wave_barrier();
            unsigned vstar = 0u, thr = 1u; bool trim = false; int allowed = 0;
            if (t >= TOPK) {
                int cgt = 0, ceq = 0;
                if (nj <= 8) {
                    unsigned r8[8];
#pragma unroll
                    for (int i = 0; i < 8; ++i) r8[i] = (i < nj) ? kr[64 * i + lane] : 0u;
                    vstar = kth_largest_pl<8>(r8, TOPK, 0);
#pragma unroll
                    for (int i = 0; i < 8; ++i) { cgt += (r8[i] > vstar) ? 1 : 0; ceq += (r8[i] == vstar) ? 1 : 0; }
                } else {
                    unsigned sm[4];
#pragma unroll
                    for (int i = 0; i < 4; ++i) sm[i] = kr[64 * ((i * nj) >> 2) + lane];
                    const float E = 1024.f / (float)nj; const int m = (int)(E + 3.5f * sqrtf(E)) + 2;
                    unsigned tau = kth_largest_pl<4>(sm, m, 16);
                    int c = count_ge_row(kr, nj, lane, tau), tot; int incl = wave_scan_dpp(c, tot);
                    if (tot < TOPK) { tau = 0u; c = nj; tot = 64 * nj; incl = nj * (lane + 1); }
                    if (tot > IDX_CAND) {
                        const unsigned tau0 = tau; unsigned pre = 0u;
                        for (int bit = 31; bit >= 0; --bit) {
                            const unsigned cand = pre | (1u << bit);
                            if (cand <= tau0) { pre = cand; continue; }
                            const int c2 = count_ge_row(kr, nj, lane, cand); int tot2; const int incl2 = wave_scan_dpp(c2, tot2);
                            if (tot2 >= TOPK) { pre = cand; c = c2; tot = tot2; incl = incl2; if (tot <= IDX_CAND) break; }
                        }
                        tau = pre;
                    }
                    if (tot <= IDX_CAND) {
                        int pos = incl - c;
#pragma unroll 8
                        for (int j = 0; j < nj; ++j) { const unsigned k = kr[64 * j + lane]; if (k >= tau) { cd[pos] = k; ++pos; } }
                        __builtin_amdgcn_wave_barrier();
                        unsigned cc[12];
#pragma unroll
                        for (int i = 0; i < 12; ++i) { const int s = 64 * i + lane; cc[i] = (s < tot) ? cd[s] : 0u; }
                        vstar = kth_largest_pl<12>(cc, TOPK, 0);
#pragma unroll
                        for (int i = 0; i < 12; ++i) { cgt += (cc[i] > vstar) ? 1 : 0; ceq += (cc[i] == vstar) ? 1 : 0; }
                    } else {
                        vstar = tau;
                        for (int j = 0; j < nj; ++j) { const unsigned k = kr[64 * j + lane]; cgt += (k > vstar) ? 1 : 0; ceq += (k == vstar) ? 1 : 0; }
                    }
                }
                int cgt_t, ceq_t; (void)wave_scan_dpp(cgt, cgt_t); (void)wave_scan_dpp(ceq, ceq_t);
                allowed = TOPK - cgt_t; trim = ceq_t > allowed; thr = vstar;
            }
            typedef unsigned u32x2 __attribute__((ext_vector_type(2)));
            if (!trim) {
                int j = 0;
                for (; j + 4 <= nj; j += 4) {
                    const unsigned k0 = kr[64 * j + lane], k1 = kr[64 * j + 64 + lane], k2 = kr[64 * j + 128 + lane], k3 = kr[64 * j + 192 + lane];
                    const unsigned long long m0 = __ballot(k0 >= thr), m1 = __ballot(k1 >= thr), m2 = __ballot(k2 >= thr), m3 = __ballot(k3 >= thr);
                    if (lane < 4) { const unsigned long long mm = lane == 0 ? m0 : lane == 1 ? m1 : lane == 2 ? m2 : m3;
                        *(u32x2*)(F.BM + bm_index(b, t, j + lane)) = (u32x2){(unsigned)mm, (unsigned)(mm >> 32)}; }
                }
                for (; j < nj; ++j) {
                    const unsigned k = kr[64 * j + lane]; const unsigned long long m = __ballot(k >= thr);
                    if (lane == 0) *(u32x2*)(F.BM + bm_index(b, t, j)) = (u32x2){(unsigned)m, (unsigned)(m >> 32)};
                }
            } else {
                for (int j = 0; j < nj; ++j) {
                    const unsigned k = kr[64 * j + lane];
                    const unsigned long long gt = __ballot(k > vstar); unsigned long long eq = __ballot(k == vstar);
                    if (allowed <= 0) eq = 0ull;
                    else { while (__popcll(eq) > allowed) eq &= ~(1ull << (63 - __clzll(eq))); allowed -= __popcll(eq); }
                    const unsigned long long m = gt | eq;
                    if (lane == 0) *(u32x2*)(F.BM + bm_index(b, t, j)) = (u32x2){(unsigned)m, (unsigned)(m >> 32)};
                }
            }
            if (nj + lane < 64) *(u32x2*)(F.BM + bm_index(b, t, nj + lane)) = (u32x2){0u, 0u};
        }
        __syncthreads();
    }
}

__device__ __forceinline__ void attn_naive(const Frame& F, LAS unsigned char* lds) {
    LAS float* qf = (LAS float*)lds;
    LAS float* p = qf + 512;
    LAS int* sel = (LAS int*)(p + 2048);
    LAS int* pcs = sel + 288;
    LAS float* btab = (LAS float*)(pcs + 128);
    LAS int* nselp = (LAS int*)(btab + 1024);
    const int tid = F.tid, hh = F.wave, lane = F.lane;
    for (int i = tid; i < 1024; i += NTHR) {
        const int dist = i >> 3, h = i & 7; int bk;
        if (dist < 16) bk = dist; else { bk = 16 + (int)(log((double)dist / 16.0) / log(8.0) * 16.0); if (bk > 31) bk = 31; }
        btab[i] = F.rel_bias[bk * 8 + h];
    }
    for (int row = blockIdx.x; row < T; row += gridDim.x) {
        const int t = row & (S - 1), b = row >> 12;
        __syncthreads();
        unsigned word = 0u;
        if (tid < 128) { word = F.BM[bm_index(b, t, tid >> 1) + (tid & 1)]; pcs[tid] = __popc(word); }
        qf[tid] = (float)F.Z[(size_t)row * ZP + ZC_AQ + tid];
        __syncthreads();
        if (tid < 128) {
            int off = 0; for (int i = 0; i < tid; ++i) off += pcs[i];
            if (tid == 127) *nselp = off + pcs[127];
            while (word) { const int bpos = __ffs(word) - 1; word &= word - 1; if (off < 288) sel[off] = 32 * tid + bpos; ++off; }
        }
        __syncthreads();
        const int nsel = min(*nselp, 256);
        float lg[4]; float mx = -INFINITY;
#pragma unroll
        for (int jj = 0; jj < 4; ++jj) {
            const int j = lane + 64 * jj; lg[jj] = -INFINITY;
            if (j < nsel) {
                const int s = sel[j]; const h16* kr = F.Z + ((size_t)b * S + s) * ZP + ZC_AK + hh * 64;
                float dot = 0.f;
#pragma unroll
                for (int c = 0; c < 8; ++c) { const h16x8 v = *(const h16x8*)(kr + 8 * c);
#pragma unroll
                    for (int i = 0; i < 8; ++i) dot += qf[hh * 64 + 8 * c + i] * (float)v[i]; }
                const int dist = t - s;
                lg[jj] = dot * 0.125f + btab[(dist < 127 ? dist : 127) * 8 + hh];
                mx = fmaxf(mx, lg[jj]);
            }
        }
        mx = wave_max(mx);
        float sum = 0.f;
#pragma unroll
        for (int jj = 0; jj < 4; ++jj) { const int j = lane + 64 * jj; const float ev = (j < nsel) ? __expf(lg[jj] - mx) : 0.f; sum += ev; p[hh * 256 + j] = ev; }
        sum = wave_sum(sum);
        __syncthreads();
        float acc = 0.f;
        for (int j = 0; j < nsel; ++j) acc += p[hh * 256 + j] * (float)F.Z[((size_t)b * S + sel[j]) * ZP + ZC_AV + hh * 64 + lane];
        F.MIX[(size_t)row * D + 512 + hh * 64 + lane] = (h16)(acc / sum);
    }
}

typedef short v4i16_t __attribute__((ext_vector_type(4)));
__device__ __forceinline__ h16x4 vtr16(const LAS unsigned char* p) { return __builtin_bit_cast(h16x4, __builtin_amdgcn_ds_read_tr16_b64_v4i16((LAS v4i16_t*)p)); }
__device__ __forceinline__ float max3f(float a, float b, float c) { float r; asm("v_max3_f32 %0, %1, %2, %3" : "=v"(r) : "v"(a), "v"(b), "v"(c)); return r; }
constexpr float LOG2E = 1.4426950408889634f;
constexpr int AT_K = 0, AT_V = 16384, AT_BT = 32768, AT_WS = 36864;
template <int VAR> __device__ __forceinline__ void attn_dense(const Frame& F, LAS unsigned char* lds, h16* OUT) {
    const int tid = F.tid, lane = F.lane, w = F.wave, q = lane & 31, hi = lane >> 5;
    LAS float* btab = (LAS float*)(lds + AT_BT);
    LAS float* wsf = (LAS float*)(lds + AT_WS) + w * 64;
    for (int i = tid; i < 1024; i += NTHR) {
        const int dist = i >> 3, h = i & 7; int bk;
        if (dist < 16) bk = dist; else { bk = 16 + (int)(log((double)dist / 16.0) / log(8.0) * 16.0); if (bk > 31) bk = 31; }
        btab[i] = F.rel_bias[bk * 8 + h] * LOG2E;
    }
    __syncthreads();
    const float c2 = 0.125f * LOG2E, THR = 8.f;
    const int vb0 = ((lane >> 4) & 1) * 32 + (lane & 3) * 8 + (4 * hi + ((lane & 15) >> 2)) * 64;
    for (int vu = blockIdx.x; vu < 256; vu += gridDim.x)
    for (int rr = 0; rr < 4; ++rr) {
        const int bh = vu >> 2, jj = vu & 3, qb = rr == 0 ? jj : rr == 1 ? 7 - jj : rr == 2 ? 8 + jj : 15 - jj, b = bh >> 3, h = bh & 7;
        const size_t rowbase = (size_t)b * S; const int q0 = qb * 256 + 32 * w, t = q0 + q, NT = 4 * (qb + 1);
        h16x8 qf[4];
#pragma unroll
        for (int ks = 0; ks < 4; ++ks) qf[ks] = *(const h16x8*)(F.Z + (rowbase + t) * ZP + ZC_AQ + h * 64 + 16 * ks + 8 * hi);
        const h16* kg = F.Z + (rowbase + lane) * ZP + ZC_AK + h * 64 + 8 * w;
        const h16* vg = F.Z + (rowbase + 16 * (w & 3) + (lane >> 2)) * ZP + ZC_AV + h * 64 + (w >> 2) * 32 + (lane & 3) * 8;
        const int sdst = w * 1024 + lane * 16;
        const unsigned* bmp = F.BM + bm_index(b, t, 0);
        typedef unsigned u32x2 __attribute__((ext_vector_type(2)));
        { const u32x4 kr0 = *(const u32x4*)kg, vr0 = *(const u32x4*)vg; *(LAS u32x4*)(lds + AT_K + sdst) = kr0; *(LAS u32x4*)(lds + AT_V + sdst) = vr0; }
        u32x2 mw = *(const u32x2*)bmp, mwn = *(const u32x2*)(bmp + 64);
        u32x4 kr = *(const u32x4*)(kg + (size_t)64 * ZP), vr = *(const u32x4*)(vg + (size_t)64 * ZP);
        __syncthreads();
        float m_run = -1e30f, l_part = 0.f; f32x16 o[2];
#pragma unroll
        for (int i = 0; i < 16; ++i) { o[0][i] = 0.f; o[1][i] = 0.f; }
        for (int kt = 0; kt < NT; ++kt) {
            const int cur = kt & 1; const bool more = (kt + 1 < NT);
            u32x4 kr2 = kr, vr2 = vr; u32x2 mw2 = mwn;
            if (kt + 2 < NT) { kr2 = *(const u32x4*)(kg + (size_t)(kt + 2) * 64 * ZP); vr2 = *(const u32x4*)(vg + (size_t)(kt + 2) * 64 * ZP); mw2 = *(const u32x2*)(bmp + (size_t)(kt + 2) * 64); }
            if (64 * kt <= q0 + 31) {
                f32x16 p0, p1;
#pragma unroll
                for (int i = 0; i < 16; ++i) { p0[i] = 0.f; p1[i] = 0.f; }
                const LAS unsigned char* kb = lds + AT_K + cur * 8192 + hi * 1024 + q * 16;
                if (VAR != 3) {
#pragma unroll
                for (int d0 = 0; d0 < 4; ++d0) { const h16x8 b0 = *(const LAS h16x8*)(kb + d0 * 2048), b1 = *(const LAS h16x8*)(kb + d0 * 2048 + 512);
                    p0 = __builtin_amdgcn_mfma_f32_32x32x16_f16(b0, qf[d0], p0, 0, 0, 0); p1 = __builtin_amdgcn_mfma_f32_32x32x16_f16(b1, qf[d0], p1, 0, 0, 0); }
                } else { asm volatile("" : "+v"(p0), "+v"(p1)); }
                const bool far = (q0 - (64 * kt + 63) >= 127);
                float mx;
                if (far) {
                    float a0 = max3f(p0[0], p0[1], p1[0]), a1 = max3f(p0[2], p0[3], p1[1]); a0 = max3f(a0, p1[2], p1[3]);
#pragma unroll
                    for (int r = 4; r < 16; r += 4) { a0 = max3f(a0, p0[r], p0[r + 1]); a1 = max3f(a1, p0[r + 2], p0[r + 3]); a0 = max3f(a0, p1[r], p1[r + 1]); a1 = max3f(a1, p1[r + 2], p1[r + 3]); }
                    mx = fmaxf(a0, a1) * c2 + btab[127 * 8 + h];
                } else {
#pragma unroll
                    for (int r = 0; r < 16; ++r) { const int kv = 64 * kt + (r & 3) + 8 * (r >> 2) + 4 * hi; int d0_ = t - kv, d1_ = d0_ - 32;
                        d0_ = d0_ < 0 ? 0 : (d0_ > 127 ? 127 : d0_); d1_ = d1_ < 0 ? 0 : (d1_ > 127 ? 127 : d1_);
                        p0[r] = p0[r] * c2 + btab[d0_ * 8 + h]; p1[r] = p1[r] * c2 + btab[d1_ * 8 + h]; }
                    mx = fmaxf(p0[0], p1[0]);
#pragma unroll
                    for (int r = 1; r < 16; ++r) mx = fmaxf(mx, fmaxf(p0[r], p1[r]));
                }
                mx = fmaxf(mx, __shfl_xor(mx, 32));
                if (__ballot(mx > m_run + THR) != 0ull) {
                    const float mn = fmaxf(m_run, mx), alpha = __builtin_amdgcn_exp2f(m_run - mn); m_run = mn; l_part *= alpha;
                    __builtin_amdgcn_wave_barrier();
                    if (hi == 0) wsf[q] = alpha;
                    __builtin_amdgcn_wave_barrier();
#pragma unroll
                    for (int g = 0; g < 4; ++g) { const f32x4 av = *(const LAS f32x4*)(wsf + 8 * g + 4 * hi);
#pragma unroll
                        for (int i = 0; i < 4; ++i) { o[0][4 * g + i] *= av[i]; o[1][4 * g + i] *= av[i]; } }
                    __builtin_amdgcn_wave_barrier();
                }
                const float cs = far ? c2 : 1.f, cb_ = far ? (btab[127 * 8 + h] - m_run) : -m_run;
                const int w0s = (int)(mw.x >> (4 * hi)), w1s = (int)(mw.y >> (4 * hi));
#pragma unroll
                for (int r = 0; r < 16; ++r) { const int pos = (r & 3) + 8 * (r >> 2);
                    const float e0 = VAR == 1 ? (p0[r] * cs + cb_) : __builtin_amdgcn_exp2f(p0[r] * cs + cb_), e1 = VAR == 1 ? (p1[r] * cs + cb_) : __builtin_amdgcn_exp2f(p1[r] * cs + cb_);
                    int k0, k1; asm("v_bfe_i32 %0, %1, %2, 1" : "=v"(k0) : "v"(w0s), "n"(pos)); asm("v_bfe_i32 %0, %1, %2, 1" : "=v"(k1) : "v"(w1s), "n"(pos));
                    p0[r] = __uint_as_float(__float_as_uint(e0) & (unsigned)k0); p1[r] = __uint_as_float(__float_as_uint(e1) & (unsigned)k1); }
                h16x8 pa[4];
#pragma unroll
                for (int j = 0; j < 4; ++j) {
                    typedef __fp16 fp16x2 __attribute__((ext_vector_type(2)));
                    const fp16x2 c0 = __builtin_amdgcn_cvt_pkrtz(p0[2 * j], p0[2 * j + 1]), c1 = __builtin_amdgcn_cvt_pkrtz(p0[8 + 2 * j], p0[9 + 2 * j]), c2_ = __builtin_amdgcn_cvt_pkrtz(p1[2 * j], p1[2 * j + 1]), c3 = __builtin_amdgcn_cvt_pkrtz(p1[8 + 2 * j], p1[9 + 2 * j]);
                    pa[0][2 * j] = (h16)c0[0]; pa[0][2 * j + 1] = (h16)c0[1]; pa[1][2 * j] = (h16)c1[0]; pa[1][2 * j + 1] = (h16)c1[1]; pa[2][2 * j] = (h16)c2_[0]; pa[2][2 * j + 1] = (h16)c2_[1]; pa[3][2 * j] = (h16)c3[0]; pa[3][2 * j + 1] = (h16)c3[1]; }
                {
                    typedef _Float16 h16x2 __attribute__((ext_vector_type(2)));
                    const h16x2 one2 = (h16x2){(h16)1.f, (h16)1.f};
#pragma unroll
                    for (int ks = 0; ks < 4; ++ks)
#pragma unroll
                        for (int j = 0; j < 4; ++j) l_part = __builtin_amdgcn_fdot2((h16x2){pa[ks][2 * j], pa[ks][2 * j + 1]}, one2, l_part, false);
                }
                const LAS unsigned char* vb = lds + AT_V + cur * 8192 + vb0;
                if (VAR == 2) { asm volatile("" :: "v"(pa[0]), "v"(pa[1]), "v"(pa[2]), "v"(pa[3])); }
                else
                for (int d0 = 0; d0 < 2; ++d0)
#pragma unroll
                    for (int ks = 0; ks < 4; ++ks) { const h16x4 lo = vtr16(vb + d0 * 4096 + ks * 1024), hh = vtr16(vb + d0 * 4096 + ks * 1024 + 512);
                        h16x8 bv; bv[0] = lo[0]; bv[1] = lo[1]; bv[2] = lo[2]; bv[3] = lo[3]; bv[4] = hh[0]; bv[5] = hh[1]; bv[6] = hh[2]; bv[7] = hh[3];
                        o[d0] = __builtin_amdgcn_mfma_f32_32x32x16_f16(pa[ks], bv, o[d0], 0, 0, 0); }
            }
            if (more) { *(LAS u32x4*)(lds + AT_K + (cur ^ 1) * 8192 + sdst) = kr; *(LAS u32x4*)(lds + AT_V + (cur ^ 1) * 8192 + sdst) = vr; }
            kr = kr2; vr = vr2; mw = mwn; mwn = mw2;
            asm volatile("s_waitcnt lgkmcnt(0)" ::: "memory"); __builtin_amdgcn_s_barrier(); asm volatile("" ::: "memory");
        }
        const float lt = l_part + __shfl_xor(l_part, 32), inv = 1.f / lt;
        __builtin_amdgcn_wave_barrier();
        if (hi == 0) wsf[q] = inv;
        __builtin_amdgcn_wave_barrier();
#pragma unroll
        for (int g = 0; g < 4; ++g) { const f32x4 av = *(const LAS f32x4*)(wsf + 8 * g + 4 * hi);
#pragma unroll
            for (int i = 0; i < 4; ++i) { const int qq = 8 * g + 4 * hi + i; h16* op = OUT + (rowbase + q0 + qq) * D + 512 + h * 64 + q;
                op[0] = (h16)(o[0][4 * g + i] * av[i]); op[32] = (h16)(o[1][4 * g + i] * av[i]); } }
        __builtin_amdgcn_wave_barrier();
    }
}

__device__ __forceinline__ void h2_phase(const Frame& F) {
    const int gw = blockIdx.x * 8 + F.wave, NGW = gridDim.x * 8;
    for (int m = gw; m < T; m += NGW) rms_row_to_h16(F.out + (size_t)m * D, F.norm_ffn, F.XN + (size_t)m * D, F.lane);
}
__device__ __forceinline__ void act_phase(const Frame& F, int row_lo, int row_hi) {
    constexpr int NCG = DFF / 8;
    const int nitems = ((row_hi - row_lo) / 32) * NCG;
    for (int id = blockIdx.x * NTHR + F.tid; id < nitems; id += gridDim.x * NTHR) {
        const int cg = id % NCG, run = id / NCG, c = cg * 8, pc = 256 * (c >> 7) + (c & 127);
        float wgt[3][8], wvl[3][8], bg[8], bv[8];
#pragma unroll
        for (int j = 0; j < 3; ++j) {
#pragma unroll
            for (int q4 = 0; q4 < 2; ++q4) { const f32x4 a = *(const f32x4*)(F.ffn_conv_w + j * NUP + c + 4 * q4), bq = *(const f32x4*)(F.ffn_conv_w + j * NUP + DFF + c + 4 * q4);
#pragma unroll
                for (int i = 0; i < 4; ++i) { wgt[j][4 * q4 + i] = a[i]; wvl[j][4 * q4 + i] = bq[i]; } }
        }
#pragma unroll
        for (int q4 = 0; q4 < 2; ++q4) { const f32x4 a = *(const f32x4*)(F.ffn_conv_b + c + 4 * q4), bq = *(const f32x4*)(F.ffn_conv_b + DFF + c + 4 * q4);
#pragma unroll
            for (int i = 0; i < 4; ++i) { bg[4 * q4 + i] = a[i]; bv[4 * q4 + i] = bq[i]; } }
        const int r0 = run * 32, t0 = (row_lo + r0) & (S - 1);
        const h16* yb = F.Y + (size_t)r0 * NUP + pc;
        h16x8 g2, g1, v2, v1;
#pragma unroll
        for (int i = 0; i < 8; ++i) { g2[i] = (h16)0.f; g1[i] = (h16)0.f; v2[i] = (h16)0.f; v1[i] = (h16)0.f; }
        if (t0 != 0) { g2 = *(const h16x8*)(yb - 2 * (ptrdiff_t)NUP); v2 = *(const h16x8*)(yb - 2 * (ptrdiff_t)NUP + 128); g1 = *(const h16x8*)(yb - (ptrdiff_t)NUP); v1 = *(const h16x8*)(yb - (ptrdiff_t)NUP + 128); }
        h16* ob = F.ACT + (size_t)(row_lo + r0) * DFF + c;
#pragma unroll 4
        for (int rr = 0; rr < 32; ++rr) {
            const h16x8 g0 = *(const h16x8*)(yb + (size_t)rr * NUP), v0 = *(const h16x8*)(yb + (size_t)rr * NUP + 128);
            h16x8 o;
#pragma unroll
            for (int i = 0; i < 8; ++i) {
                const float ug = bg[i] + wgt[0][i] * (float)g2[i] + wgt[1][i] * (float)g1[i] + wgt[2][i] * (float)g0[i];
                const float uv = bv[i] + wvl[0][i] * (float)v2[i] + wvl[1][i] * (float)v1[i] + wvl[2][i] * (float)v0[i];
                o[i] = (h16)(ug * sigmoidf_(ug) * uv);
            }
            *(h16x8*)(ob + (size_t)rr * DFF) = o;
            g2 = g1; g1 = g0; v2 = v1; v1 = v0;
        }
    }
}
__device__ __forceinline__ void final_norm_phase(const Frame& F) {
    const int gw = blockIdx.x * 8 + F.wave, NGW = gridDim.x * 8;
    f32x4 g[4];
#pragma unroll
    for (int j = 0; j < 4; ++j) g[j] = *(const f32x4*)(F.norm_final + 4 * F.lane + 256 * j);
    for (int m = gw; m < T; m += NGW) {
        float* xr = F.out + (size_t)m * D; const float r = pg8::rstd16(F.SS2 + (size_t)m * 16);
#pragma unroll
        for (int j = 0; j < 4; ++j) { const f32x4 v = *(const f32x4*)(xr + 4 * F.lane + 256 * j); *(f32x4*)(xr + 4 * F.lane + 256 * j) = v * r * g[j]; }
    }
}

__device__ __forceinline__ void fresh_tid(Frame& F) { int t = threadIdx.x; asm volatile("" : "+v"(t)); F.tid = t; F.lane = t & 63; F.wave = __builtin_amdgcn_readfirstlane(t >> 6); }
#ifndef MK_N_LAUNCHES
#define MK_N_LAUNCHES 1
#endif
constexpr int N_PHASES = 11;
constexpr int RING_BYTES = 131072, MISC_OFF = RING_BYTES + 320, LDS_BYTES = 157696;
constexpr int CW_BAR = 4096;
constexpr size_t CTL_ZERO_BYTES = 64 * 1024;
__global__ void __launch_bounds__(NTHR, 2) mk_fwd(Args a) {
    extern __shared__ __attribute__((aligned(16))) unsigned char lds_raw[];
    LAS unsigned char* lds = (LAS unsigned char*)lds_raw;
    Frame F;
    F.x = a.in[0]; F.norm_mix = a.in[1]; F.w_in = a.in[2]; F.conv_w = a.in[3]; F.conv_b = a.in[4]; F.i_bias = a.in[5]; F.f_bias = a.in[6]; F.mlstm_norm = a.in[7];
    F.idx_k_norm = a.in[8]; F.rel_bias = a.in[9]; F.w_out = a.in[10]; F.norm_ffn = a.in[11]; F.w_up = a.in[12]; F.ffn_conv_w = a.in[13]; F.ffn_conv_b = a.in[14];
    F.w_down = a.in[15]; F.norm_final = a.in[16]; F.out = a.out;
    unsigned char* ws = a.ws;
    F.WIN = (h16*)(ws + WS_WIN); F.WOUT = (h16*)(ws + WS_WOUT); F.WUP = (h16*)(ws + WS_WUP); F.WDN = (h16*)(ws + WS_WDN);
    F.GATES = (float*)(ws + WS_GATES); F.XN = (h16*)(ws + WS_XN); F.Z = (h16*)(ws + WS_Z); F.MIX = (h16*)(ws + WS_MIX); F.KN = (h16*)(ws + WS_KN);
    F.BM = (unsigned*)(ws + WS_BM); F.KVT = (float*)(ws + WS_KVT); F.KS = (float*)(ws + WS_KS); F.G = (float*)(ws + WS_GML); F.MLOC = F.G + 2048; F.MPREV = F.G + 4096; F.SS = (float*)(ws + WS_SS); F.SS2 = (float*)(ws + WS_SS2); F.YH = (float*)(ws + WS_YH); F.RSTD = (float*)(ws + WS_YH + 6 * MiB); F.Y = (h16*)(ws + WS_Y); F.ACT = (h16*)(ws + WS_ACT);
    F.tid = threadIdx.x; F.lane = F.tid & 63; F.wave = __builtin_amdgcn_readfirstlane(F.tid >> 6);
    volatile LAS unsigned* MISC = (volatile LAS unsigned*)(lds + MISC_OFF);
    for (int u = F.tid; u < (LDS_BYTES - RING_BYTES) / 4; u += NTHR) ((LAS unsigned*)(lds + RING_BYTES))[u] = 0u;
    __syncthreads();
    XcdBarrier bar; bar.bar = (unsigned*)(ws + WS_CTL) + CW_BAR; bar.x = 0; bar.st = nullptr;
    if (MK_N_LAUNCHES == 1) bar = xcd_barrier_post((unsigned*)(ws + WS_CTL) + CW_BAR, MISC + 8);
    const int lo = a.ph_lo, hi = a.ph_hi, G = gridDim.x;
#define IN(k) (fresh_tid(F), lo <= (k) && (k) < hi)
#define SEAM(k) do { if (IN(k) && IN((k) + 1)) xcd_barrier(bar); } while (0)
#ifndef PROBE_DUP
#define PROBE_DUP 0
#endif
#define REP(k) for (int rep_ = 0; rep_ <= ((PROBE_DUP >> (k)) & 1); ++rep_)
    if (IN(0)) REP(0) p0_prologue(F, lds);
    SEAM(0);
    if (IN(1)) REP(1) { pg8::Gemm g{(const pg8::bf16_t*)F.XN, (const pg8::bf16_t*)F.WIN, T, ZP, D}; pg8::StaticOrder So; So.init(T, ZP, G, (int)blockIdx.x);
        pg8::EpiH16 E{F.Z, ZP, 0, F.GATES, ZC_G}; pg8::gemm_phase<pg8::EpiH16, pg8::StaticOrder, true, true>(lds, g, So, E); }
    SEAM(1);
    if (IN(2)) { kn_phase(F); REP(2) mlstm_A(F, lds); }
    SEAM(2);
    if (IN(3)) mlstm_B(F);
    SEAM(3);
    if (IN(4)) { mlstm_C<0>(F, lds, F.MIX);
#ifdef PROBE_MC
        mlstm_C<PROBE_MC>(F, lds, (h16*)F.BM);
#endif
        index_mfma<0>(F, lds);
#ifdef PROBE_IDX
        index_mfma<PROBE_IDX>(F, lds);
#endif
 }
    SEAM(4);
    if (IN(5)) { attn_dense<0>(F, lds, F.MIX);
#ifdef PROBE_ATT
        attn_dense<PROBE_ATT>(F, lds, (h16*)F.KVT);
#endif
    }
    SEAM(5);
    if (IN(6)) REP(6) { pg8::Gemm g{(const pg8::bf16_t*)F.MIX, (const pg8::bf16_t*)F.WOUT, T, D, D}; pg8::StaticOrder So; So.init(T, D, G, (int)blockIdx.x);
        pg8::EpiOut E{F.x, F.out, F.XN, F.SS}; pg8::gemm_phase<pg8::EpiOut, pg8::StaticOrder, true, true>(lds, g, So, E); }
    SEAM(6);
    if (IN(7)) REP(7) { for (int m = blockIdx.x * NTHR + F.tid; m < T; m += G * NTHR) F.RSTD[m] = pg8::rstd16(F.SS + (size_t)m * 16);
        pg8::Gemm g{(const pg8::bf16_t*)(F.XN - 2 * D), (const pg8::bf16_t*)F.WUP, 256, NUP, D}; pg8::StaticOrder So; So.init(256, NUP, G, (int)blockIdx.x);
        pg8::EpiHalo E{F.YH, NUP, F.SS}; pg8::gemm_phase<pg8::EpiHalo, pg8::StaticOrder, true, true, 2>(lds, g, So, E); }
    SEAM(7);
    if (IN(8)) REP(8) { pg8::Gemm g{(const pg8::bf16_t*)F.XN, (const pg8::bf16_t*)F.WUP, T, NUP, D}; pg8::StaticOrder So; So.init(T, NUP, G, (int)blockIdx.x);
        pg8::EpiAct E{F.ACT, F.RSTD, F.YH, F.ffn_conv_w, F.ffn_conv_b, (LAS float*)(lds + RING_BYTES + 1024)};
        pg8::gemm_phase<pg8::EpiAct, pg8::StaticOrder, true, true, 1>(lds, g, So, E); }
    SEAM(8);
    if (IN(9)) { pg8::Gemm g{(const pg8::bf16_t*)F.ACT, (const pg8::bf16_t*)F.WDN, T, D, DFF}; pg8::StaticOrder So; So.init(T, D, G, (int)blockIdx.x);
        pg8::EpiOut E{F.out, F.out, nullptr, F.SS2}; pg8::gemm_phase<pg8::EpiOut, pg8::StaticOrder, true, true>(lds, g, So, E); }
    SEAM(9);
    if (IN(10)) final_norm_phase(F);
#undef IN
#undef SEAM
}

extern "C" void kernel_launch(void* const* d_in, const int* in_sizes, int n_in, void* d_out, int out_size, void* d_ws, size_t ws_size, hipStream_t stream) {
    static int grid = 0;
    if (grid == 0) {
        if (n_in != 17 || in_sizes[0] != T * D || out_size != T * D || ws_size < WS_END) { fprintf(stderr, "kernel_launch: unexpected shapes (n_in %d, in0 %d, out %d, ws %zu)\n", n_in, n_in > 0 ? in_sizes[0] : -1, out_size, ws_size); grid = -1; return; }
        int dev = 0, cus = 0, per_cu = 0;
        if (hipGetDevice(&dev) != hipSuccess || hipDeviceGetAttribute(&cus, hipDeviceAttributeMultiprocessorCount, dev) != hipSuccess) { fprintf(stderr, "kernel_launch: device query failed\n"); grid = -1; return; }
        if (hipFuncSetAttribute((const void*)mk_fwd, hipFuncAttributeMaxDynamicSharedMemorySize, LDS_BYTES) != hipSuccess) { fprintf(stderr, "kernel_launch: hipFuncSetAttribute failed\n"); grid = -1; return; }
        if (hipOccupancyMaxActiveBlocksPerMultiprocessor(&per_cu, (const void*)mk_fwd, NTHR, LDS_BYTES) != hipSuccess || per_cu < 1) fprintf(stderr, "kernel_launch: note: occupancy query reports %d workgroups per CU\n", per_cu);
        (void)hipGetLastError();
        grid = cus;
    }
    if (grid < 0) return;
    if (hipMemsetAsync((char*)d_ws + WS_CTL, 0, CTL_ZERO_BYTES, stream) != hipSuccess) { fprintf(stderr, "kernel_launch: memset failed\n"); return; }
    Args a{};
    for (int i = 0; i < 17; ++i) a.in[i] = (const float*)d_in[i];
    a.out = (float*)d_out; a.ws = (unsigned char*)d_ws;
    if (MK_N_LAUNCHES == 1) { a.ph_lo = 0; a.ph_hi = N_PHASES; hipLaunchKernelGGL(mk_fwd, dim3(grid), dim3(NTHR), LDS_BYTES, stream, a); }
    else for (int ph = 0; ph < N_PHASES; ++ph) { a.ph_lo = ph; a.ph_hi = ph + 1; hipLaunchKernelGGL(mk_fwd, dim3(grid), dim3(NTHR), LDS_BYTES, stream, a); }
}
```
